# Optimizing an MI355X kernel written in HIP

```python
import jax, jax.numpy as jnp
from jax import lax
import numpy as np

D_MODEL = 1024
BATCH = 8
SEQ = 2048
DEPTH = 2

MEM_LEN = 256
EPS = 1e-6
MLA_HEADS = 8
QK_NOPE = 64
QK_ROPE = 32
QK_HEAD = QK_NOPE + QK_ROPE
V_HEAD = 64
Q_LORA = 256
KV_LORA = 128
ROPE_THETA = 10000.0
Q_BLOCK = 128
CONV_WIDTH = 512
CONV_K = 3
SG_WIDTH = 512
SG_GROUPS = 4
SG_CHUNK = 128
MEM_HEADS = 4
MEM_HEAD_DIM = 128
N_BRANCH = 4
BRANCH_WIDTH = 512

IN_SIZES = [Q_LORA, KV_LORA, QK_ROPE, 3 * CONV_WIDTH, 2 * SG_WIDTH,
            MEM_HEADS * MEM_HEAD_DIM, N_BRANCH * BRANCH_WIDTH, N_BRANCH * D_MODEL]
IN_WIDTH = sum(IN_SIZES)
IN_OFFSETS = [int(o) for o in np.cumsum(IN_SIZES)[:-1]]
NEG_INF = -1e30

kernel_name = "hybrid_gated_mla_conv_sgmlp_memory"


def rms_norm(x, g):
    x32 = x.astype(jnp.float32)
    y = x32 * lax.rsqrt(jnp.mean(x32 * x32, axis=-1, keepdims=True) + EPS)
    return (y * g.astype(jnp.float32)).astype(x.dtype)


def layer_norm(x, g, b):
    x32 = x.astype(jnp.float32)
    mu = jnp.mean(x32, axis=-1, keepdims=True)
    xc = x32 - mu
    y = xc * lax.rsqrt(jnp.mean(xc * xc, axis=-1, keepdims=True) + EPS)
    return (y * g.astype(jnp.float32) + b.astype(jnp.float32)).astype(x.dtype)


def apply_rope(x, pos):
    half = x.shape[-1] // 2
    inv_freq = ROPE_THETA ** (-jnp.arange(half, dtype=jnp.float32) / half)
    ang = pos.astype(jnp.float32)[..., None] * inv_freq
    cos = jnp.cos(ang)[:, :, None, :].astype(x.dtype)
    sin = jnp.sin(ang)[:, :, None, :].astype(x.dtype)
    x1, x2 = x[..., :half], x[..., half:]
    return jnp.concatenate([x1 * cos - x2 * sin, x1 * sin + x2 * cos], axis=-1)


def causal_block_attention(q, k, v, scale):
    S = q.shape[1]
    outs = []
    for i in range(S // Q_BLOCK):
        lo, hi = i * Q_BLOCK, (i + 1) * Q_BLOCK
        qb, kb, vb = q[:, lo:hi], k[:, :hi], v[:, :hi]
        s = jnp.einsum('bqhd,bkhd->bhqk', qb, kb).astype(jnp.float32) * scale
        mask = jnp.arange(hi)[None, :] <= (lo + jnp.arange(Q_BLOCK))[:, None]
        s = jnp.where(mask, s, NEG_INF)
        p = jax.nn.softmax(s, axis=-1).astype(vb.dtype)
        outs.append(jnp.einsum('bhqk,bkhd->bqhd', p, vb))
    return jnp.concatenate(outs, axis=1)


def mla_branch(c_q, c_kv, k_rope, pos, cq_g, ckv_g, w_uq, w_ukv, q_g, k_g):
    B, S, _ = c_q.shape
    q = (rms_norm(c_q, cq_g) @ w_uq).reshape(B, S, MLA_HEADS, QK_HEAD)
    kv = (rms_norm(c_kv, ckv_g) @ w_ukv).reshape(B, S, MLA_HEADS, QK_NOPE + V_HEAD)
    k_nope, v = kv[..., :QK_NOPE], kv[..., QK_NOPE:]
    k_r = jnp.broadcast_to(k_rope[:, :, None, :], (B, S, MLA_HEADS, QK_ROPE))
    k = jnp.concatenate([k_nope, k_r], axis=-1)
    q = rms_norm(q, q_g)
    k = rms_norm(k, k_g)
    q = jnp.concatenate([q[..., :QK_NOPE], apply_rope(q[..., QK_NOPE:], pos)], axis=-1)
    k = jnp.concatenate([k[..., :QK_NOPE], apply_rope(k[..., QK_NOPE:], pos)], axis=-1)
    o = causal_block_attention(q, k, v, QK_HEAD ** -0.5)
    return o.reshape(B, S, MLA_HEADS * V_HEAD)


def shortconv_branch(conv_in, conv_w, conv_b):
    b_gate, c_gate, xin = jnp.split(conv_in, 3, axis=-1)
    S = xin.shape[1]
    z = c_gate * xin
    zp = jnp.pad(z, ((0, 0), (CONV_K - 1, 0), (0, 0)))
    y = conv_b + conv_w[0] * zp[:, 0:S]
    for j in range(1, CONV_K):
        y = y + conv_w[j] * zp[:, j:j + S]
    return b_gate * y


def spatial_gating_branch(sg_in, ln_g, ln_b, w_s, b_s):
    u, v = jnp.split(sg_in, 2, axis=-1)
    B, S, _ = v.shape
    v = layer_norm(v, ln_g, ln_b)
    v = v.reshape(B, S // SG_CHUNK, SG_CHUNK, SG_GROUPS, SG_WIDTH // SG_GROUPS)
    tril = jnp.tril(jnp.ones((SG_CHUNK, SG_CHUNK), dtype=bool))
    w = jnp.where(tril[None], w_s, jnp.zeros((), w_s.dtype))
    mixed = jnp.einsum('gts,bcsgd->bctgd', w, v) + b_s.T[None, None, :, :, None]
    return u * mixed.reshape(B, S, SG_WIDTH)


def memory_branch(q_in, mem, mem_g, w_mem_kv, q_g, k_g):
    B, S, _ = q_in.shape
    M = mem.shape[1]
    q = rms_norm(q_in.reshape(B, S, MEM_HEADS, MEM_HEAD_DIM), q_g)
    kv = (rms_norm(mem, mem_g) @ w_mem_kv).reshape(B, M, 2, MEM_HEADS, MEM_HEAD_DIM)
    k = rms_norm(kv[:, :, 0], k_g)
    v = kv[:, :, 1]
    s = jnp.einsum('bqhd,bmhd->bhqm', q, k).astype(jnp.float32) * (MEM_HEAD_DIM ** -0.5)
    p = jax.nn.softmax(s, axis=-1).astype(v.dtype)
    o = jnp.einsum('bhqm,bmhd->bqhd', p, v)
    return o.reshape(B, S, MEM_HEADS * MEM_HEAD_DIM)


def hybrid_layer(x, mem, pos, norm_g, w_in, cq_g, ckv_g, w_uq, w_ukv, mla_qg, mla_kg,
                 conv_w, conv_b, sg_ln_g, sg_ln_b, w_s, b_s, mem_g, w_mem_kv, mem_qg, mem_kg,
                 b_merge, w_branch, w_out):
    B, S, D = x.shape
    h = rms_norm(x, norm_g)
    proj = h @ w_in
    c_q, c_kv, k_rope, conv_in, sg_in, mem_q, silu_gates, merge_logits = jnp.split(proj, IN_OFFSETS, axis=-1)
    y_a = mla_branch(c_q, c_kv, k_rope, pos, cq_g, ckv_g, w_uq, w_ukv, mla_qg, mla_kg)
    y_b = shortconv_branch(conv_in, conv_w, conv_b)
    y_c = spatial_gating_branch(sg_in, sg_ln_g, sg_ln_b, w_s, b_s)
    y_d = memory_branch(mem_q, mem, mem_g, w_mem_kv, mem_qg, mem_kg)
    ys = jnp.stack([y_a, y_b, y_c, y_d], axis=2)
    ys = ys * jax.nn.silu(silu_gates.reshape(B, S, N_BRANCH, BRANCH_WIDTH))
    z = jnp.einsum('bsnw,nwd->bsnd', ys, w_branch)
    gate = jax.nn.sigmoid(merge_logits.reshape(B, S, N_BRANCH, D) + b_merge)
    merged = jnp.sum(gate * z, axis=2)
    return x + merged @ w_out


def setup_inputs(seed: int = 0) -> dict:
    key = jax.random.key(seed)
    ks = jax.random.split(key, 32)
    f32 = jnp.float32
    L = DEPTH

    def nrm(k, shape, scale):
        return jax.random.normal(k, shape, f32) * scale

    def gain(k, shape):
        return 1.0 + 0.05 * jax.random.normal(k, shape, f32)

    x = jax.random.normal(ks[0], (BATCH, SEQ, D_MODEL), f32)
    mem = jax.random.normal(ks[1], (BATCH, MEM_LEN, D_MODEL), f32)
    offset = jax.random.randint(ks[2], (BATCH, 1), 0, 1024, dtype=jnp.int32)
    positions = offset + jnp.arange(SEQ, dtype=jnp.int32)[None, :]
    return {
        "x": x,
        "mem": mem,
        "positions": positions,
        "norm_g": gain(ks[3], (L, D_MODEL)),
        "w_in": nrm(ks[4], (L, D_MODEL, IN_WIDTH), D_MODEL ** -0.5),
        "cq_norm_g": gain(ks[5], (L, Q_LORA)),
        "ckv_norm_g": gain(ks[6], (L, KV_LORA)),
        "w_uq": nrm(ks[7], (L, Q_LORA, MLA_HEADS * QK_HEAD), Q_LORA ** -0.5),
        "w_ukv": nrm(ks[8], (L, KV_LORA, MLA_HEADS * (QK_NOPE + V_HEAD)), KV_LORA ** -0.5),
        "mla_q_norm_g": gain(ks[9], (L, QK_HEAD)),
        "mla_k_norm_g": gain(ks[10], (L, QK_HEAD)),
        "conv_w": nrm(ks[11], (L, CONV_K, CONV_WIDTH), CONV_K ** -0.5),
        "conv_b": nrm(ks[12], (L, CONV_WIDTH), 0.02),
        "sg_ln_g": gain(ks[13], (L, SG_WIDTH)),
        "sg_ln_b": nrm(ks[14], (L, SG_WIDTH), 0.02),
        "w_spatial": nrm(ks[15], (L, SG_GROUPS, SG_CHUNK, SG_CHUNK), 0.5 * SG_CHUNK ** -0.5),
        "b_spatial": 1.0 + 0.1 * jax.random.normal(ks[16], (L, SG_GROUPS, SG_CHUNK), f32),
        "mem_norm_g": gain(ks[17], (L, D_MODEL)),
        "w_mem_kv": nrm(ks[18], (L, D_MODEL, 2 * MEM_HEADS * MEM_HEAD_DIM), D_MODEL ** -0.5),
        "mem_q_norm_g": gain(ks[19], (L, MEM_HEAD_DIM)),
        "mem_k_norm_g": gain(ks[20], (L, MEM_HEAD_DIM)),
        "b_merge": nrm(ks[21], (L, N_BRANCH, D_MODEL), 0.1),
        "w_branch": nrm(ks[22], (L, N_BRANCH, BRANCH_WIDTH, D_MODEL), BRANCH_WIDTH ** -0.5),
        "w_out": nrm(ks[23], (L, D_MODEL, D_MODEL), D_MODEL ** -0.5),
    }


def reference(x, mem, positions, norm_g, w_in, cq_norm_g, ckv_norm_g, w_uq, w_ukv,
              mla_q_norm_g, mla_k_norm_g, conv_w, conv_b, sg_ln_g, sg_ln_b, w_spatial,
              b_spatial, mem_norm_g, w_mem_kv, mem_q_norm_g, mem_k_norm_g, b_merge,
              w_branch, w_out):
    for l in range(DEPTH):
        x = hybrid_layer(x, mem, positions, norm_g[l], w_in[l], cq_norm_g[l], ckv_norm_g[l],
                         w_uq[l], w_ukv[l], mla_q_norm_g[l], mla_k_norm_g[l], conv_w[l], conv_b[l],
                         sg_ln_g[l], sg_ln_b[l], w_spatial[l], b_spatial[l], mem_norm_g[l],
                         w_mem_kv[l], mem_q_norm_g[l], mem_k_norm_g[l], b_merge[l],
                         w_branch[l], w_out[l])
    return x
```

```cpp
#include <hip/hip_runtime.h>
#include <hip/hip_cooperative_groups.h>
#include <cstdio>
#include <cstdint>
namespace cg = cooperative_groups;
namespace pg8 {
#define PG8_LAS __attribute__((address_space(3)))
typedef unsigned short bf16_t;
typedef short bf16x8 __attribute__((ext_vector_type(8)));
typedef float f32x4 __attribute__((ext_vector_type(4)));
typedef unsigned u32x4 __attribute__((ext_vector_type(4)));
constexpr int BM = 256, BK = 64, HALF = 128, HTB = HALF * BK * 2  , STAGE_BYTES = 8 * HTB, NXCD = 8, WGM = 8;

__host__ __device__ __forceinline__ int lds_byte(int r, int c) { const int st = (r >> 4) * 2 + (c >> 5), rr = r & 15, cc = c & 31, ob = rr * 64 + cc * 2; return st * 1024 + (ob ^ (((ob >> 9) & 1) << 5)); }
__host__ __device__ __forceinline__ void stage_rc(int b, int& R, int& C) { const int st = b / 1024, sb = b % 1024, swz = sb ^ (((sb >> 9) & 1) << 5); R = (st >> 1) * 16 + swz / 64; C = (st & 1) * 32 + (swz % 64) / 2; }
__host__ __device__ __forceinline__ int perm32(int rho) { const int n = rho >> 4, i = rho & 15; return 8 * (i >> 2) + 4 * n + (i & 3); }

struct Unit { int pm, pn; };
struct Gemm { const bf16_t* A; int lda; const bf16_t* Bt; int M, N, K; };

struct StaticOrder {
    int nM, nN, nwg, G, c;
    __host__ __device__ void init(int M, int N, int G_, int c_) { nM = M / BM; nN = N / BM; nwg = nM * nN; G = G_; c = c_; }
    __host__ __device__ bool next(int i, Unit& u) const {
        const long L = (long)i * G + c; if (L >= nwg) return false;
        int wgid = (int)L; { const int q = nwg / NXCD, r = nwg % NXCD, xcd = wgid % NXCD, off = wgid / NXCD; wgid = (xcd < r ? xcd * (q + 1) : r * (q + 1) + (xcd - r) * q) + off; }
        const int nig = WGM * nN, gid = wgid / nig, fm = gid * WGM, gsz = (nM - fm) < WGM ? (nM - fm) : WGM;
        u.pm = fm + ((wgid % nig) % gsz); u.pn = (wgid % nig) / gsz; return true;
    }
    __device__ __forceinline__ void a_ready(const Unit&) const {}
    __device__ __forceinline__ void done(const Unit&) const {}
};

__device__ __forceinline__ unsigned cvt_pk_bf16(float lo, float hi) { unsigned r; asm volatile("v_cvt_pk_bf16_f32 %0, %1, %2" : "=v"(r) : "v"(lo), "v"(hi)); return r; }
__device__ __forceinline__ int opaque_tid() { int t = threadIdx.x; asm volatile("" : "+v"(t)); return t; }
__device__ __forceinline__ float bflo(unsigned u) { return __uint_as_float(u << 16); }
__device__ __forceinline__ float bfhi(unsigned u) { return __uint_as_float(u & 0xffff0000u); }
__device__ __forceinline__ float sigm(float x) { return __builtin_amdgcn_rcpf(1.0f + __expf(-x)); }

template <int ACT> struct EpiAct {
    static constexpr bool PERM = true, AFTER_DRAIN = false, HAS_MID = false;
    bf16_t* O0; int ld0; int npn0; bf16_t* O1; int ld1; const float* bias;
    __device__ __forceinline__ void operator()(const f32x4 (&acc)[2][2][4][2], const Unit& u, int wr, int wc, int fr, int fq) const {
        const int row0 = u.pm * BM + wr * 64 + fr;
        const bool second = (u.pn >= npn0);
        bf16_t* base = second ? O1 : O0; const int ld = second ? ld1 : ld0; const int colt = second ? (u.pn - npn0) * BM : u.pn * BM;
        const int col0 = colt + wc * 32 + 8 * fq;
#pragma unroll
        for (int bj = 0; bj < 2; ++bj) {
            f32x4 b0 = (f32x4){0.f, 0.f, 0.f, 0.f}, b1 = b0;
            if (ACT == 2) { b0 = *(const f32x4*)(bias + col0 + bj * HALF); b1 = *(const f32x4*)(bias + col0 + bj * HALF + 4); }
#pragma unroll
            for (int ai = 0; ai < 2; ++ai)
#pragma unroll
                for (int m = 0; m < 4; ++m) {
                    bf16_t* rowp = base + (size_t)(row0 + ai * HALF + m * 16) * ld + col0 + bj * HALF;
                    f32x4 v0 = acc[ai][bj][m][0], v1 = acc[ai][bj][m][1];
                    if (ACT != 0 && second) {
#pragma unroll
                        for (int e = 0; e < 4; ++e) {
                            if (ACT == 1) { v0[e] = v0[e] * sigm(v0[e]); v1[e] = v1[e] * sigm(v1[e]); }
                            if (ACT == 2) { v0[e] = sigm(v0[e] + b0[e]); v1[e] = sigm(v1[e] + b1[e]); }
                        }
                    }
                    u32x4 w; w.x = cvt_pk_bf16(v0[0], v0[1]); w.y = cvt_pk_bf16(v0[2], v0[3]); w.z = cvt_pk_bf16(v1[0], v1[1]); w.w = cvt_pk_bf16(v1[2], v1[3]);
                    *(u32x4*)rowp = w;
                }
        }
    }
};

struct EpiGate {
    static constexpr bool PERM = true, AFTER_DRAIN = false, HAS_MID = true;
    const bf16_t* GATE; bf16_t* O;
    __device__ __forceinline__ void mid(f32x4 (&acc)[2][2][4][2], const Unit& u, int nb, int wr, int wc, int fr_, int fq_) const {
        int fr = fr_, fq = fq_; asm volatile("" : "+v"(fr), "+v"(fq));
        const int row0 = u.pm * BM + wr * 64 + fr, col0 = u.pn * BM + wc * 32 + 8 * fq;
#pragma unroll
        for (int ai = 0; ai < 2; ++ai)
#pragma unroll
            for (int m = 0; m < 4; ++m)
#pragma unroll
                for (int bj = 0; bj < 2; ++bj) {
                    const bf16_t* gp = GATE + (size_t)(row0 + ai * HALF + m * 16) * 4096 + (nb - 1) * 1024 + col0 + bj * HALF;
                    const u32x4 a = *(const u32x4*)gp, b = *(const u32x4*)(gp + 1024);
                    f32x4 r0, r1;
                    r0[0] = bflo(a.x) * __builtin_amdgcn_rcpf(bflo(b.x)); r0[1] = bfhi(a.x) * __builtin_amdgcn_rcpf(bfhi(b.x));
                    r0[2] = bflo(a.y) * __builtin_amdgcn_rcpf(bflo(b.y)); r0[3] = bfhi(a.y) * __builtin_amdgcn_rcpf(bfhi(b.y));
                    r1[0] = bflo(a.z) * __builtin_amdgcn_rcpf(bflo(b.z)); r1[1] = bfhi(a.z) * __builtin_amdgcn_rcpf(bfhi(b.z));
                    r1[2] = bflo(a.w) * __builtin_amdgcn_rcpf(bflo(b.w)); r1[3] = bfhi(a.w) * __builtin_amdgcn_rcpf(bfhi(b.w));
                    acc[ai][bj][m][0] = acc[ai][bj][m][0] * r0; acc[ai][bj][m][1] = acc[ai][bj][m][1] * r1;
                    __builtin_amdgcn_sched_barrier(0);
                }
    }
    __device__ __forceinline__ void operator()(const f32x4 (&acc)[2][2][4][2], const Unit& u, int wr, int wc, int fr, int fq) const {
        const int row0 = u.pm * BM + wr * 64 + fr, col0 = u.pn * BM + wc * 32 + 8 * fq;
#pragma unroll
        for (int ai = 0; ai < 2; ++ai)
#pragma unroll
            for (int m = 0; m < 4; ++m)
#pragma unroll
                for (int bj = 0; bj < 2; ++bj) {
                    const size_t r = (size_t)(row0 + ai * HALF + m * 16);
                    const u32x4 a = *(const u32x4*)(GATE + r * 4096 + 3 * 1024 + col0 + bj * HALF);
                    const f32x4 v0 = acc[ai][bj][m][0], v1 = acc[ai][bj][m][1];
                    u32x4 w; w.x = cvt_pk_bf16(v0[0] * bflo(a.x), v0[1] * bfhi(a.x)); w.y = cvt_pk_bf16(v0[2] * bflo(a.y), v0[3] * bfhi(a.y));
                    w.z = cvt_pk_bf16(v1[0] * bflo(a.z), v1[1] * bfhi(a.z)); w.w = cvt_pk_bf16(v1[2] * bflo(a.w), v1[3] * bfhi(a.w));
                    *(u32x4*)(O + r * 1024 + col0 + bj * HALF) = w;
                    __builtin_amdgcn_sched_barrier(0);
                }
    }
};

struct EpiRes {
    static constexpr bool PERM = false, AFTER_DRAIN = false, HAS_MID = false;
    const float* base; float* out; int ldc;
    __device__ __forceinline__ void operator()(const f32x4 (&acc)[2][2][4][2], const Unit& u, int wr, int wc, int fr, int fq) const {
        const int row0 = u.pm * BM + wr * 64 + fr, col0 = u.pn * BM + wc * 32 + 4 * fq;
#pragma unroll
        for (int ai = 0; ai < 2; ++ai)
#pragma unroll
            for (int m = 0; m < 4; ++m)
#pragma unroll
                for (int bj = 0; bj < 2; ++bj)
#pragma unroll
                    for (int n = 0; n < 2; ++n) {
                        const size_t o = (size_t)(row0 + ai * HALF + m * 16) * ldc + col0 + bj * HALF + 16 * n;
                        const f32x4 x = *(const f32x4*)(base + o);
                        *(f32x4*)(out + o) = x + acc[ai][bj][m][n];
                    }
    }
};
template <class Epi, class Sched, bool ALIGN_EPI = false, bool SP2 = false>
__device__ __forceinline__ void gemm_phase(PG8_LAS unsigned char* lds, const Gemm g, const Sched& S, const Epi& E) {
    const int tid = pg8::opaque_tid(), wid = __builtin_amdgcn_readfirstlane(tid >> 6), lane = tid & 63, wr = wid >> 2, wc = wid & 3, fr = lane & 15, fq = lane >> 4;
    const int K = g.K, nt = K / BK;
    unsigned voffA[2], voffB[2];
#pragma unroll
    for (int i = 0; i < 2; ++i) { int R, C; stage_rc(tid * 16 + i * 8192, R, C); const int Rb = Epi::PERM ? ((R & ~31) + perm32(R & 31)) : R;
        voffA[i] = (unsigned)(R * g.lda + C) * 2u; voffB[i] = (unsigned)(Rb * K + C) * 2u; }
    const size_t kstep = (size_t)(BK * 2);
    const size_t hstepA = (size_t)HALF * g.lda * 2, hstepB = (size_t)HALF * K * 2;
    const size_t tstepA = 2 * hstepA, tstepB = 2 * hstepB;
    const unsigned ldsw = (unsigned)wid * 1024u;
    const int aoff = lds_byte(wr * 64 + fr, fq * 8), boff = lds_byte(wc * 32 + fr, fq * 8);
#define PG8_SA(b, h) (((b) * 2 + (h)) * HTB)
#define PG8_SB(b, h) ((4 + (b) * 2 + (h)) * HTB)
#define PG8_STAGE(bufoff, gbase, voff) do { _Pragma("unroll") for (int _i = 0; _i < 2; ++_i) \
        __builtin_amdgcn_global_load_lds((const unsigned*)((const char*)(gbase) + (voff)[_i]), (PG8_LAS unsigned*)(lds + (bufoff) + ldsw + _i * 8192), 16, 0, 0); } while (0)
#define PG8_LDA(dst, b, h) do { _Pragma("unroll") for (int m = 0; m < 4; ++m) _Pragma("unroll") for (int k = 0; k < 2; ++k) dst[m][k] = *(const PG8_LAS bf16x8*)(lds + PG8_SA(b, h) + aoff + m * 2048 + k * 1024); } while (0)
#define PG8_LDB(dst, b, h) do { _Pragma("unroll") for (int n = 0; n < 2; ++n) _Pragma("unroll") for (int k = 0; k < 2; ++k) dst[n][k] = *(const PG8_LAS bf16x8*)(lds + PG8_SB(b, h) + boff + n * 2048 + k * 1024); } while (0)
#define PG8_MMA(ai, bj, At, Bt) do { __builtin_amdgcn_s_setprio(1); _Pragma("unroll") for (int m = 0; m < 4; ++m) _Pragma("unroll") for (int n = 0; n < 2; ++n) _Pragma("unroll") for (int k = 0; k < 2; ++k) \
        acc[ai][bj][m][n] = __builtin_amdgcn_mfma_f32_16x16x32_bf16(Bt[n][k], At[m][k], acc[ai][bj][m][n], 0, 0, 0); __builtin_amdgcn_s_setprio(0); } while (0)
#define PG8_WAIT_V(n) asm volatile("s_waitcnt vmcnt(" #n ")" ::: "memory")
#define PG8_WAIT_L(n) asm volatile("s_waitcnt lgkmcnt(" #n ")" ::: "memory")
#define PG8_BAR __builtin_amdgcn_s_barrier()
#define PG8_SCHED __builtin_amdgcn_sched_barrier(0)
    Unit cur, nxt; int ui = 0;
    if (!S.next(0, cur)) return;
    f32x4 acc[2][2][4][2];
#pragma unroll
    for (int a = 0; a < 2; ++a)
#pragma unroll
        for (int b = 0; b < 2; ++b)
#pragma unroll
            for (int m = 0; m < 4; ++m)
#pragma unroll
                for (int n = 0; n < 2; ++n) acc[a][b][m][n] = (f32x4){0.f, 0.f, 0.f, 0.f};
    bf16x8 At[4][2], B0[2][2], B1[2][2];
    const char* cA = (const char*)g.A + (size_t)cur.pm * tstepA; const char* cB = (const char*)g.Bt + (size_t)cur.pn * tstepB;
    S.a_ready(cur);
    if constexpr (SP2) {
        PG8_STAGE(PG8_SB(0, 0), cB, voffB); PG8_STAGE(PG8_SB(0, 1), cB + hstepB, voffB); PG8_STAGE(PG8_SA(0, 0), cA, voffA); PG8_STAGE(PG8_SA(0, 1), cA + hstepA, voffA);
        if (wr == 1) PG8_BAR;
        PG8_WAIT_V(2); PG8_BAR;
        PG8_STAGE(PG8_SB(1, 0), cB + kstep, voffB); PG8_STAGE(PG8_SA(1, 0), cA + kstep, voffA); PG8_STAGE(PG8_SB(1, 1), cB + hstepB + kstep, voffB);
        PG8_WAIT_V(6); PG8_BAR;
    } else {
        PG8_STAGE(PG8_SB(0, 0), cB, voffB); PG8_STAGE(PG8_SA(0, 0), cA, voffA); PG8_STAGE(PG8_SB(0, 1), cB + hstepB, voffB); PG8_STAGE(PG8_SA(0, 1), cA + hstepA, voffA);
        if (wr == 1) PG8_BAR;
        PG8_WAIT_V(4); PG8_BAR;
        PG8_STAGE(PG8_SB(1, 0), cB + kstep, voffB); PG8_STAGE(PG8_SA(1, 0), cA + kstep, voffA); PG8_STAGE(PG8_SB(1, 1), cB + hstepB + kstep, voffB);
        PG8_WAIT_V(6); PG8_BAR;
    }
    for (;;) {
        const bool has_next = S.next(ui + 1, nxt);
        const char* nA = has_next ? (const char*)g.A + (size_t)nxt.pm * tstepA : cA; const char* nB = has_next ? (const char*)g.Bt + (size_t)nxt.pn * tstepB : cB;
        for (int t = 0; t < nt; t += 2) {
            if constexpr (Epi::HAS_MID) { if (t != 0 && (t & 7) == 0) E.mid(acc, cur, t >> 3, wr, wc, fr, fq); }
            const bool last = (t == nt - 2);
            const char* a1 = cA + (size_t)(t + 1) * kstep;
            const char* a2 = last ? nA : cA + (size_t)(t + 2) * kstep; const char* b2 = last ? nB : cB + (size_t)(t + 2) * kstep;
            const char* a3 = a2 + kstep; const char* b3 = b2 + kstep;
            if (last && has_next) S.a_ready(nxt);
            if constexpr (SP2) {
            PG8_LDB(B0, 0, 0); PG8_LDB(B1, 0, 1); PG8_SCHED; PG8_LDA(At, 0, 0); PG8_STAGE(PG8_SA(1, 1), a1 + hstepA, voffA);
            PG8_WAIT_V(8); PG8_WAIT_L(0); PG8_BAR; PG8_MMA(0, 0, At, B0); PG8_MMA(0, 1, At, B1); PG8_BAR; PG8_SCHED;
            PG8_LDA(At, 0, 1); PG8_STAGE(PG8_SB(0, 0), b2, voffB); PG8_STAGE(PG8_SB(0, 1), b2 + hstepB, voffB); PG8_STAGE(PG8_SA(0, 0), a2, voffA);
            PG8_WAIT_V(8); PG8_WAIT_L(0); PG8_BAR; PG8_MMA(1, 0, At, B0); PG8_MMA(1, 1, At, B1); PG8_BAR; PG8_SCHED;
            PG8_LDB(B0, 1, 0); PG8_LDB(B1, 1, 1); PG8_SCHED; PG8_LDA(At, 1, 0); PG8_STAGE(PG8_SA(0, 1), a2 + hstepA, voffA);
            PG8_WAIT_V(8); PG8_WAIT_L(0); PG8_BAR; PG8_MMA(0, 0, At, B0); PG8_MMA(0, 1, At, B1); PG8_BAR; PG8_SCHED;
            PG8_LDA(At, 1, 1); PG8_STAGE(PG8_SB(1, 0), b3, voffB); PG8_STAGE(PG8_SB(1, 1), b3 + hstepB, voffB); PG8_STAGE(PG8_SA(1, 0), a3, voffA);
            PG8_WAIT_V(8); PG8_WAIT_L(0); PG8_BAR; PG8_MMA(1, 0, At, B0); PG8_MMA(1, 1, At, B1); PG8_BAR; PG8_SCHED;
            } else {
            PG8_LDB(B0, 0, 0); PG8_SCHED; PG8_LDA(At, 0, 0); PG8_STAGE(PG8_SA(1, 1), a1 + hstepA, voffA);
            PG8_WAIT_L(8); PG8_BAR; PG8_WAIT_L(0); PG8_MMA(0, 0, At, B0); PG8_BAR; PG8_SCHED;
            PG8_LDB(B1, 0, 1); PG8_STAGE(PG8_SB(0, 0), b2, voffB);
            PG8_BAR; PG8_WAIT_L(0); PG8_MMA(0, 1, At, B1); PG8_BAR;
            PG8_LDA(At, 0, 1); PG8_STAGE(PG8_SA(0, 0), a2, voffA);
            PG8_BAR; PG8_WAIT_L(0); PG8_MMA(1, 0, At, B0); PG8_BAR; PG8_SCHED;
            PG8_STAGE(PG8_SB(0, 1), b2 + hstepB, voffB);
            PG8_WAIT_V(6); PG8_BAR; PG8_MMA(1, 1, At, B1); PG8_BAR;
            PG8_LDB(B0, 1, 0); PG8_SCHED; PG8_LDA(At, 1, 0); PG8_STAGE(PG8_SA(0, 1), a2 + hstepA, voffA);
            PG8_WAIT_L(8); PG8_BAR; PG8_WAIT_L(0); PG8_MMA(0, 0, At, B0); PG8_BAR; PG8_SCHED;
            PG8_LDB(B1, 1, 1); PG8_STAGE(PG8_SB(1, 0), b3, voffB);
            PG8_BAR; PG8_WAIT_L(0); PG8_MMA(0, 1, At, B1); PG8_BAR;
            PG8_LDA(At, 1, 1); PG8_STAGE(PG8_SA(1, 0), a3, voffA);
            PG8_BAR; PG8_WAIT_L(0); PG8_MMA(1, 0, At, B0); PG8_BAR; PG8_SCHED;
            PG8_STAGE(PG8_SB(1, 1), b3 + hstepB, voffB);
            PG8_WAIT_V(6); PG8_BAR; PG8_MMA(1, 1, At, B1); PG8_BAR;
            }
        }
        if constexpr (ALIGN_EPI) { if (wr == 0) PG8_BAR; }
        if constexpr (!Epi::AFTER_DRAIN) { E(acc, cur, wr, wc, fr, fq); S.done(cur); }
        if (!has_next) break;
#pragma unroll
        for (int a = 0; a < 2; ++a)
#pragma unroll
            for (int b = 0; b < 2; ++b)
#pragma unroll
                for (int m = 0; m < 4; ++m)
#pragma unroll
                    for (int n = 0; n < 2; ++n) acc[a][b][m][n] = (f32x4){0.f, 0.f, 0.f, 0.f};
        cur = nxt; cA = nA; cB = nB; ++ui;
        if constexpr (ALIGN_EPI) { if (wr == 1) PG8_BAR; }
    }
    PG8_WAIT_V(0);
    if constexpr (!ALIGN_EPI) { if (wr == 0) PG8_BAR; }
    PG8_BAR;
    if constexpr (Epi::AFTER_DRAIN) { E.fused(acc, cur, wr, wc, fr, fq, lds, wid, lane); S.done(cur); }
#undef PG8_SA
#undef PG8_SB
#undef PG8_STAGE
#undef PG8_LDA
#undef PG8_LDB
#undef PG8_MMA
#undef PG8_WAIT_V
#undef PG8_WAIT_L
#undef PG8_BAR
#undef PG8_SCHED
}
}
constexpr int NWAVES = 8, NTHR = 512;
constexpr int BATCH = 8, SEQ = 2048, DM = 1024, T = BATCH * SEQ, DEPTH = 2, MEML = 256, MEMT = BATCH * MEML;
constexpr int INW = 9632, INWP = 9728, NA = 5632  , MIXW = 3584, GW = 2048, GATEW = 4096;
constexpr float EPS = 1e-6f;
constexpr int MC_CQ = 0, MC_CKV = 256, MC_KR = 384, MC_BG = 512, MC_CG = 1024, MC_XIN = 1536, MC_U = 2048, MC_V = 2560, MC_MQ = 3072;
constexpr size_t MiB = 1u << 20;
constexpr size_t WS_W0 = 1 * MiB, WS_W1 = 275 * MiB;
constexpr size_t WO_WIN = 0, WO_WUQ = 19 * MiB, WO_WUKV = WO_WUQ + 768 * 256 * 2, WO_WBR = WO_WUKV + 1024 * 128 * 2, WO_WOUT = WO_WBR + 4 * MiB, WO_END = WO_WOUT + 2 * MiB;
static_assert(WO_END <= 26 * MiB, "weights");
constexpr size_t WS_MEMK = 27 * MiB, WS_MEMVT = 31 * MiB;
constexpr size_t WS_MIX = 35 * MiB, WS_GATE = 35 * MiB;
constexpr size_t WS_Q = 147 * MiB, WS_K = 171 * MiB, WS_VT = 195 * MiB, WS_H = 179 * MiB, WS_MERGED = 179 * MiB;
constexpr size_t WS_WMEMT = 147 * MiB, WS_MEMN = 151 * MiB, WS_KVRAW = 159 * MiB;
constexpr size_t WS_G = 211 * MiB, WS_END = 301 * MiB;
constexpr int LDS_BYTES = 147456;

#define LAS __attribute__((address_space(3)))
typedef unsigned short bf16;
typedef unsigned v4u __attribute__((ext_vector_type(4)));
typedef unsigned v2u __attribute__((ext_vector_type(2)));
typedef float f32x4 __attribute__((ext_vector_type(4)));
typedef short bf16x8 __attribute__((ext_vector_type(8)));
using pg8::cvt_pk_bf16; using pg8::bflo; using pg8::bfhi; using pg8::sigm;

__device__ __forceinline__ float wave_sum(float v) {
#pragma unroll
    for (int o = 1; o < 64; o <<= 1) v += __shfl_xor(v, o);
    return v;
}
__device__ __forceinline__ f32x4 mfma16(bf16x8 a, bf16x8 b, f32x4 c) { return __builtin_amdgcn_mfma_f32_16x16x32_bf16(a, b, c, 0, 0, 0); }
__device__ __forceinline__ bf16x8 as_bf8(v4u v) { return __builtin_bit_cast(bf16x8, v); }

struct Args { const float* in[24]; float* out; unsigned char* ws; int ph_lo, ph_hi; };

__device__ __forceinline__ void tr_item(const float* W, int K, int N, bf16* WT, int ldt, int coff, int win, LAS float* scr, int item, int lane) {
    const int nblk = N / 32, kb = item / nblk, nb = item % nblk, k0 = 64 * kb, n0 = 32 * nb;
    const int radd = (win && n0 >= 416) ? 96 : 0;
#pragma unroll 8
    for (int i = 0; i < 32; ++i) { const int kk = 2 * i + (lane >> 5); scr[kk * 33 + (lane & 31)] = W[(size_t)(k0 + kk) * N + n0 + (lane & 31)]; }
    asm volatile("s_waitcnt lgkmcnt(0)" ::: "memory");
    const int c = lane & 7;
#pragma unroll
    for (int j = 0; j < 4; ++j) { const int n = (lane >> 3) + 8 * j; const LAS float* s = scr + (8 * c) * 33 + n;
        v4u o; o.x = cvt_pk_bf16(s[0 * 33], s[1 * 33]); o.y = cvt_pk_bf16(s[2 * 33], s[3 * 33]); o.z = cvt_pk_bf16(s[4 * 33], s[5 * 33]); o.w = cvt_pk_bf16(s[6 * 33], s[7 * 33]);
        *(v4u*)(WT + (size_t)(radd + n0 + n) * ldt + coff + k0 + 8 * c) = o; }
    asm volatile("s_waitcnt lgkmcnt(0)" ::: "memory");
}
__device__ __forceinline__ void rms_row(const float* xrow, const float* g, bf16* orow, int lane) {
    const f32x4* xr = (const f32x4*)xrow + lane; const f32x4* gr = (const f32x4*)g + lane;
    f32x4 v[4]; float s = 0.f;
#pragma unroll
    for (int j = 0; j < 4; ++j) { v[j] = xr[64 * j]; s += (v[j].x * v[j].x + v[j].y * v[j].y) + (v[j].z * v[j].z + v[j].w * v[j].w); }
    const float rstd = 1.0f / sqrtf(wave_sum(s) * (1.f / 1024.f) + EPS);
    v2u* o8 = (v2u*)orow + lane;
#pragma unroll
    for (int j = 0; j < 4; ++j) { const f32x4 gg = gr[64 * j]; v2u o; o.x = cvt_pk_bf16(v[j].x * rstd * gg.x, v[j].y * rstd * gg.y); o.y = cvt_pk_bf16(v[j].z * rstd * gg.z, v[j].w * rstd * gg.w); o8[64 * j] = o; }
}
__device__ __forceinline__ void norm_rows(const float* x, const float* g, bf16* H, int rows, int bid, int nb) {
    const int tid = pg8::opaque_tid(), lane = tid & 63, gw = bid * NWAVES + (tid >> 6), ngw = nb * NWAVES;
    for (int m = gw; m < rows; m += ngw) rms_row(x + (size_t)m * DM, g, H + (size_t)m * DM, lane);
}

__device__ __forceinline__ void ph_prologue(const Args& a, LAS unsigned char* lds, int bid, int nb) {
    const int tid = pg8::opaque_tid(), lane = tid & 63, wave = tid >> 6;
    LAS float* scr = (LAS float*)(lds + wave * 16384);
    const int gw = bid * NWAVES + wave, ngw = nb * NWAVES;
    constexpr int I_IN = 16 * 301, I_UQ = 4 * 24, I_UKV = 2 * 32, I_MEM = 16 * 32, I_BR = 8 * 32, I_OUT = 16 * 32;
    constexpr int PER_L = I_IN + I_UQ + I_UKV + I_MEM + 4 * I_BR + I_OUT;
    for (int it0 = gw; it0 < 2 * PER_L; it0 += ngw) {
        const int l = it0 / PER_L; int r = it0 % PER_L;
        unsigned char* wb = a.ws + (l ? WS_W1 : WS_W0);
        if (r < I_IN) { tr_item(a.in[4] + (size_t)l * DM * INW, DM, INW, (bf16*)(wb + WO_WIN), DM, 0, 1, scr, r, lane); continue; } r -= I_IN;
        if (r < I_UQ) { tr_item(a.in[7] + (size_t)l * 256 * 768, 256, 768, (bf16*)(wb + WO_WUQ), 256, 0, 0, scr, r, lane); continue; } r -= I_UQ;
        if (r < I_UKV) { tr_item(a.in[8] + (size_t)l * 128 * 1024, 128, 1024, (bf16*)(wb + WO_WUKV), 128, 0, 0, scr, r, lane); continue; } r -= I_UKV;
        if (r < I_MEM) { tr_item(a.in[18] + (size_t)l * DM * 1024, DM, 1024, (bf16*)(a.ws + WS_WMEMT + l * 2 * MiB), DM, 0, 0, scr, r, lane); continue; } r -= I_MEM;
        if (r < 4 * I_BR) { const int n = r / I_BR; tr_item(a.in[22] + ((size_t)l * 4 + n) * 512 * DM, 512, DM, (bf16*)(wb + WO_WBR), 2048, n * 512, 0, scr, r % I_BR, lane); continue; } r -= 4 * I_BR;
        tr_item(a.in[23] + (size_t)l * DM * DM, DM, DM, (bf16*)(wb + WO_WOUT), DM, 0, 0, scr, r, lane);
    }
    for (int i = bid * NTHR + tid; i < 2 * 96 * 128; i += nb * NTHR) { const int l = i / (96 * 128), r = i % (96 * 128);
        *(v4u*)(a.ws + (l ? WS_W1 : WS_W0) + WO_WIN + (size_t)(416 * 1024) * 2 + (size_t)r * 16) = (v4u){0u, 0u, 0u, 0u}; }
    for (int l = 0; l < 2; ++l) norm_rows(a.in[1], a.in[17] + l * DM, (bf16*)(a.ws + WS_MEMN + l * 4 * MiB), MEMT, bid, nb);
    norm_rows(a.in[0], a.in[3], (bf16*)(a.ws + WS_H), T, bid, nb);
}

__device__ __forceinline__ void ph_mempost(const Args& a, int bid, int nb) {
    const int tid = pg8::opaque_tid(), lane = tid & 63, wave = tid >> 6;
    const int gw = bid * NWAVES + wave, ngw = nb * NWAVES;
    for (int it = gw; it < 2 * MEMT * 4; it += ngw) {
        const int l = it / (MEMT * 4), r = (it / 4) % MEMT, h = it & 3, b = r >> 8, m = r & 255;
        const bf16* kv = (const bf16*)(a.ws + WS_KVRAW + l * 4 * MiB) + (size_t)r * 1024;
        const unsigned ku = *(const unsigned*)(kv + h * 128 + 2 * lane);
        const float k0 = bflo(ku), k1 = bfhi(ku);
        const float rstd = 1.0f / sqrtf(wave_sum(k0 * k0 + k1 * k1) * (1.f / 128.f) + EPS);
        const float* kg = a.in[20] + l * 128;
        bf16* mk = (bf16*)(a.ws + WS_MEMK + l * 2 * MiB) + ((size_t)(b * 4 + h) * 256 + m) * 128;
        *(unsigned*)(mk + 2 * lane) = cvt_pk_bf16(k0 * rstd * kg[2 * lane], k1 * rstd * kg[2 * lane + 1]);
        const unsigned vu = *(const unsigned*)(kv + 512 + h * 128 + 2 * lane);
        bf16* mv = (bf16*)(a.ws + WS_MEMVT + l * 2 * MiB) + ((size_t)(b * 4 + h) * 128 + 2 * lane) * 256 + m;
        mv[0] = (bf16)(vu & 0xffffu); mv[256] = (bf16)(vu >> 16);
    }
}

__device__ __forceinline__ void ph_p2(const Args& a, int l, LAS unsigned char* lds, int bid, int nb) {
    const int tid = pg8::opaque_tid(), lane = tid & 63, w = tid >> 6, c16 = lane & 15, q4 = lane >> 4;
    const bf16* MIX = (const bf16*)(a.ws + WS_MIX);
    const unsigned char* wb = a.ws + (l ? WS_W1 : WS_W0);
    const bf16* WuqT = (const bf16*)(wb + WO_WUQ); const bf16* WukvT = (const bf16*)(wb + WO_WUKV);
    const float* cqg = a.in[5] + l * 256; const float* ckvg = a.in[6] + l * 128; const float* qg = a.in[9] + l * 96; const float* kg = a.in[10] + l * 96;
    const int* pos = (const int*)a.in[2];
    bf16* Qb = (bf16*)(a.ws + WS_Q); bf16* Kb = (bf16*)(a.ws + WS_K); bf16* Vtb = (bf16*)(a.ws + WS_VT);
    constexpr int AQ_LD = 264, AKV_LD = 136;
    LAS bf16* Aq = (LAS bf16*)lds; LAS bf16* Akv = (LAS bf16*)(lds + 33792);
    LAS float* kr = (LAS float*)(lds + 51200); LAS float* cs = (LAS float*)(lds + 59392); LAS float* sn = (LAS float*)(lds + 63488);
    for (int u = bid; u < T / 64; u += nb) {
        const int t0 = u * 64;
        __syncthreads();
        {
            const int row = tid >> 3, part = tid & 7;
            const bf16* src = MIX + (size_t)(t0 + row) * MIXW;
            v4u x[4]; float ss = 0.f;
#pragma unroll
            for (int i = 0; i < 4; ++i) { x[i] = *(const v4u*)(src + MC_CQ + part * 32 + i * 8);
                ss += bflo(x[i].x) * bflo(x[i].x) + bfhi(x[i].x) * bfhi(x[i].x) + bflo(x[i].y) * bflo(x[i].y) + bfhi(x[i].y) * bfhi(x[i].y)
                    + bflo(x[i].z) * bflo(x[i].z) + bfhi(x[i].z) * bfhi(x[i].z) + bflo(x[i].w) * bflo(x[i].w) + bfhi(x[i].w) * bfhi(x[i].w); }
            ss += __shfl_xor(ss, 1); ss += __shfl_xor(ss, 2); ss += __shfl_xor(ss, 4);
            float rstd = 1.0f / sqrtf(ss * (1.f / 256.f) + EPS);
#pragma unroll
            for (int i = 0; i < 4; ++i) { const float* gp = cqg + part * 32 + i * 8; v4u o;
                o.x = cvt_pk_bf16(bflo(x[i].x) * rstd * gp[0], bfhi(x[i].x) * rstd * gp[1]); o.y = cvt_pk_bf16(bflo(x[i].y) * rstd * gp[2], bfhi(x[i].y) * rstd * gp[3]);
                o.z = cvt_pk_bf16(bflo(x[i].z) * rstd * gp[4], bfhi(x[i].z) * rstd * gp[5]); o.w = cvt_pk_bf16(bflo(x[i].w) * rstd * gp[6], bfhi(x[i].w) * rstd * gp[7]);
                *(LAS v4u*)(Aq + row * AQ_LD + part * 32 + i * 8) = o; }
            v4u y[2]; ss = 0.f;
#pragma unroll
            for (int i = 0; i < 2; ++i) { y[i] = *(const v4u*)(src + MC_CKV + part * 16 + i * 8);
                ss += bflo(y[i].x) * bflo(y[i].x) + bfhi(y[i].x) * bfhi(y[i].x) + bflo(y[i].y) * bflo(y[i].y) + bfhi(y[i].y) * bfhi(y[i].y)
                    + bflo(y[i].z) * bflo(y[i].z) + bfhi(y[i].z) * bfhi(y[i].z) + bflo(y[i].w) * bflo(y[i].w) + bfhi(y[i].w) * bfhi(y[i].w); }
            ss += __shfl_xor(ss, 1); ss += __shfl_xor(ss, 2); ss += __shfl_xor(ss, 4);
            rstd = 1.0f / sqrtf(ss * (1.f / 128.f) + EPS);
#pragma unroll
            for (int i = 0; i < 2; ++i) { const float* gp = ckvg + part * 16 + i * 8; v4u o;
                o.x = cvt_pk_bf16(bflo(y[i].x) * rstd * gp[0], bfhi(y[i].x) * rstd * gp[1]); o.y = cvt_pk_bf16(bflo(y[i].y) * rstd * gp[2], bfhi(y[i].y) * rstd * gp[3]);
                o.z = cvt_pk_bf16(bflo(y[i].z) * rstd * gp[4], bfhi(y[i].z) * rstd * gp[5]); o.w = cvt_pk_bf16(bflo(y[i].w) * rstd * gp[6], bfhi(y[i].w) * rstd * gp[7]);
                *(LAS v4u*)(Akv + row * AKV_LD + part * 16 + i * 8) = o; }
            const v2u z = *(const v2u*)(src + MC_KR + part * 4);
            kr[row * 32 + part * 4 + 0] = bflo(z.x); kr[row * 32 + part * 4 + 1] = bfhi(z.x); kr[row * 32 + part * 4 + 2] = bflo(z.y); kr[row * 32 + part * 4 + 3] = bfhi(z.y);
#pragma unroll
            for (int i = 0; i < 2; ++i) { const int e = tid * 2 + i, r = e >> 4, f = e & 15;
                const float invf = exp2f(-(float)f * (13.287712379549449f / 16.0f));
                const float ang = (float)pos[t0 + r] * invf; float sv, cv; sincosf(ang, &sv, &cv); cs[e] = cv; sn[e] = sv; }
        }
        __syncthreads();
        const int h = w;
        {
            f32x4 acc[4][6];
#pragma unroll
            for (int mt = 0; mt < 4; ++mt)
#pragma unroll
                for (int nt = 0; nt < 6; ++nt) acc[mt][nt] = (f32x4){0.f, 0.f, 0.f, 0.f};
#pragma unroll 1
            for (int ks = 0; ks < 8; ++ks) {
                bf16x8 tf[4];
#pragma unroll
                for (int mt = 0; mt < 4; ++mt) tf[mt] = as_bf8(*(const LAS v4u*)(Aq + (mt * 16 + c16) * AQ_LD + ks * 32 + 8 * q4));
#pragma unroll
                for (int nt = 0; nt < 6; ++nt) {
                    const bf16x8 wf = as_bf8(*(const v4u*)(WuqT + (size_t)(h * 96 + nt * 16 + c16) * 256 + ks * 32 + 8 * q4));
#pragma unroll
                    for (int mt = 0; mt < 4; ++mt) acc[mt][nt] = mfma16(wf, tf[mt], acc[mt][nt]);
                }
            }
#pragma unroll
            for (int mt = 0; mt < 4; ++mt) {
                float ss = 0.f;
#pragma unroll
                for (int nt = 0; nt < 6; ++nt) ss += acc[mt][nt][0] * acc[mt][nt][0] + acc[mt][nt][1] * acc[mt][nt][1] + acc[mt][nt][2] * acc[mt][nt][2] + acc[mt][nt][3] * acc[mt][nt][3];
                ss += __shfl_xor(ss, 16); ss += __shfl_xor(ss, 32);
                const float rstd = 1.0f / sqrtf(ss * (1.f / 96.f) + EPS);
                const int r = mt * 16 + c16, t = t0 + r, b = t >> 11, s = t & 2047;
                bf16* qrow = Qb + ((size_t)(b * 8 + h) * SEQ + s) * 96;
#pragma unroll
                for (int nt = 0; nt < 4; ++nt) { const float* gp = qg + nt * 16 + 4 * q4; v2u o;
                    o.x = cvt_pk_bf16(acc[mt][nt][0] * rstd * gp[0], acc[mt][nt][1] * rstd * gp[1]); o.y = cvt_pk_bf16(acc[mt][nt][2] * rstd * gp[2], acc[mt][nt][3] * rstd * gp[3]);
                    *(v2u*)(qrow + nt * 16 + 4 * q4) = o; }
                float o1[4], o2[4];
#pragma unroll
                for (int j = 0; j < 4; ++j) { const int f = 4 * q4 + j; const float x1 = acc[mt][4][j] * rstd * qg[64 + f], x2 = acc[mt][5][j] * rstd * qg[80 + f];
                    const float cv = cs[r * 16 + f], sv = sn[r * 16 + f]; o1[j] = x1 * cv - x2 * sv; o2[j] = x1 * sv + x2 * cv; }
                v2u p1, p2; p1.x = cvt_pk_bf16(o1[0], o1[1]); p1.y = cvt_pk_bf16(o1[2], o1[3]); p2.x = cvt_pk_bf16(o2[0], o2[1]); p2.y = cvt_pk_bf16(o2[2], o2[3]);
                *(v2u*)(qrow + 64 + 4 * q4) = p1; *(v2u*)(qrow + 80 + 4 * q4) = p2;
            }
        }
        __builtin_amdgcn_sched_barrier(0);
        {
            f32x4 acc[4][4];
#pragma unroll
            for (int mt = 0; mt < 4; ++mt)
#pragma unroll
                for (int nt = 0; nt < 4; ++nt) acc[mt][nt] = (f32x4){0.f, 0.f, 0.f, 0.f};
#pragma unroll 1
            for (int ks = 0; ks < 4; ++ks) {
                bf16x8 tf[4];
#pragma unroll
                for (int mt = 0; mt < 4; ++mt) tf[mt] = as_bf8(*(const LAS v4u*)(Akv + (mt * 16 + c16) * AKV_LD + ks * 32 + 8 * q4));
#pragma unroll
                for (int nt = 0; nt < 4; ++nt) {
                    const bf16x8 wf = as_bf8(*(const v4u*)(WukvT + (size_t)(h * 128 + nt * 16 + c16) * 128 + ks * 32 + 8 * q4));
#pragma unroll
                    for (int mt = 0; mt < 4; ++mt) acc[mt][nt] = mfma16(wf, tf[mt], acc[mt][nt]);
                }
            }
#pragma unroll
            for (int mt = 0; mt < 4; ++mt) {
                const int r = mt * 16 + c16, t = t0 + r, b = t >> 11, s = t & 2047;
                float kr1[4], kr2[4]; float ss = 0.f;
#pragma unroll
                for (int j = 0; j < 4; ++j) { kr1[j] = kr[r * 32 + 4 * q4 + j]; kr2[j] = kr[r * 32 + 16 + 4 * q4 + j]; ss += kr1[j] * kr1[j] + kr2[j] * kr2[j]; }
#pragma unroll
                for (int nt = 0; nt < 4; ++nt) ss += acc[mt][nt][0] * acc[mt][nt][0] + acc[mt][nt][1] * acc[mt][nt][1] + acc[mt][nt][2] * acc[mt][nt][2] + acc[mt][nt][3] * acc[mt][nt][3];
                ss += __shfl_xor(ss, 16); ss += __shfl_xor(ss, 32);
                const float rstd = 1.0f / sqrtf(ss * (1.f / 96.f) + EPS);
                bf16* krow = Kb + ((size_t)(b * 8 + h) * SEQ + s) * 96;
#pragma unroll
                for (int nt = 0; nt < 4; ++nt) { const float* gp = kg + nt * 16 + 4 * q4; v2u o;
                    o.x = cvt_pk_bf16(acc[mt][nt][0] * rstd * gp[0], acc[mt][nt][1] * rstd * gp[1]); o.y = cvt_pk_bf16(acc[mt][nt][2] * rstd * gp[2], acc[mt][nt][3] * rstd * gp[3]);
                    *(v2u*)(krow + nt * 16 + 4 * q4) = o; }
                float o1[4], o2[4];
#pragma unroll
                for (int j = 0; j < 4; ++j) { const int f = 4 * q4 + j; const float x1 = kr1[j] * rstd * kg[64 + f], x2 = kr2[j] * rstd * kg[80 + f];
                    const float cv = cs[r * 16 + f], sv = sn[r * 16 + f]; o1[j] = x1 * cv - x2 * sv; o2[j] = x1 * sv + x2 * cv; }
                v2u p1, p2; p1.x = cvt_pk_bf16(o1[0], o1[1]); p1.y = cvt_pk_bf16(o1[2], o1[3]); p2.x = cvt_pk_bf16(o2[0], o2[1]); p2.y = cvt_pk_bf16(o2[2], o2[3]);
                *(v2u*)(krow + 64 + 4 * q4) = p1; *(v2u*)(krow + 80 + 4 * q4) = p2;
            }
        }
        __builtin_amdgcn_sched_barrier(0);
        {
            f32x4 acc[4][4];
#pragma unroll
            for (int mt = 0; mt < 4; ++mt)
#pragma unroll
                for (int nt = 0; nt < 4; ++nt) acc[mt][nt] = (f32x4){0.f, 0.f, 0.f, 0.f};
#pragma unroll 1
            for (int ks = 0; ks < 4; ++ks) {
                bf16x8 tf[4];
#pragma unroll
                for (int mt = 0; mt < 4; ++mt) tf[mt] = as_bf8(*(const LAS v4u*)(Akv + (mt * 16 + c16) * AKV_LD + ks * 32 + 8 * q4));
#pragma unroll
                for (int nt = 0; nt < 4; ++nt) {
                    const bf16x8 wf = as_bf8(*(const v4u*)(WukvT + (size_t)(h * 128 + 64 + nt * 16 + c16) * 128 + ks * 32 + 8 * q4));
#pragma unroll
                    for (int mt = 0; mt < 4; ++mt) acc[mt][nt] = mfma16(wf, tf[mt], acc[mt][nt]);
                }
            }
#pragma unroll
            for (int mt = 0; mt < 4; ++mt) {
                const int r = mt * 16 + c16, t = t0 + r, b = t >> 11, s = t & 2047;
                bf16* vcol = Vtb + (size_t)(b * 8 + h) * 64 * SEQ + s;
#pragma unroll
                for (int nt = 0; nt < 4; ++nt)
#pragma unroll
                    for (int j = 0; j < 4; ++j) { const int d = nt * 16 + 4 * q4 + j; vcol[(size_t)d * SEQ] = (bf16)(cvt_pk_bf16(acc[mt][nt][j], 0.f) & 0xffffu); }
            }
        }
    }
}
template <int DQK, int DV, bool CAUSAL, bool QNORM>
__device__ __forceinline__ void attn_block(LAS unsigned char* lds, const bf16* Qp, int qpitch, const float* qg, const bf16* Kp, const bf16* Vtp, int vpitch,
                                           int nkt, int row0seq, float scale_log2, bf16* Gp, int gpitch) {
    constexpr int KS = DQK / 32, DT = DV / 16, KROW = DQK + 8, VROW = 72, KBUF = 64 * KROW * 2, VBUF = DV * VROW * 2;
    constexpr int NKC = 8 * DQK, NVC = 8 * DV, KPT = (NKC + NTHR - 1) / NTHR, VPT = (NVC + NTHR - 1) / NTHR;
    static_assert(2 * KBUF + 2 * VBUF <= 131072, "attention LDS");
    const int tid = pg8::opaque_tid(), lane = tid & 63, w = tid >> 6, c16 = lane & 15, q4 = lane >> 4;
    __syncthreads();
    bf16x8 qf[2][KS];
    {
        v4u raw[2][KS];
#pragma unroll
        for (int qt = 0; qt < 2; ++qt)
#pragma unroll
            for (int ks = 0; ks < KS; ++ks) raw[qt][ks] = *(const v4u*)(Qp + (size_t)(32 * w + 16 * qt + c16) * qpitch + ks * 32 + 8 * q4);
        if (QNORM) {
#pragma unroll
            for (int qt = 0; qt < 2; ++qt) {
                float ss = 0.f;
#pragma unroll
                for (int ks = 0; ks < KS; ++ks) { const v4u x = raw[qt][ks];
                    ss += bflo(x.x) * bflo(x.x) + bfhi(x.x) * bfhi(x.x) + bflo(x.y) * bflo(x.y) + bfhi(x.y) * bfhi(x.y) + bflo(x.z) * bflo(x.z) + bfhi(x.z) * bfhi(x.z) + bflo(x.w) * bflo(x.w) + bfhi(x.w) * bfhi(x.w); }
                ss += __shfl_xor(ss, 16); ss += __shfl_xor(ss, 32);
                const float rstd = 1.0f / sqrtf(ss * (1.f / DQK) + EPS);
#pragma unroll
                for (int ks = 0; ks < KS; ++ks) { const v4u x = raw[qt][ks]; const float* gp = qg + ks * 32 + 8 * q4; v4u o;
                    o.x = cvt_pk_bf16(bflo(x.x) * rstd * gp[0], bfhi(x.x) * rstd * gp[1]); o.y = cvt_pk_bf16(bflo(x.y) * rstd * gp[2], bfhi(x.y) * rstd * gp[3]);
                    o.z = cvt_pk_bf16(bflo(x.z) * rstd * gp[4], bfhi(x.z) * rstd * gp[5]); o.w = cvt_pk_bf16(bflo(x.w) * rstd * gp[6], bfhi(x.w) * rstd * gp[7]);
                    raw[qt][ks] = o; }
            }
        }
#pragma unroll
        for (int qt = 0; qt < 2; ++qt)
#pragma unroll
            for (int ks = 0; ks < KS; ++ks) qf[qt][ks] = as_bf8(raw[qt][ks]);
    }
    v4u kreg[KPT], vreg[VPT];
#define ATT_GLOAD(kt) do { \
    _Pragma("unroll") for (int i = 0; i < KPT; ++i) { const int ch = tid + i * NTHR; if (ch < NKC) kreg[i] = *(const v4u*)(Kp + (size_t)(kt) * 64 * DQK + (size_t)ch * 8); } \
    _Pragma("unroll") for (int i = 0; i < VPT; ++i) { const int ch = tid + i * NTHR; if (ch < NVC) vreg[i] = *(const v4u*)(Vtp + (size_t)(ch >> 3) * vpitch + (kt) * 64 + (ch & 7) * 8); } } while (0)
#define ATT_LSTORE(buf) do { \
    _Pragma("unroll") for (int i = 0; i < KPT; ++i) { const int ch = tid + i * NTHR; if (ch < NKC) *(LAS v4u*)(lds + (buf) * KBUF + (ch / (DQK / 8)) * (KROW * 2) + (ch % (DQK / 8)) * 16) = kreg[i]; } \
    _Pragma("unroll") for (int i = 0; i < VPT; ++i) { const int ch = tid + i * NTHR; if (ch < NVC) *(LAS v4u*)(lds + 2 * KBUF + (buf) * VBUF + (ch >> 3) * (VROW * 2) + (ch & 7) * 16) = vreg[i]; } } while (0)
    ATT_GLOAD(0); ATT_LSTORE(0);
    __syncthreads();
    float m_run[2] = {-1e30f, -1e30f}, l_run[2] = {0.f, 0.f};
    f32x4 o[DT][2];
#pragma unroll
    for (int dt = 0; dt < DT; ++dt) { o[dt][0] = (f32x4){0.f, 0.f, 0.f, 0.f}; o[dt][1] = (f32x4){0.f, 0.f, 0.f, 0.f}; }
    const int rw0 = row0seq + 32 * w;
    for (int kt = 0; kt < nkt; ++kt) {
        if (kt + 1 < nkt) ATT_GLOAD(kt + 1);
        const int k0 = kt * 64;
        const bool active = !CAUSAL || (k0 <= rw0 + 31);
        if (active) {
            const LAS unsigned char* kb = lds + (kt & 1) * KBUF; const LAS unsigned char* vb = lds + 2 * KBUF + (kt & 1) * VBUF;
            f32x4 s[4][2];
#pragma unroll
            for (int kk = 0; kk < 4; ++kk) { s[kk][0] = (f32x4){0.f, 0.f, 0.f, 0.f}; s[kk][1] = (f32x4){0.f, 0.f, 0.f, 0.f}; }
#pragma unroll
            for (int kk = 0; kk < 4; ++kk)
#pragma unroll
                for (int ks = 0; ks < KS; ++ks) { const bf16x8 kf = as_bf8(*(const LAS v4u*)(kb + (kk * 16 + c16) * (KROW * 2) + (ks * 32 + 8 * q4) * 2));
                    s[kk][0] = mfma16(kf, qf[0][ks], s[kk][0]); s[kk][1] = mfma16(kf, qf[1][ks], s[kk][1]); }
            const bool needmask = CAUSAL && (k0 + 63 > rw0);
            bf16x8 pf[2][2];
#pragma unroll
            for (int qt = 0; qt < 2; ++qt) {
                const int rowi = rw0 + 16 * qt + c16;
                float tmax = -INFINITY;
#pragma unroll
                for (int kk = 0; kk < 4; ++kk)
#pragma unroll
                    for (int j = 0; j < 4; ++j) { float v = s[kk][qt][j] * scale_log2;
                        if (needmask) { const int key = k0 + kk * 16 + 4 * q4 + j; v = (key > rowi) ? -INFINITY : v; }
                        s[kk][qt][j] = v; tmax = fmaxf(tmax, v); }
                tmax = fmaxf(tmax, __shfl_xor(tmax, 16)); tmax = fmaxf(tmax, __shfl_xor(tmax, 32));
                const float mnew = fmaxf(m_run[qt], tmax), alpha = __builtin_amdgcn_exp2f(m_run[qt] - mnew);
                m_run[qt] = mnew;
                float psum = 0.f;
#pragma unroll
                for (int kk = 0; kk < 4; ++kk)
#pragma unroll
                    for (int j = 0; j < 4; ++j) { const float p = __builtin_amdgcn_exp2f(s[kk][qt][j] - mnew); s[kk][qt][j] = p; psum += p; }
                l_run[qt] = l_run[qt] * alpha + psum;
#pragma unroll
                for (int dt = 0; dt < DT; ++dt) o[dt][qt] = o[dt][qt] * alpha;
#pragma unroll
                for (int kp = 0; kp < 2; ++kp) { v4u pp;
                    pp.x = cvt_pk_bf16(s[2 * kp][qt][0], s[2 * kp][qt][1]); pp.y = cvt_pk_bf16(s[2 * kp][qt][2], s[2 * kp][qt][3]);
                    pp.z = cvt_pk_bf16(s[2 * kp + 1][qt][0], s[2 * kp + 1][qt][1]); pp.w = cvt_pk_bf16(s[2 * kp + 1][qt][2], s[2 * kp + 1][qt][3]);
                    pf[qt][kp] = as_bf8(pp); }
            }
#pragma unroll
            for (int dt = 0; dt < DT; ++dt)
#pragma unroll
                for (int kp = 0; kp < 2; ++kp) {
                    const LAS unsigned char* vp = vb + (dt * 16 + c16) * (VROW * 2) + (32 * kp + 4 * q4) * 2;
                    const v2u a0 = *(const LAS v2u*)vp, a1 = *(const LAS v2u*)(vp + 32);
                    const bf16x8 vf = as_bf8((v4u){a0.x, a0.y, a1.x, a1.y});
                    o[dt][0] = mfma16(vf, pf[0][kp], o[dt][0]); o[dt][1] = mfma16(vf, pf[1][kp], o[dt][1]);
                }
        }
        if (kt + 1 < nkt) ATT_LSTORE((kt + 1) & 1);
        __syncthreads();
    }
#undef ATT_GLOAD
#undef ATT_LSTORE
#pragma unroll
    for (int qt = 0; qt < 2; ++qt) {
        float lt = l_run[qt]; lt += __shfl_xor(lt, 16); lt += __shfl_xor(lt, 32);
        const float inv = 1.0f / lt;
        bf16* gr = Gp + (size_t)(32 * w + 16 * qt + c16) * gpitch + 4 * q4;
#pragma unroll
        for (int dt = 0; dt < DT; ++dt) { const v2u g = *(const v2u*)(gr + dt * 16); v2u r;
            r.x = cvt_pk_bf16(o[dt][qt][0] * inv * bflo(g.x), o[dt][qt][1] * inv * bfhi(g.x)); r.y = cvt_pk_bf16(o[dt][qt][2] * inv * bflo(g.y), o[dt][qt][3] * inv * bfhi(g.y));
            *(v2u*)(gr + dt * 16) = r; }
    }
}

__device__ __forceinline__ void ph_mla(const Args& a, LAS unsigned char* lds, int bid, int nb) {
    const bf16* Qb = (const bf16*)(a.ws + WS_Q); const bf16* Kb = (const bf16*)(a.ws + WS_K); const bf16* Vtb = (const bf16*)(a.ws + WS_VT); bf16* G = (bf16*)(a.ws + WS_G);
    const float sc = 0.10206207261596577f * 1.4426950408889634f;
    for (int u = bid; u < 256; u += nb) {
        const int b = u >> 5, h = (u >> 2) & 7, p = u & 3;
        for (int half = 0; half < 2; ++half) {
            const int jb = half ? p : 7 - p;
            const size_t bh = (size_t)(b * 8 + h);
            attn_block<96, 64, true, false>(lds, Qb + (bh * SEQ + 256 * jb) * 96, 96, nullptr, Kb + bh * SEQ * 96, Vtb + bh * 64 * SEQ, SEQ, 4 * (jb + 1), 256 * jb, sc,
                                            G + (size_t)(b * SEQ + 256 * jb) * GW + h * 64, GW);
        }
    }
}
__device__ __forceinline__ void ph_memattn(const Args& a, int l, LAS unsigned char* lds, int bid, int nb) {
    const bf16* MIX = (const bf16*)(a.ws + WS_MIX); bf16* G = (bf16*)(a.ws + WS_G);
    const bf16* mk = (const bf16*)(a.ws + WS_MEMK + l * 2 * MiB); const bf16* mv = (const bf16*)(a.ws + WS_MEMVT + l * 2 * MiB);
    const float sc = 0.08838834764831845f * 1.4426950408889634f;
    for (int u = bid; u < 256; u += nb) {
        const int tb = u >> 2, h = u & 3, t0 = tb * 256, b = t0 >> 11;
        attn_block<128, 128, false, true>(lds, MIX + (size_t)t0 * MIXW + MC_MQ + h * 128, MIXW, a.in[19] + l * 128, mk + (size_t)(b * 4 + h) * 256 * 128, mv + (size_t)(b * 4 + h) * 128 * 256, 256,
                                          4, 0, sc, G + (size_t)t0 * GW + 3 * 512 + h * 128, GW);
    }
}

__device__ __forceinline__ void ph_sg(const Args& a, int l, LAS unsigned char* lds, int bid, int nb) {
    const int tid = pg8::opaque_tid(), lane = tid & 63, w = tid >> 6, c16 = lane & 15, q4 = lane >> 4;
    const bf16* MIX = (const bf16*)(a.ws + WS_MIX); bf16* G = (bf16*)(a.ws + WS_G);
    const float* lng = a.in[13] + l * 512; const float* lnb = a.in[14] + l * 512; const float* ws_ = a.in[15] + (size_t)l * 4 * 128 * 128; const float* bs = a.in[16] + l * 4 * 128;
    LAS float* stat = (LAS float*)lds; LAS bf16* vT = (LAS bf16*)(lds + 1024); constexpr int VLD = 136;
    for (int u = bid; u < 512; u += nb) {
        const int c = u >> 2, g = u & 3, t0 = c * 128;
        __syncthreads();
        {   const int row = tid >> 2, part = tid & 3; const bf16* src = MIX + (size_t)(t0 + row) * MIXW + MC_V + part * 128;
            float s1 = 0.f, s2 = 0.f;
#pragma unroll 4
            for (int i = 0; i < 16; ++i) { const v4u x = *(const v4u*)(src + i * 8);
                const float f0 = bflo(x.x), f1 = bfhi(x.x), f2 = bflo(x.y), f3 = bfhi(x.y), f4 = bflo(x.z), f5 = bfhi(x.z), f6 = bflo(x.w), f7 = bfhi(x.w);
                s1 += ((f0 + f1) + (f2 + f3)) + ((f4 + f5) + (f6 + f7)); s2 += ((f0 * f0 + f1 * f1) + (f2 * f2 + f3 * f3)) + ((f4 * f4 + f5 * f5) + (f6 * f6 + f7 * f7)); }
            s1 += __shfl_xor(s1, 1); s1 += __shfl_xor(s1, 2); s2 += __shfl_xor(s2, 1); s2 += __shfl_xor(s2, 2);
            const float mean = s1 * (1.f / 512.f), var = fmaxf(s2 * (1.f / 512.f) - mean * mean, 0.f);
            if (part == 0) { stat[row * 2] = mean; stat[row * 2 + 1] = 1.0f / sqrtf(var + EPS); }
        }
        __syncthreads();
        {   const int s = tid & 127, dq = tid >> 7; const bf16* src = MIX + (size_t)(t0 + s) * MIXW + MC_V + g * 128 + dq * 32;
            const float mean = stat[s * 2], rstd = stat[s * 2 + 1];
#pragma unroll
            for (int i = 0; i < 4; ++i) { const v4u x = *(const v4u*)(src + i * 8); const int d0 = dq * 32 + i * 8; const float* gp = lng + g * 128 + d0; const float* bp = lnb + g * 128 + d0;
                float f[8] = {bflo(x.x), bfhi(x.x), bflo(x.y), bfhi(x.y), bflo(x.z), bfhi(x.z), bflo(x.w), bfhi(x.w)};
#pragma unroll
                for (int e = 0; e < 8; ++e) { const float y = (f[e] - mean) * rstd * gp[e] + bp[e]; vT[(d0 + e) * VLD + s] = (bf16)(cvt_pk_bf16(y, 0.f) & 0xffffu); } }
        }
        __syncthreads();
        {   f32x4 acc[8];
#pragma unroll
            for (int nt = 0; nt < 8; ++nt) acc[nt] = (f32x4){0.f, 0.f, 0.f, 0.f};
            const int tt = 16 * w + c16, nks = (w >> 1) + 1;
            const float* wrow = ws_ + ((size_t)g * 128 + tt) * 128;
            for (int ks = 0; ks < nks; ++ks) {
                const int s0 = ks * 32 + 8 * q4;
                const f32x4 w0 = *(const f32x4*)(wrow + s0), w1 = *(const f32x4*)(wrow + s0 + 4);
                float wv[8] = {w0[0], w0[1], w0[2], w0[3], w1[0], w1[1], w1[2], w1[3]};
#pragma unroll
                for (int e = 0; e < 8; ++e) wv[e] = (s0 + e <= tt) ? wv[e] : 0.f;
                v4u wp; wp.x = cvt_pk_bf16(wv[0], wv[1]); wp.y = cvt_pk_bf16(wv[2], wv[3]); wp.z = cvt_pk_bf16(wv[4], wv[5]); wp.w = cvt_pk_bf16(wv[6], wv[7]);
                const bf16x8 bfrag = as_bf8(wp);
#pragma unroll
                for (int nt = 0; nt < 8; ++nt) { const bf16x8 af = as_bf8(*(const LAS v4u*)(vT + (nt * 16 + c16) * VLD + s0)); acc[nt] = mfma16(af, bfrag, acc[nt]); }
            }
            const int t = t0 + tt; const float bias = bs[g * 128 + tt];
            const bf16* up = MIX + (size_t)t * MIXW + MC_U + g * 128 + 4 * q4; bf16* gp = G + (size_t)t * GW + 2 * 512 + g * 128 + 4 * q4;
#pragma unroll
            for (int nt = 0; nt < 8; ++nt) { const v2u uu = *(const v2u*)(up + nt * 16), gg = *(const v2u*)(gp + nt * 16); v2u r;
                r.x = cvt_pk_bf16(bflo(uu.x) * (acc[nt][0] + bias) * bflo(gg.x), bfhi(uu.x) * (acc[nt][1] + bias) * bfhi(gg.x));
                r.y = cvt_pk_bf16(bflo(uu.y) * (acc[nt][2] + bias) * bflo(gg.y), bfhi(uu.y) * (acc[nt][3] + bias) * bfhi(gg.y));
                *(v2u*)(gp + nt * 16) = r; }
        }
    }
}

__device__ __forceinline__ void ph_conv(const Args& a, int l, int bid, int nb) {
    const bf16* MIX = (const bf16*)(a.ws + WS_MIX); bf16* G = (bf16*)(a.ws + WS_G);
    const float* cw = a.in[11] + l * 3 * 512; const float* cb = a.in[12] + l * 512;
    for (int idx = bid * NTHR + pg8::opaque_tid(); idx < T * 64; idx += nb * NTHR) {
        const int t = idx >> 6, c = (idx & 63) * 8, s = t & 2047;
        const bf16* row = MIX + (size_t)t * MIXW;
        const v4u bg = *(const v4u*)(row + MC_BG + c);
        float z[3][8];
#pragma unroll
        for (int d = 0; d < 3; ++d) {
            if (s - d >= 0) { const v4u cgv = *(const v4u*)(row - (size_t)d * MIXW + MC_CG + c), xv = *(const v4u*)(row - (size_t)d * MIXW + MC_XIN + c);
                z[d][0] = bflo(cgv.x) * bflo(xv.x); z[d][1] = bfhi(cgv.x) * bfhi(xv.x); z[d][2] = bflo(cgv.y) * bflo(xv.y); z[d][3] = bfhi(cgv.y) * bfhi(xv.y);
                z[d][4] = bflo(cgv.z) * bflo(xv.z); z[d][5] = bfhi(cgv.z) * bfhi(xv.z); z[d][6] = bflo(cgv.w) * bflo(xv.w); z[d][7] = bfhi(cgv.w) * bfhi(xv.w); }
            else {
#pragma unroll
                for (int e = 0; e < 8; ++e) z[d][e] = 0.f; }
        }
        bf16* gp = G + (size_t)t * GW + 512 + c; const v4u gg = *(const v4u*)gp;
        const float bgf[8] = {bflo(bg.x), bfhi(bg.x), bflo(bg.y), bfhi(bg.y), bflo(bg.z), bfhi(bg.z), bflo(bg.w), bfhi(bg.w)};
        const float ggf[8] = {bflo(gg.x), bfhi(gg.x), bflo(gg.y), bfhi(gg.y), bflo(gg.z), bfhi(gg.z), bflo(gg.w), bfhi(gg.w)};
        float y[8];
#pragma unroll
        for (int e = 0; e < 8; ++e) y[e] = bgf[e] * (cb[c + e] + cw[c + e] * z[2][e] + cw[512 + c + e] * z[1][e] + cw[1024 + c + e] * z[0][e]) * ggf[e];
        v4u r; r.x = cvt_pk_bf16(y[0], y[1]); r.y = cvt_pk_bf16(y[2], y[3]); r.z = cvt_pk_bf16(y[4], y[5]); r.w = cvt_pk_bf16(y[6], y[7]);
        *(v4u*)gp = r;
    }
}
#ifndef MK_PER_PHASE
#define MK_PER_PHASE 0
#endif
constexpr int NPH = 3 + 8 + 7;
__global__ void __launch_bounds__(NTHR, 2) mk_fwd(Args a) {
    extern __shared__ __attribute__((aligned(16))) unsigned char lds_raw[];
    LAS unsigned char* lds = (LAS unsigned char*)lds_raw;
    cg::grid_group grid = cg::this_grid();
    const int bid = blockIdx.x, nb = gridDim.x;
    const int lo = a.ph_lo, hi = a.ph_hi;
    bf16* H = (bf16*)(a.ws + WS_H); bf16* MIX = (bf16*)(a.ws + WS_MIX); bf16* G = (bf16*)(a.ws + WS_G); bf16* GATE = (bf16*)(a.ws + WS_GATE); bf16* MERGED = (bf16*)(a.ws + WS_MERGED);
#define IN(k) (lo <= (k) && (k) < hi)
#define SEAM(k) do { if (IN((k) + 1)) grid.sync(); } while (0)
    if (IN(0)) { ph_prologue(a, lds, bid, nb); SEAM(0); }
    if (IN(1)) {
        for (int l = 0; l < 2; ++l) {
            pg8::Gemm g{(const bf16*)(a.ws + WS_MEMN + l * 4 * MiB), DM, (const bf16*)(a.ws + WS_WMEMT + l * 2 * MiB), MEMT, 1024, DM};
            pg8::StaticOrder S; S.init(MEMT, 1024, nb, (bid + 128 * l) % nb);
            pg8::EpiAct<0> E{(bf16*)(a.ws + WS_KVRAW + l * 4 * MiB), 1024, 1 << 20, nullptr, 0, nullptr};
            pg8::gemm_phase<pg8::EpiAct<0>, pg8::StaticOrder, true, true>(lds, g, S, E);
        }
        SEAM(1);
    }
    if (IN(2)) { ph_mempost(a, bid, nb); SEAM(2); }
    for (int l = 0; l < 2; ++l) {
        const int base = 3 + 8 * l;
        const unsigned char* wb = a.ws + (l ? WS_W1 : WS_W0);
        const bf16* WinT = (const bf16*)(wb + WO_WIN);
        const float* xl = l ? a.out : a.in[0];
        if (IN(base + 0)) {
            pg8::Gemm g{H, DM, WinT, T, NA, DM};
            pg8::StaticOrder S; S.init(T, NA, nb, bid);
            pg8::EpiAct<1> E{MIX, MIXW, 14, G, GW, nullptr};
            pg8::gemm_phase<pg8::EpiAct<1>, pg8::StaticOrder, true, true>(lds, g, S, E);
            SEAM(base + 0);
        }
        if (IN(base + 1)) {
#ifndef SKIP_P2
 ph_p2(a, l, lds, bid, nb);
#endif
 SEAM(base + 1); }
        if (IN(base + 2)) {
#ifndef SKIP_MLA
 ph_mla(a, lds, bid, nb);
#endif
#ifndef SKIP_MEM
 ph_memattn(a, l, lds, bid, nb);
#endif
#ifndef SKIP_SG
 ph_sg(a, l, lds, bid, nb);
#endif
#ifndef SKIP_CONV
 ph_conv(a, l, bid, nb);
#endif
 __syncthreads(); SEAM(base + 2); }
        if (IN(base + 3)) { norm_rows(xl, a.in[3] + l * DM, H, T, bid, nb); SEAM(base + 3); }
        if (IN(base + 4)) {
            pg8::Gemm g{H, DM, WinT + (size_t)NA * DM, T, GATEW, DM};
            pg8::StaticOrder S; S.init(T, GATEW, nb, bid);
            pg8::EpiAct<2> E{nullptr, 0, 0, GATE, GATEW, a.in[21] + l * 4096};
            pg8::gemm_phase<pg8::EpiAct<2>, pg8::StaticOrder, true, true>(lds, g, S, E);
            SEAM(base + 4);
        }
        if (IN(base + 5)) {
            pg8::Gemm g{G, GW, (const bf16*)(wb + WO_WBR), T, DM, 2048};
            pg8::StaticOrder S; S.init(T, DM, nb, bid);
            pg8::EpiGate E{GATE, MERGED};
#ifndef SKIP_P4
            pg8::gemm_phase<pg8::EpiGate, pg8::StaticOrder, false, true>(lds, g, S, E);
#endif
            SEAM(base + 5);
        }
        if (IN(base + 6)) {
            pg8::Gemm g{MERGED, DM, (const bf16*)(wb + WO_WOUT), T, DM, DM};
            pg8::StaticOrder S; S.init(T, DM, nb, bid);
            pg8::EpiRes E{xl, a.out, DM};
            pg8::gemm_phase<pg8::EpiRes, pg8::StaticOrder, false, true>(lds, g, S, E);
            if (l == 0) SEAM(base + 6);
        }
        if (l == 0 && IN(base + 7)) { norm_rows(a.out, a.in[3] + DM, H, T, bid, nb); SEAM(base + 7); }
    }
#undef IN
#undef SEAM
}

extern "C" void kernel_launch(void* const* d_in, const int* in_sizes, int n_in, void* d_out, int out_size, void* d_ws, size_t ws_size, hipStream_t stream) {
    static int grid = 0;
    if (grid == 0) {
        if (n_in != 24 || out_size != T * DM || ws_size < WS_END) { fprintf(stderr, "kernel_launch: unexpected problem (n_in %d out %d ws %zu)\n", n_in, out_size, ws_size); grid = -1; return; }
        int dev = 0, cus = 0, per_cu = 0;
        hipGetDevice(&dev); hipDeviceGetAttribute(&cus, hipDeviceAttributeMultiprocessorCount, dev);
        if (hipFuncSetAttribute((const void*)mk_fwd, hipFuncAttributeMaxDynamicSharedMemorySize, LDS_BYTES) != hipSuccess) { fprintf(stderr, "kernel_launch: hipFuncSetAttribute failed\n"); grid = -1; return; }
        if (hipOccupancyMaxActiveBlocksPerMultiprocessor(&per_cu, (const void*)mk_fwd, NTHR, LDS_BYTES) != hipSuccess || per_cu < 1) { fprintf(stderr, "kernel_launch: occupancy query says %d\n", per_cu); per_cu = 1; }
        (void)hipGetLastError();
        grid = cus;
    }
    if (grid < 0) return;
    Args a{};
    for (int i = 0; i < 24; ++i) a.in[i] = (const float*)d_in[i];
    a.out = (float*)d_out; a.ws = (unsigned char*)d_ws;
#if MK_PER_PHASE
    for (int p = 0; p < NPH; ++p) { a.ph_lo = p; a.ph_hi = p + 1; void* args[] = {&a};
        hipError_t e = hipLaunchCooperativeKernel((void*)mk_fwd, dim3(grid), dim3(NTHR), args, LDS_BYTES, stream);
        if (e != hipSuccess) { fprintf(stderr, "launch %d failed: %s\n", p, hipGetErrorString(e)); break; } }
#else
    a.ph_lo = 0; a.ph_hi = NPH; void* args[] = {&a};
    hipError_t e = hipLaunchCooperativeKernel((void*)mk_fwd, dim3(grid), dim3(NTHR), args, LDS_BYTES, stream);
    if (e != hipSuccess) fprintf(stderr, "cooperative launch failed: %s (grid %d)\n", hipGetErrorString(e), grid);
#endif
}
```

```cpp
#include <hip/hip_runtime.h>
#include <hip/hip_cooperative_groups.h>
#include <cstdio>
#include <cstdint>
namespace cg = cooperative_groups;
namespace pg8 {
#define PG8_LAS __attribute__((address_space(3)))
typedef unsigned short bf16_t;
typedef short bf16x8 __attribute__((ext_vector_type(8)));
typedef float f32x4 __attribute__((ext_vector_type(4)));
typedef unsigned u32x4 __attribute__((ext_vector_type(4)));
constexpr int BM = 256, BK = 64, HALF = 128, HTB = HALF * BK * 2  , STAGE_BYTES = 8 * HTB, NXCD = 8, WGM = 8;

__host__ __device__ __forceinline__ int lds_byte(int r, int c) { const int st = (r >> 4) * 2 + (c >> 5), rr = r & 15, cc = c & 31, ob = rr * 64 + cc * 2; return st * 1024 + (ob ^ (((ob >> 9) & 1) << 5)); }
__host__ __device__ __forceinline__ void stage_rc(int b, int& R, int& C) { const int st = b / 1024, sb = b % 1024, swz = sb ^ (((sb >> 9) & 1) << 5); R = (st >> 1) * 16 + swz / 64; C = (st & 1) * 32 + (swz % 64) / 2; }
__host__ __device__ __forceinline__ int perm32(int rho) { const int n = rho >> 4, i = rho & 15; return 8 * (i >> 2) + 4 * n + (i & 3); }

struct Unit { int pm, pn; };
struct Gemm { const bf16_t* A; int lda; const bf16_t* Bt; int M, N, K; };

struct StaticOrder {
    int nM, nN, nwg, G, c;
    __host__ __device__ void init(int M, int N, int G_, int c_) { nM = M / BM; nN = N / BM; nwg = nM * nN; G = G_; c = c_; }
    __host__ __device__ bool next(int i, Unit& u) const {
        const long L = (long)i * G + c; if (L >= nwg) return false;
        int wgid = (int)L; { const int q = nwg / NXCD, r = nwg % NXCD, xcd = wgid % NXCD, off = wgid / NXCD; wgid = (xcd < r ? xcd * (q + 1) : r * (q + 1) + (xcd - r) * q) + off; }
        const int nig = WGM * nN, gid = wgid / nig, fm = gid * WGM, gsz = (nM - fm) < WGM ? (nM - fm) : WGM;
        u.pm = fm + ((wgid % nig) % gsz); u.pn = (wgid % nig) / gsz; return true;
    }
    __device__ __forceinline__ void a_ready(const Unit&) const {}
    __device__ __forceinline__ void done(const Unit&) const {}
};

__device__ __forceinline__ unsigned cvt_pk_bf16(float lo, float hi) { unsigned r; asm volatile("v_cvt_pk_bf16_f32 %0, %1, %2" : "=v"(r) : "v"(lo), "v"(hi)); return r; }
__device__ __forceinline__ int opaque_tid() { int t = threadIdx.x; asm volatile("" : "+v"(t)); return t; }
__device__ __forceinline__ float bflo(unsigned u) { return __uint_as_float(u << 16); }
__device__ __forceinline__ float bfhi(unsigned u) { return __uint_as_float(u & 0xffff0000u); }
__device__ __forceinline__ float sigm(float x) { return __builtin_amdgcn_rcpf(1.0f + __expf(-x)); }

template <int ACT> struct EpiAct {
    static constexpr bool PERM = true, AFTER_DRAIN = false, HAS_MID = false;
    bf16_t* O0; int ld0; int npn0; bf16_t* O1; int ld1; const float* bias;
    __device__ __forceinline__ void operator()(const f32x4 (&acc)[2][2][4][2], const Unit& u, int wr, int wc, int fr, int fq) const {
        const int row0 = u.pm * BM + wr * 64 + fr;
        const bool second = (u.pn >= npn0);
        bf16_t* base = second ? O1 : O0; const int ld = second ? ld1 : ld0; const int colt = second ? (u.pn - npn0) * BM : u.pn * BM;
        const int col0 = colt + wc * 32 + 8 * fq;
#pragma unroll
        for (int bj = 0; bj < 2; ++bj) {
            f32x4 b0 = (f32x4){0.f, 0.f, 0.f, 0.f}, b1 = b0;
            if (ACT == 2) { b0 = *(const f32x4*)(bias + col0 + bj * HALF); b1 = *(const f32x4*)(bias + col0 + bj * HALF + 4); }
#pragma unroll
            for (int ai = 0; ai < 2; ++ai)
#pragma unroll
                for (int m = 0; m < 4; ++m) {
                    bf16_t* rowp = base + (size_t)(row0 + ai * HALF + m * 16) * ld + col0 + bj * HALF;
                    f32x4 v0 = acc[ai][bj][m][0], v1 = acc[ai][bj][m][1];
                    if (ACT != 0 && second) {
#pragma unroll
                        for (int e = 0; e < 4; ++e) {
                            if (ACT == 1) { v0[e] = v0[e] * sigm(v0[e]); v1[e] = v1[e] * sigm(v1[e]); }
                            if (ACT == 2) { v0[e] = sigm(v0[e] + b0[e]); v1[e] = sigm(v1[e] + b1[e]); }
                        }
                    }
                    u32x4 w; w.x = cvt_pk_bf16(v0[0], v0[1]); w.y = cvt_pk_bf16(v0[2], v0[3]); w.z = cvt_pk_bf16(v1[0], v1[1]); w.w = cvt_pk_bf16(v1[2], v1[3]);
                    *(u32x4*)rowp = w;
                }
        }
    }
};

struct EpiGate {
    static constexpr bool PERM = true, AFTER_DRAIN = false, HAS_MID = true;
    const bf16_t* GATE; bf16_t* O;
    __device__ __forceinline__ void mid(f32x4 (&acc)[2][2][4][2], const Unit& u, int nb, int wr, int wc, int fr_, int fq_) const {
        int fr = fr_, fq = fq_; asm volatile("" : "+v"(fr), "+v"(fq));
        const int row0 = u.pm * BM + wr * 64 + fr, col0 = u.pn * BM + wc * 32 + 8 * fq;
#pragma unroll
        for (int ai = 0; ai < 2; ++ai)
#pragma unroll
            for (int m = 0; m < 4; ++m)
#pragma unroll
                for (int bj = 0; bj < 2; ++bj) {
                    const bf16_t* gp = GATE + (size_t)(row0 + ai * HALF + m * 16) * 4096 + (nb - 1) * 1024 + col0 + bj * HALF;
                    const u32x4 a = *(const u32x4*)gp, b = *(const u32x4*)(gp + 1024);
                    f32x4 r0, r1;
                    r0[0] = bflo(a.x) * __builtin_amdgcn_rcpf(bflo(b.x)); r0[1] = bfhi(a.x) * __builtin_amdgcn_rcpf(bfhi(b.x));
                    r0[2] = bflo(a.y) * __builtin_amdgcn_rcpf(bflo(b.y)); r0[3] = bfhi(a.y) * __builtin_amdgcn_rcpf(bfhi(b.y));
                    r1[0] = bflo(a.z) * __builtin_amdgcn_rcpf(bflo(b.z)); r1[1] = bfhi(a.z) * __builtin_amdgcn_rcpf(bfhi(b.z));
                    r1[2] = bflo(a.w) * __builtin_amdgcn_rcpf(bflo(b.w)); r1[3] = bfhi(a.w) * __builtin_amdgcn_rcpf(bfhi(b.w));
                    acc[ai][bj][m][0] = acc[ai][bj][m][0] * r0; acc[ai][bj][m][1] = acc[ai][bj][m][1] * r1;
                    __builtin_amdgcn_sched_barrier(0);
                }
    }
    __device__ __forceinline__ void operator()(const f32x4 (&acc)[2][2][4][2], const Unit& u, int wr, int wc, int fr, int fq) const {
        const int row0 = u.pm * BM + wr * 64 + fr, col0 = u.pn * BM + wc * 32 + 8 * fq;
#pragma unroll
        for (int ai = 0; ai < 2; ++ai)
#pragma unroll
            for (int m = 0; m < 4; ++m)
#pragma unroll
                for (int bj = 0; bj < 2; ++bj) {
                    const size_t r = (size_t)(row0 + ai * HALF + m * 16);
                    const u32x4 a = *(const u32x4*)(GATE + r * 4096 + 3 * 1024 + col0 + bj * HALF);
                    const f32x4 v0 = acc[ai][bj][m][0], v1 = acc[ai][bj][m][1];
                    u32x4 w; w.x = cvt_pk_bf16(v0[0] * bflo(a.x), v0[1] * bfhi(a.x)); w.y = cvt_pk_bf16(v0[2] * bflo(a.y), v0[3] * bfhi(a.y));
                    w.z = cvt_pk_bf16(v1[0] * bflo(a.z), v1[1] * bfhi(a.z)); w.w = cvt_pk_bf16(v1[2] * bflo(a.w), v1[3] * bfhi(a.w));
                    *(u32x4*)(O + r * 1024 + col0 + bj * HALF) = w;
                    __builtin_amdgcn_sched_barrier(0);
                }
    }
};

struct EpiRes {
    static constexpr bool PERM = false, AFTER_DRAIN = false, HAS_MID = false;
    const float* base; float* out; int ldc;
    __device__ __forceinline__ void operator()(const f32x4 (&acc)[2][2][4][2], const Unit& u, int wr, int wc, int fr, int fq) const {
        const int row0 = u.pm * BM + wr * 64 + fr, col0 = u.pn * BM + wc * 32 + 4 * fq;
#pragma unroll
        for (int ai = 0; ai < 2; ++ai)
#pragma unroll
            for (int m = 0; m < 4; ++m)
#pragma unroll
                for (int bj = 0; bj < 2; ++bj)
#pragma unroll
                    for (int n = 0; n < 2; ++n) {
                        const size_t o = (size_t)(row0 + ai * HALF + m * 16) * ldc + col0 + bj * HALF + 16 * n;
                        const f32x4 x = *(const f32x4*)(base + o);
                        *(f32x4*)(out + o) = x + acc[ai][bj][m][n];
                    }
    }
};
template <class Epi, class Sched, bool ALIGN_EPI = false, bool SP2 = false>
__device__ __forceinline__ void gemm_phase(PG8_LAS unsigned char* lds, const Gemm g, const Sched& S, const Epi& E) {
    const int tid = pg8::opaque_tid(), wid = __builtin_amdgcn_readfirstlane(tid >> 6), lane = tid & 63, wr = wid >> 2, wc = wid & 3, fr = lane & 15, fq = lane >> 4;
    const int K = g.K, nt = K / BK;
    unsigned voffA[2], voffB[2];
#pragma unroll
    for (int i = 0; i < 2; ++i) { int R, C; stage_rc(tid * 16 + i * 8192, R, C); const int Rb = Epi::PERM ? ((R & ~31) + perm32(R & 31)) : R;
        voffA[i] = (unsigned)(R * g.lda + C) * 2u; voffB[i] = (unsigned)(Rb * K + C) * 2u; }
    const size_t kstep = (size_t)(BK * 2);
    const size_t hstepA = (size_t)HALF * g.lda * 2, hstepB = (size_t)HALF * K * 2;
    const size_t tstepA = 2 * hstepA, tstepB = 2 * hstepB;
    const unsigned ldsw = (unsigned)wid * 1024u;
    const int aoff = lds_byte(wr * 64 + fr, fq * 8), boff = lds_byte(wc * 32 + fr, fq * 8);
#define PG8_SA(b, h) (((b) * 2 + (h)) * HTB)
#define PG8_SB(b, h) ((4 + (b) * 2 + (h)) * HTB)
#define PG8_STAGE(bufoff, gbase, voff) do { _Pragma("unroll") for (int _i = 0; _i < 2; ++_i) \
        __builtin_amdgcn_global_load_lds((const unsigned*)((const char*)(gbase) + (voff)[_i]), (PG8_LAS unsigned*)(lds + (bufoff) + ldsw + _i * 8192), 16, 0, 0); } while (0)
#define PG8_LDA(dst, b, h) do { _Pragma("unroll") for (int m = 0; m < 4; ++m) _Pragma("unroll") for (int k = 0; k < 2; ++k) dst[m][k] = *(const PG8_LAS bf16x8*)(lds + PG8_SA(b, h) + aoff + m * 2048 + k * 1024); } while (0)
#define PG8_LDB(dst, b, h) do { _Pragma("unroll") for (int n = 0; n < 2; ++n) _Pragma("unroll") for (int k = 0; k < 2; ++k) dst[n][k] = *(const PG8_LAS bf16x8*)(lds + PG8_SB(b, h) + boff + n * 2048 + k * 1024); } while (0)
#define PG8_MMA(ai, bj, At, Bt) do { __builtin_amdgcn_s_setprio(1); _Pragma("unroll") for (int m = 0; m < 4; ++m) _Pragma("unroll") for (int n = 0; n < 2; ++n) _Pragma("unroll") for (int k = 0; k < 2; ++k) \
        acc[ai][bj][m][n] = __builtin_amdgcn_mfma_f32_16x16x32_bf16(Bt[n][k], At[m][k], acc[ai][bj][m][n], 0, 0, 0); __builtin_amdgcn_s_setprio(0); } while (0)
#define PG8_WAIT_V(n) asm volatile("s_waitcnt vmcnt(" #n ")" ::: "memory")
#define PG8_WAIT_L(n) asm volatile("s_waitcnt lgkmcnt(" #n ")" ::: "memory")
#define PG8_BAR __builtin_amdgcn_s_barrier()
#define PG8_SCHED __builtin_amdgcn_sched_barrier(0)
    Unit cur, nxt; int ui = 0;
    if (!S.next(0, cur)) return;
    f32x4 acc[2][2][4][2];
#pragma unroll
    for (int a = 0; a < 2; ++a)
#pragma unroll
        for (int b = 0; b < 2; ++b)
#pragma unroll
            for (int m = 0; m < 4; ++m)
#pragma unroll
                for (int n = 0; n < 2; ++n) acc[a][b][m][n] = (f32x4){0.f, 0.f, 0.f, 0.f};
    bf16x8 At[4][2], B0[2][2], B1[2][2];
    const char* cA = (const char*)g.A + (size_t)cur.pm * tstepA; const char* cB = (const char*)g.Bt + (size_t)cur.pn * tstepB;
    S.a_ready(cur);
    if constexpr (SP2) {
        PG8_STAGE(PG8_SB(0, 0), cB, voffB); PG8_STAGE(PG8_SB(0, 1), cB + hstepB, voffB); PG8_STAGE(PG8_SA(0, 0), cA, voffA); PG8_STAGE(PG8_SA(0, 1), cA + hstepA, voffA);
        if (wr == 1) PG8_BAR;
        PG8_WAIT_V(2); PG8_BAR;
        PG8_STAGE(PG8_SB(1, 0), cB + kstep, voffB); PG8_STAGE(PG8_SA(1, 0), cA + kstep, voffA); PG8_STAGE(PG8_SB(1, 1), cB + hstepB + kstep, voffB);
        PG8_WAIT_V(6); PG8_BAR;
    } else {
        PG8_STAGE(PG8_SB(0, 0), cB, voffB); PG8_STAGE(PG8_SA(0, 0), cA, voffA); PG8_STAGE(PG8_SB(0, 1), cB + hstepB, voffB); PG8_STAGE(PG8_SA(0, 1), cA + hstepA, voffA);
        if (wr == 1) PG8_BAR;
        PG8_WAIT_V(4); PG8_BAR;
        PG8_STAGE(PG8_SB(1, 0), cB + kstep, voffB); PG8_STAGE(PG8_SA(1, 0), cA + kstep, voffA); PG8_STAGE(PG8_SB(1, 1), cB + hstepB + kstep, voffB);
        PG8_WAIT_V(6); PG8_BAR;
    }
    for (;;) {
        const bool has_next = S.next(ui + 1, nxt);
        const char* nA = has_next ? (const char*)g.A + (size_t)nxt.pm * tstepA : cA; const char* nB = has_next ? (const char*)g.Bt + (size_t)nxt.pn * tstepB : cB;
        for (int t = 0; t < nt; t += 2) {
            if constexpr (Epi::HAS_MID) { if (t != 0 && (t & 7) == 0) E.mid(acc, cur, t >> 3, wr, wc, fr, fq); }
            const bool last = (t == nt - 2);
            const char* a1 = cA + (size_t)(t + 1) * kstep;
            const char* a2 = last ? nA : cA + (size_t)(t + 2) * kstep; const char* b2 = last ? nB : cB + (size_t)(t + 2) * kstep;
            const char* a3 = a2 + kstep; const char* b3 = b2 + kstep;
            if (last && has_next) S.a_ready(nxt);
            if constexpr (SP2) {
            PG8_LDB(B0, 0, 0); PG8_LDB(B1, 0, 1); PG8_SCHED; PG8_LDA(At, 0, 0); PG8_STAGE(PG8_SA(1, 1), a1 + hstepA, voffA);
            PG8_WAIT_V(8); PG8_WAIT_L(0); PG8_BAR; PG8_MMA(0, 0, At, B0); PG8_MMA(0, 1, At, B1); PG8_BAR; PG8_SCHED;
            PG8_LDA(At, 0, 1); PG8_STAGE(PG8_SB(0, 0), b2, voffB); PG8_STAGE(PG8_SB(0, 1), b2 + hstepB, voffB); PG8_STAGE(PG8_SA(0, 0), a2, voffA);
            PG8_WAIT_V(8); PG8_WAIT_L(0); PG8_BAR; PG8_MMA(1, 0, At, B0); PG8_MMA(1, 1, At, B1); PG8_BAR; PG8_SCHED;
            PG8_LDB(B0, 1, 0); PG8_LDB(B1, 1, 1); PG8_SCHED; PG8_LDA(At, 1, 0); PG8_STAGE(PG8_SA(0, 1), a2 + hstepA, voffA);
            PG8_WAIT_V(8); PG8_WAIT_L(0); PG8_BAR; PG8_MMA(0, 0, At, B0); PG8_MMA(0, 1, At, B1); PG8_BAR; PG8_SCHED;
            PG8_LDA(At, 1, 1); PG8_STAGE(PG8_SB(1, 0), b3, voffB); PG8_STAGE(PG8_SB(1, 1), b3 + hstepB, voffB); PG8_STAGE(PG8_SA(1, 0), a3, voffA);
            PG8_WAIT_V(8); PG8_WAIT_L(0); PG8_BAR; PG8_MMA(1, 0, At, B0); PG8_MMA(1, 1, At, B1); PG8_BAR; PG8_SCHED;
            } else {
            PG8_LDB(B0, 0, 0); PG8_SCHED; PG8_LDA(At, 0, 0); PG8_STAGE(PG8_SA(1, 1), a1 + hstepA, voffA);
            PG8_WAIT_L(8); PG8_BAR; PG8_WAIT_L(0); PG8_MMA(0, 0, At, B0); PG8_BAR; PG8_SCHED;
            PG8_LDB(B1, 0, 1); PG8_STAGE(PG8_SB(0, 0), b2, voffB);
            PG8_BAR; PG8_WAIT_L(0); PG8_MMA(0, 1, At, B1); PG8_BAR;
            PG8_LDA(At, 0, 1); PG8_STAGE(PG8_SA(0, 0), a2, voffA);
            PG8_BAR; PG8_WAIT_L(0); PG8_MMA(1, 0, At, B0); PG8_BAR; PG8_SCHED;
            PG8_STAGE(PG8_SB(0, 1), b2 + hstepB, voffB);
            PG8_WAIT_V(6); PG8_BAR; PG8_MMA(1, 1, At, B1); PG8_BAR;
            PG8_LDB(B0, 1, 0); PG8_SCHED; PG8_LDA(At, 1, 0); PG8_STAGE(PG8_SA(0, 1), a2 + hstepA, voffA);
            PG8_WAIT_L(8); PG8_BAR; PG8_WAIT_L(0); PG8_MMA(0, 0, At, B0); PG8_BAR; PG8_SCHED;
            PG8_LDB(B1, 1, 1); PG8_STAGE(PG8_SB(1, 0), b3, voffB);
            PG8_BAR; PG8_WAIT_L(0); PG8_MMA(0, 1, At, B1); PG8_BAR;
            PG8_LDA(At, 1, 1); PG8_STAGE(PG8_SA(1, 0), a3, voffA);
            PG8_BAR; PG8_WAIT_L(0); PG8_MMA(1, 0, At, B0); PG8_BAR; PG8_SCHED;
            PG8_STAGE(PG8_SB(1, 1), b3 + hstepB, voffB);
            PG8_WAIT_V(6); PG8_BAR; PG8_MMA(1, 1, At, B1); PG8_BAR;
            }
        }
        if constexpr (ALIGN_EPI) { if (wr == 0) PG8_BAR; }
        if constexpr (!Epi::AFTER_DRAIN) { E(acc, cur, wr, wc, fr, fq); S.done(cur); }
        if (!has_next) break;
#pragma unroll
        for (int a = 0; a < 2; ++a)
#pragma unroll
            for (int b = 0; b < 2; ++b)
#pragma unroll
                for (int m = 0; m < 4; ++m)
#pragma unroll
                    for (int n = 0; n < 2; ++n) acc[a][b][m][n] = (f32x4){0.f, 0.f, 0.f, 0.f};
        cur = nxt; cA = nA; cB = nB; ++ui;
        if constexpr (ALIGN_EPI) { if (wr == 1) PG8_BAR; }
    }
    PG8_WAIT_V(0);
    if constexpr (!ALIGN_EPI) { if (wr == 0) PG8_BAR; }
    PG8_BAR;
    if constexpr (Epi::AFTER_DRAIN) { E.fused(acc, cur, wr, wc, fr, fq, lds, wid, lane); S.done(cur); }
#undef PG8_SA
#undef PG8_SB
#undef PG8_STAGE
#undef PG8_LDA
#undef PG8_LDB
#undef PG8_MMA
#undef PG8_WAIT_V
#undef PG8_WAIT_L
#undef PG8_BAR
#undef PG8_SCHED
}
}
constexpr int NWAVES = 8, NTHR = 512;
constexpr int BATCH = 8, SEQ = 2048, DM = 1024, T = BATCH * SEQ, DEPTH = 2, MEML = 256, MEMT = BATCH * MEML;
constexpr int INW = 9632, INWP = 9728, NA = 5632  , MIXW = 3584, GW = 2048, GATEW = 4096;
constexpr float EPS = 1e-6f;
constexpr int MC_CQ = 0, MC_CKV = 256, MC_KR = 384, MC_BG = 512, MC_CG = 1024, MC_XIN = 1536, MC_U = 2048, MC_V = 2560, MC_MQ = 3072;
constexpr size_t MiB = 1u << 20;
constexpr size_t WS_W0 = 1 * MiB, WS_W1 = 275 * MiB;
constexpr size_t WO_WIN = 0, WO_WUQ = 19 * MiB, WO_WUKV = WO_WUQ + 768 * 256 * 2, WO_WBR = WO_WUKV + 1024 * 128 * 2, WO_WOUT = WO_WBR + 4 * MiB, WO_END = WO_WOUT + 2 * MiB;
static_assert(WO_END <= 26 * MiB, "weights");
constexpr size_t WS_MEMK = 27 * MiB, WS_MEMVT = 31 * MiB;
constexpr size_t WS_MIX = 35 * MiB, WS_GATE = 35 * MiB;
constexpr size_t WS_Q = 147 * MiB, WS_K = 171 * MiB, WS_VT = 195 * MiB, WS_H = 179 * MiB, WS_MERGED = 179 * MiB;
constexpr size_t WS_WMEMT = 147 * MiB, WS_MEMN = 151 * MiB, WS_KVRAW = 159 * MiB;
constexpr size_t WS_G = 211 * MiB, WS_END = 301 * MiB;
constexpr int LDS_BYTES = 147456;

#define LAS __attribute__((address_space(3)))
typedef unsigned short bf16;
typedef unsigned v4u __attribute__((ext_vector_type(4)));
typedef unsigned v2u __attribute__((ext_vector_type(2)));
typedef float f32x4 __attribute__((ext_vector_type(4)));
typedef short bf16x8 __attribute__((ext_vector_type(8)));
using pg8::cvt_pk_bf16; using pg8::bflo; using pg8::bfhi; using pg8::sigm;

__device__ __forceinline__ float wave_sum(float v) {
#pragma unroll
    for (int o = 1; o < 64; o <<= 1) v += __shfl_xor(v, o);
    return v;
}
__device__ __forceinline__ f32x4 mfma16(bf16x8 a, bf16x8 b, f32x4 c) { return __builtin_amdgcn_mfma_f32_16x16x32_bf16(a, b, c, 0, 0, 0); }
__device__ __forceinline__ bf16x8 as_bf8(v4u v) { return __builtin_bit_cast(bf16x8, v); }

struct Args { const float* in[24]; float* out; unsigned char* ws; int ph_lo, ph_hi; };

__device__ __forceinline__ void tr_item(const float* W, int K, int N, bf16* WT, int ldt, int coff, int win, LAS float* scr, int item, int lane) {
    const int nblk = N / 32, kb = item / nblk, nb = item % nblk, k0 = 64 * kb, n0 = 32 * nb;
    const int radd = (win && n0 >= 416) ? 96 : 0;
#pragma unroll 8
    for (int i = 0; i < 32; ++i) { const int kk = 2 * i + (lane >> 5); scr[kk * 33 + (lane & 31)] = W[(size_t)(k0 + kk) * N + n0 + (lane & 31)]; }
    asm volatile("s_waitcnt lgkmcnt(0)" ::: "memory");
    const int c = lane & 7;
#pragma unroll
    for (int j = 0; j < 4; ++j) { const int n = (lane >> 3) + 8 * j; const LAS float* s = scr + (8 * c) * 33 + n;
        v4u o; o.x = cvt_pk_bf16(s[0 * 33], s[1 * 33]); o.y = cvt_pk_bf16(s[2 * 33], s[3 * 33]); o.z = cvt_pk_bf16(s[4 * 33], s[5 * 33]); o.w = cvt_pk_bf16(s[6 * 33], s[7 * 33]);
        *(v4u*)(WT + (size_t)(radd + n0 + n) * ldt + coff + k0 + 8 * c) = o; }
    asm volatile("s_waitcnt lgkmcnt(0)" ::: "memory");
}
__device__ __forceinline__ void rms_row(const float* xrow, const float* g, bf16* orow, int lane) {
    const f32x4* xr = (const f32x4*)xrow + lane; const f32x4* gr = (const f32x4*)g + lane;
    f32x4 v[4]; float s = 0.f;
#pragma unroll
    for (int j = 0; j < 4; ++j) { v[j] = xr[64 * j]; s += (v[j].x * v[j].x + v[j].y * v[j].y) + (v[j].z * v[j].z + v[j].w * v[j].w); }
    const float rstd = 1.0f / sqrtf(wave_sum(s) * (1.f / 1024.f) + EPS);
    v2u* o8 = (v2u*)orow + lane;
#pragma unroll
    for (int j = 0; j < 4; ++j) { const f32x4 gg = gr[64 * j]; v2u o; o.x = cvt_pk_bf16(v[j].x * rstd * gg.x, v[j].y * rstd * gg.y); o.y = cvt_pk_bf16(v[j].z * rstd * gg.z, v[j].w * rstd * gg.w); o8[64 * j] = o; }
}
__device__ __forceinline__ void norm_rows(const float* x, const float* g, bf16* H, int rows, int bid, int nb) {
    const int tid = pg8::opaque_tid(), lane = tid & 63, gw = bid * NWAVES + (tid >> 6), ngw = nb * NWAVES;
    for (int m = gw; m < rows; m += ngw) rms_row(x + (size_t)m * DM, g, H + (size_t)m * DM, lane);
}

__device__ __forceinline__ void ph_prologue(const Args& a, LAS unsigned char* lds, int bid, int nb) {
    const int tid = pg8::opaque_tid(), lane = tid & 63, wave = tid >> 6;
    LAS float* scr = (LAS float*)(lds + wave * 16384);
    const int gw = bid * NWAVES + wave, ngw = nb * NWAVES;
    constexpr int I_IN = 16 * 301, I_UQ = 4 * 24, I_UKV = 2 * 32, I_MEM = 16 * 32, I_BR = 8 * 32, I_OUT = 16 * 32;
    constexpr int PER_L = I_IN + I_UQ + I_UKV + I_MEM + 4 * I_BR + I_OUT;
    for (int it0 = gw; it0 < 2 * PER_L; it0 += ngw) {
        const int l = it0 / PER_L; int r = it0 % PER_L;
        unsigned char* wb = a.ws + (l ? WS_W1 : WS_W0);
        if (r < I_IN) { tr_item(a.in[4] + (size_t)l * DM * INW, DM, INW, (bf16*)(wb + WO_WIN), DM, 0, 1, scr, r, lane); continue; } r -= I_IN;
        if (r < I_UQ) { tr_item(a.in[7] + (size_t)l * 256 * 768, 256, 768, (bf16*)(wb + WO_WUQ), 256, 0, 0, scr, r, lane); continue; } r -= I_UQ;
        if (r < I_UKV) { tr_item(a.in[8] + (size_t)l * 128 * 1024, 128, 1024, (bf16*)(wb + WO_WUKV), 128, 0, 0, scr, r, lane); continue; } r -= I_UKV;
        if (r < I_MEM) { tr_item(a.in[18] + (size_t)l * DM * 1024, DM, 1024, (bf16*)(a.ws + WS_WMEMT + l * 2 * MiB), DM, 0, 0, scr, r, lane); continue; } r -= I_MEM;
        if (r < 4 * I_BR) { const int n = r / I_BR; tr_item(a.in[22] + ((size_t)l * 4 + n) * 512 * DM, 512, DM, (bf16*)(wb + WO_WBR), 2048, n * 512, 0, scr, r % I_BR, lane); continue; } r -= 4 * I_BR;
        tr_item(a.in[23] + (size_t)l * DM * DM, DM, DM, (bf16*)(wb + WO_WOUT), DM, 0, 0, scr, r, lane);
    }
    for (int i = bid * NTHR + tid; i < 2 * 96 * 128; i += nb * NTHR) { const int l = i / (96 * 128), r = i % (96 * 128);
        *(v4u*)(a.ws + (l ? WS_W1 : WS_W0) + WO_WIN + (size_t)(416 * 1024) * 2 + (size_t)r * 16) = (v4u){0u, 0u, 0u, 0u}; }
    for (int l = 0; l < 2; ++l) norm_rows(a.in[1], a.in[17] + l * DM, (bf16*)(a.ws + WS_MEMN + l * 4 * MiB), MEMT, bid, nb);
    norm_rows(a.in[0], a.in[3], (bf16*)(a.ws + WS_H), T, bid, nb);
}

__device__ __forceinline__ void ph_mempost(const Args& a, int bid, int nb) {
    const int tid = pg8::opaque_tid(), lane = tid & 63, wave = tid >> 6;
    const int gw = bid * NWAVES + wave, ngw = nb * NWAVES;
    for (int it = gw; it < 2 * MEMT * 4; it += ngw) {
        const int l = it / (MEMT * 4), r = (it / 4) % MEMT, h = it & 3, b = r >> 8, m = r & 255;
        const bf16* kv = (const bf16*)(a.ws + WS_KVRAW + l * 4 * MiB) + (size_t)r * 1024;
        const unsigned ku = *(const unsigned*)(kv + h * 128 + 2 * lane);
        const float k0 = bflo(ku), k1 = bfhi(ku);
        const float rstd = 1.0f / sqrtf(wave_sum(k0 * k0 + k1 * k1) * (1.f / 128.f) + EPS);
        const float* kg = a.in[20] + l * 128;
        bf16* mk = (bf16*)(a.ws + WS_MEMK + l * 2 * MiB) + ((size_t)(b * 4 + h) * 256 + m) * 128;
        *(unsigned*)(mk + 2 * lane) = cvt_pk_bf16(k0 * rstd * kg[2 * lane], k1 * rstd * kg[2 * lane + 1]);
        const unsigned vu = *(const unsigned*)(kv + 512 + h * 128 + 2 * lane);
        bf16* mv = (bf16*)(a.ws + WS_MEMVT + l * 2 * MiB) + ((size_t)(b * 4 + h) * 128 + 2 * lane) * 256 + m;
        mv[0] = (bf16)(vu & 0xffffu); mv[256] = (bf16)(vu >> 16);
    }
}

__device__ __forceinline__ void ph_p2(const Args& a, int l, LAS unsigned char* lds, int bid, int nb) {
    const int tid = pg8::opaque_tid(), lane = tid & 63, w = tid >> 6, c16 = lane & 15, q4 = lane >> 4;
    const bf16* MIX = (const bf16*)(a.ws + WS_MIX);
    const unsigned char* wb = a.ws + (l ? WS_W1 : WS_W0);
    const bf16* WuqT = (const bf16*)(wb + WO_WUQ); const bf16* WukvT = (const bf16*)(wb + WO_WUKV);
    const float* cqg = a.in[5] + l * 256; const float* ckvg = a.in[6] + l * 128; const float* qg = a.in[9] + l * 96; const float* kg = a.in[10] + l * 96;
    const int* pos = (const int*)a.in[2];
    bf16* Qb = (bf16*)(a.ws + WS_Q); bf16* Kb = (bf16*)(a.ws + WS_K); bf16* Vtb = (bf16*)(a.ws + WS_VT);
    constexpr int AQ_LD = 264, AKV_LD = 136;
    LAS bf16* Aq = (LAS bf16*)lds; LAS bf16* Akv = (LAS bf16*)(lds + 33792);
    LAS float* kr = (LAS float*)(lds + 51200); LAS float* cs = (LAS float*)(lds + 59392); LAS float* sn = (LAS float*)(lds + 63488);
    for (int u = bid; u < T / 64; u += nb) {
        const int t0 = u * 64;
        __syncthreads();
        {
            const int row = tid >> 3, part = tid & 7;
            const bf16* src = MIX + (size_t)(t0 + row) * MIXW;
            v4u x[4]; float ss = 0.f;
#pragma unroll
            for (int i = 0; i < 4; ++i) { x[i] = *(const v4u*)(src + MC_CQ + part * 32 + i * 8);
                ss += bflo(x[i].x) * bflo(x[i].x) + bfhi(x[i].x) * bfhi(x[i].x) + bflo(x[i].y) * bflo(x[i].y) + bfhi(x[i].y) * bfhi(x[i].y)
                    + bflo(x[i].z) * bflo(x[i].z) + bfhi(x[i].z) * bfhi(x[i].z) + bflo(x[i].w) * bflo(x[i].w) + bfhi(x[i].w) * bfhi(x[i].w); }
            ss += __shfl_xor(ss, 1); ss += __shfl_xor(ss, 2); ss += __shfl_xor(ss, 4);
            float rstd = 1.0f / sqrtf(ss * (1.f / 256.f) + EPS);
#pragma unroll
            for (int i = 0; i < 4; ++i) { const float* gp = cqg + part * 32 + i * 8; v4u o;
                o.x = cvt_pk_bf16(bflo(x[i].x) * rstd * gp[0], bfhi(x[i].x) * rstd * gp[1]); o.y = cvt_pk_bf16(bflo(x[i].y) * rstd * gp[2], bfhi(x[i].y) * rstd * gp[3]);
                o.z = cvt_pk_bf16(bflo(x[i].z) * rstd * gp[4], bfhi(x[i].z) * rstd * gp[5]); o.w = cvt_pk_bf16(bflo(x[i].w) * rstd * gp[6], bfhi(x[i].w) * rstd * gp[7]);
                *(LAS v4u*)(Aq + row * AQ_LD + part * 32 + i * 8) = o; }
            v4u y[2]; ss = 0.f;
#pragma unroll
            for (int i = 0; i < 2; ++i) { y[i] = *(const v4u*)(src + MC_CKV + part * 16 + i * 8);
                ss += bflo(y[i].x) * bflo(y[i].x) + bfhi(y[i].x) * bfhi(y[i].x) + bflo(y[i].y) * bflo(y[i].y) + bfhi(y[i].y) * bfhi(y[i].y)
                    + bflo(y[i].z) * bflo(y[i].z) + bfhi(y[i].z) * bfhi(y[i].z) + bflo(y[i].w) * bflo(y[i].w) + bfhi(y[i].w) * bfhi(y[i].w); }
            ss += __shfl_xor(ss, 1); ss += __shfl_xor(ss, 2); ss += __shfl_xor(ss, 4);
            rstd = 1.0f / sqrtf(ss * (1.f / 128.f) + EPS);
#pragma unroll
            for (int i = 0; i < 2; ++i) { const float* gp = ckvg + part * 16 + i * 8; v4u o;
                o.x = cvt_pk_bf16(bflo(y[i].x) * rstd * gp[0], bfhi(y[i].x) * rstd * gp[1]); o.y = cvt_pk_bf16(bflo(y[i].y) * rstd * gp[2], bfhi(y[i].y) * rstd * gp[3]);
                o.z = cvt_pk_bf16(bflo(y[i].z) * rstd * gp[4], bfhi(y[i].z) * rstd * gp[5]); o.w = cvt_pk_bf16(bflo(y[i].w) * rstd * gp[6], bfhi(y[i].w) * rstd * gp[7]);
                *(LAS v4u*)(Akv + row * AKV_LD + part * 16 + i * 8) = o; }
            const v2u z = *(const v2u*)(src + MC_KR + part * 4);
            kr[row * 32 + part * 4 + 0] = bflo(z.x); kr[row * 32 + part * 4 + 1] = bfhi(z.x); kr[row * 32 + part * 4 + 2] = bflo(z.y); kr[row * 32 + part * 4 + 3] = bfhi(z.y);
#pragma unroll
            for (int i = 0; i < 2; ++i) { const int e = tid * 2 + i, r = e >> 4, f = e & 15;
                const float invf = exp2f(-(float)f * (13.287712379549449f / 16.0f));
                const float ang = (float)pos[t0 + r] * invf; float sv, cv; sincosf(ang, &sv, &cv); cs[e] = cv; sn[e] = sv; }
        }
        __syncthreads();
        const int h = w;
        {
            f32x4 acc[4][6];
#pragma unroll
            for (int mt = 0; mt < 4; ++mt)
#pragma unroll
                for (int nt = 0; nt < 6; ++nt) acc[mt][nt] = (f32x4){0.f, 0.f, 0.f, 0.f};
#pragma unroll 1
            for (int ks = 0; ks < 8; ++ks) {
                bf16x8 tf[4];
#pragma unroll
                for (int mt = 0; mt < 4; ++mt) tf[mt] = as_bf8(*(const LAS v4u*)(Aq + (mt * 16 + c16) * AQ_LD + ks * 32 + 8 * q4));
#pragma unroll
                for (int nt = 0; nt < 6; ++nt) {
                    const bf16x8 wf = as_bf8(*(const v4u*)(WuqT + (size_t)(h * 96 + nt * 16 + c16) * 256 + ks * 32 + 8 * q4));
#pragma unroll
                    for (int mt = 0; mt < 4; ++mt) acc[mt][nt] = mfma16(wf, tf[mt], acc[mt][nt]);
                }
            }
#pragma unroll
            for (int mt = 0; mt < 4; ++mt) {
                float ss = 0.f;
#pragma unroll
                for (int nt = 0; nt < 6; ++nt) ss += acc[mt][nt][0] * acc[mt][nt][0] + acc[mt][nt][1] * acc[mt][nt][1] + acc[mt][nt][2] * acc[mt][nt][2] + acc[mt][nt][3] * acc[mt][nt][3];
                ss += __shfl_xor(ss, 16); ss += __shfl_xor(ss, 32);
                const float rstd = 1.0f / sqrtf(ss * (1.f / 96.f) + EPS);
                const int r = mt * 16 + c16, t = t0 + r, b = t >> 11, s = t & 2047;
                bf16* qrow = Qb + ((size_t)(b * 8 + h) * SEQ + s) * 96;
#pragma unroll
                for (int nt = 0; nt < 4; ++nt) { const float* gp = qg + nt * 16 + 4 * q4; v2u o;
                    o.x = cvt_pk_bf16(acc[mt][nt][0] * rstd * gp[0], acc[mt][nt][1] * rstd * gp[1]); o.y = cvt_pk_bf16(acc[mt][nt][2] * rstd * gp[2], acc[mt][nt][3] * rstd * gp[3]);
                    *(v2u*)(qrow + nt * 16 + 4 * q4) = o; }
                float o1[4], o2[4];
#pragma unroll
                for (int j = 0; j < 4; ++j) { const int f = 4 * q4 + j; const float x1 = acc[mt][4][j] * rstd * qg[64 + f], x2 = acc[mt][5][j] * rstd * qg[80 + f];
                    const float cv = cs[r * 16 + f], sv = sn[r * 16 + f]; o1[j] = x1 * cv - x2 * sv; o2[j] = x1 * sv + x2 * cv; }
                v2u p1, p2; p1.x = cvt_pk_bf16(o1[0], o1[1]); p1.y = cvt_pk_bf16(o1[2], o1[3]); p2.x = cvt_pk_bf16(o2[0], o2[1]); p2.y = cvt_pk_bf16(o2[2], o2[3]);
                *(v2u*)(qrow + 64 + 4 * q4) = p1; *(v2u*)(qrow + 80 + 4 * q4) = p2;
            }
        }
        __builtin_amdgcn_sched_barrier(0);
        {
            f32x4 acc[4][4];
#pragma unroll
            for (int mt = 0; mt < 4; ++mt)
#pragma unroll
                for (int nt = 0; nt < 4; ++nt) acc[mt][nt] = (f32x4){0.f, 0.f, 0.f, 0.f};
#pragma unroll 1
            for (int ks = 0; ks < 4; ++ks) {
                bf16x8 tf[4];
#pragma unroll
                for (int mt = 0; mt < 4; ++mt) tf[mt] = as_bf8(*(const LAS v4u*)(Akv + (mt * 16 + c16) * AKV_LD + ks * 32 + 8 * q4));
#pragma unroll
                for (int nt = 0; nt < 4; ++nt) {
                    const bf16x8 wf = as_bf8(*(const v4u*)(WukvT + (size_t)(h * 128 + nt * 16 + c16) * 128 + ks * 32 + 8 * q4));
#pragma unroll
                    for (int mt = 0; mt < 4; ++mt) acc[mt][nt] = mfma16(wf, tf[mt], acc[mt][nt]);
                }
            }
#pragma unroll
            for (int mt = 0; mt < 4; ++mt) {
                const int r = mt * 16 + c16, t = t0 + r, b = t >> 11, s = t & 2047;
                float kr1[4], kr2[4]; float ss = 0.f;
#pragma unroll
                for (int j = 0; j < 4; ++j) { kr1[j] = kr[r * 32 + 4 * q4 + j]; kr2[j] = kr[r * 32 + 16 + 4 * q4 + j]; ss += kr1[j] * kr1[j] + kr2[j] * kr2[j]; }
#pragma unroll
                for (int nt = 0; nt < 4; ++nt) ss += acc[mt][nt][0] * acc[mt][nt][0] + acc[mt][nt][1] * acc[mt][nt][1] + acc[mt][nt][2] * acc[mt][nt][2] + acc[mt][nt][3] * acc[mt][nt][3];
                ss += __shfl_xor(ss, 16); ss += __shfl_xor(ss, 32);
                const float rstd = 1.0f / sqrtf(ss * (1.f / 96.f) + EPS);
                bf16* krow = Kb + ((size_t)(b * 8 + h) * SEQ + s) * 96;
#pragma unroll
                for (int nt = 0; nt < 4; ++nt) { const float* gp = kg + nt * 16 + 4 * q4; v2u o;
                    o.x = cvt_pk_bf16(acc[mt][nt][0] * rstd * gp[0], acc[mt][nt][1] * rstd * gp[1]); o.y = cvt_pk_bf16(acc[mt][nt][2] * rstd * gp[2], acc[mt][nt][3] * rstd * gp[3]);
                    *(v2u*)(krow + nt * 16 + 4 * q4) = o; }
                float o1[4], o2[4];
#pragma unroll
                for (int j = 0; j < 4; ++j) { const int f = 4 * q4 + j; const float x1 = kr1[j] * rstd * kg[64 + f], x2 = kr2[j] * rstd * kg[80 + f];
                    const float cv = cs[r * 16 + f], sv = sn[r * 16 + f]; o1[j] = x1 * cv - x2 * sv; o2[j] = x1 * sv + x2 * cv; }
                v2u p1, p2; p1.x = cvt_pk_bf16(o1[0], o1[1]); p1.y = cvt_pk_bf16(o1[2], o1[3]); p2.x = cvt_pk_bf16(o2[0], o2[1]); p2.y = cvt_pk_bf16(o2[2], o2[3]);
                *(v2u*)(krow + 64 + 4 * q4) = p1; *(v2u*)(krow + 80 + 4 * q4) = p2;
            }
        }
        __builtin_amdgcn_sched_barrier(0);
        {
            f32x4 acc[4][4];
#pragma unroll
            for (int mt = 0; mt < 4; ++mt)
#pragma unroll
                for (int nt = 0; nt < 4; ++nt) acc[mt][nt] = (f32x4){0.f, 0.f, 0.f, 0.f};
#pragma unroll 1
            for (int ks = 0; ks < 4; ++ks) {
                bf16x8 tf[4];
#pragma unroll
                for (int mt = 0; mt < 4; ++mt) tf[mt] = as_bf8(*(const LAS v4u*)(Akv + (mt * 16 + c16) * AKV_LD + ks * 32 + 8 * q4));
#pragma unroll
                for (int nt = 0; nt < 4; ++nt) {
                    const bf16x8 wf = as_bf8(*(const v4u*)(WukvT + (size_t)(h * 128 + 64 + nt * 16 + c16) * 128 + ks * 32 + 8 * q4));
#pragma unroll
                    for (int mt = 0; mt < 4; ++mt) acc[mt][nt] = mfma16(wf, tf[mt], acc[mt][nt]);
                }
            }
#pragma unroll
            for (int mt = 0; mt < 4; ++mt) {
                const int r = mt * 16 + c16, t = t0 + r, b = t >> 11, s = t & 2047;
                bf16* vcol = Vtb + (size_t)(b * 8 + h) * 64 * SEQ + s;
#pragma unroll
                for (int nt = 0; nt < 4; ++nt)
#pragma unroll
                    for (int j = 0; j < 4; ++j) { const int d = nt * 16 + 4 * q4 + j; vcol[(size_t)d * SEQ] = (bf16)(cvt_pk_bf16(acc[mt][nt][j], 0.f) & 0xffffu); }
            }
        }
    }
}
template <int DQK, int DV, bool CAUSAL, bool QNORM>
__device__ __forceinline__ void attn_block(LAS unsigned char* lds, const bf16* Qp, int qpitch, const float* qg, const bf16* Kp, const bf16* Vtp, int vpitch,
                                           int nkt, int row0seq, float scale_log2, bf16* Gp, int gpitch, bool st) {
    constexpr int KS = DQK / 32, DT = DV / 16, KROW = DQK + 8, VROW = 72, KBUF = 64 * KROW * 2, VBUF = DV * VROW * 2;
    constexpr int NKC = 8 * DQK, NVC = 8 * DV, KPT = (NKC + NTHR - 1) / NTHR, VPT = (NVC + NTHR - 1) / NTHR;
    static_assert(2 * KBUF + 2 * VBUF <= 131072, "attention LDS");
    const int tid = pg8::opaque_tid(), lane = tid & 63, w = tid >> 6, c16 = lane & 15, q4 = lane >> 4;
    __syncthreads();
    bf16x8 qf[2][KS];
    {
        v4u raw[2][KS];
#pragma unroll
        for (int qt = 0; qt < 2; ++qt)
#pragma unroll
            for (int ks = 0; ks < KS; ++ks) raw[qt][ks] = *(const v4u*)(Qp + (size_t)(32 * w + 16 * qt + c16) * qpitch + ks * 32 + 8 * q4);
        if (QNORM) {
#pragma unroll
            for (int qt = 0; qt < 2; ++qt) {
                float ss = 0.f;
#pragma unroll
                for (int ks = 0; ks < KS; ++ks) { const v4u x = raw[qt][ks];
                    ss += bflo(x.x) * bflo(x.x) + bfhi(x.x) * bfhi(x.x) + bflo(x.y) * bflo(x.y) + bfhi(x.y) * bfhi(x.y) + bflo(x.z) * bflo(x.z) + bfhi(x.z) * bfhi(x.z) + bflo(x.w) * bflo(x.w) + bfhi(x.w) * bfhi(x.w); }
                ss += __shfl_xor(ss, 16); ss += __shfl_xor(ss, 32);
                const float rstd = 1.0f / sqrtf(ss * (1.f / DQK) + EPS);
#pragma unroll
                for (int ks = 0; ks < KS; ++ks) { const v4u x = raw[qt][ks]; const float* gp = qg + ks * 32 + 8 * q4; v4u o;
                    o.x = cvt_pk_bf16(bflo(x.x) * rstd * gp[0], bfhi(x.x) * rstd * gp[1]); o.y = cvt_pk_bf16(bflo(x.y) * rstd * gp[2], bfhi(x.y) * rstd * gp[3]);
                    o.z = cvt_pk_bf16(bflo(x.z) * rstd * gp[4], bfhi(x.z) * rstd * gp[5]); o.w = cvt_pk_bf16(bflo(x.w) * rstd * gp[6], bfhi(x.w) * rstd * gp[7]);
                    raw[qt][ks] = o; }
            }
        }
#pragma unroll
        for (int qt = 0; qt < 2; ++qt)
#pragma unroll
            for (int ks = 0; ks < KS; ++ks) qf[qt][ks] = as_bf8(raw[qt][ks]);
    }
    v4u kreg[KPT], vreg[VPT];
#define ATT_GLOAD(kt) do { \
    _Pragma("unroll") for (int i = 0; i < KPT; ++i) { const int ch = tid + i * NTHR; if (ch < NKC) kreg[i] = *(const v4u*)(Kp + (size_t)(kt) * 64 * DQK + (size_t)ch * 8); } \
    _Pragma("unroll") for (int i = 0; i < VPT; ++i) { const int ch = tid + i * NTHR; if (ch < NVC) vreg[i] = *(const v4u*)(Vtp + (size_t)(ch >> 3) * vpitch + (kt) * 64 + (ch & 7) * 8); } } while (0)
#define ATT_LSTORE(buf) do { \
    _Pragma("unroll") for (int i = 0; i < KPT; ++i) { const int ch = tid + i * NTHR; if (ch < NKC) *(LAS v4u*)(lds + (buf) * KBUF + (ch / (DQK / 8)) * (KROW * 2) + (ch % (DQK / 8)) * 16) = kreg[i]; } \
    _Pragma("unroll") for (int i = 0; i < VPT; ++i) { const int ch = tid + i * NTHR; if (ch < NVC) *(LAS v4u*)(lds + 2 * KBUF + (buf) * VBUF + (ch >> 3) * (VROW * 2) + (ch & 7) * 16) = vreg[i]; } } while (0)
    ATT_GLOAD(0); ATT_LSTORE(0);
    __syncthreads();
    float m_run[2] = {-1e30f, -1e30f}, l_run[2] = {0.f, 0.f};
    f32x4 o[DT][2];
#pragma unroll
    for (int dt = 0; dt < DT; ++dt) { o[dt][0] = (f32x4){0.f, 0.f, 0.f, 0.f}; o[dt][1] = (f32x4){0.f, 0.f, 0.f, 0.f}; }
    const int rw0 = row0seq + 32 * w;
    for (int kt = 0; kt < nkt; ++kt) {
        if (kt + 1 < nkt) ATT_GLOAD(kt + 1);
        const int k0 = kt * 64;
        const bool active = !CAUSAL || (k0 <= rw0 + 31);
        if (active) {
            const LAS unsigned char* kb = lds + (kt & 1) * KBUF; const LAS unsigned char* vb = lds + 2 * KBUF + (kt & 1) * VBUF;
            f32x4 s[4][2];
#pragma unroll
            for (int kk = 0; kk < 4; ++kk) { s[kk][0] = (f32x4){0.f, 0.f, 0.f, 0.f}; s[kk][1] = (f32x4){0.f, 0.f, 0.f, 0.f}; }
#pragma unroll
            for (int kk = 0; kk < 4; ++kk)
#pragma unroll
                for (int ks = 0; ks < KS; ++ks) { const bf16x8 kf = as_bf8(*(const LAS v4u*)(kb + (kk * 16 + c16) * (KROW * 2) + (ks * 32 + 8 * q4) * 2));
                    s[kk][0] = mfma16(kf, qf[0][ks], s[kk][0]); s[kk][1] = mfma16(kf, qf[1][ks], s[kk][1]); }
            const bool needmask = CAUSAL && (k0 + 63 > rw0);
            bf16x8 pf[2][2];
#pragma unroll
            for (int qt = 0; qt < 2; ++qt) {
                const int rowi = rw0 + 16 * qt + c16;
                float tmax = -INFINITY;
#pragma unroll
                for (int kk = 0; kk < 4; ++kk)
#pragma unroll
                    for (int j = 0; j < 4; ++j) { float v = s[kk][qt][j] * scale_log2;
                        if (needmask) { const int key = k0 + kk * 16 + 4 * q4 + j; v = (key > rowi) ? -INFINITY : v; }
                        s[kk][qt][j] = v; tmax = fmaxf(tmax, v); }
                tmax = fmaxf(tmax, __shfl_xor(tmax, 16)); tmax = fmaxf(tmax, __shfl_xor(tmax, 32));
                const float mnew = fmaxf(m_run[qt], tmax), alpha = __builtin_amdgcn_exp2f(m_run[qt] - mnew);
                m_run[qt] = mnew;
                float psum = 0.f;
#pragma unroll
                for (int kk = 0; kk < 4; ++kk)
#pragma unroll
                    for (int j = 0; j < 4; ++j) { const float p = __builtin_amdgcn_exp2f(s[kk][qt][j] - mnew); s[kk][qt][j] = p; psum += p; }
                l_run[qt] = l_run[qt] * alpha + psum;
#pragma unroll
                for (int dt = 0; dt < DT; ++dt) o[dt][qt] = o[dt][qt] * alpha;
#pragma unroll
                for (int kp = 0; kp < 2; ++kp) { v4u pp;
                    pp.x = cvt_pk_bf16(s[2 * kp][qt][0], s[2 * kp][qt][1]); pp.y = cvt_pk_bf16(s[2 * kp][qt][2], s[2 * kp][qt][3]);
                    pp.z = cvt_pk_bf16(s[2 * kp + 1][qt][0], s[2 * kp + 1][qt][1]); pp.w = cvt_pk_bf16(s[2 * kp + 1][qt][2], s[2 * kp + 1][qt][3]);
                    pf[qt][kp] = as_bf8(pp); }
            }
#pragma unroll
            for (int dt = 0; dt < DT; ++dt)
#pragma unroll
                for (int kp = 0; kp < 2; ++kp) {
                    const LAS unsigned char* vp = vb + (dt * 16 + c16) * (VROW * 2) + (32 * kp + 4 * q4) * 2;
                    const v2u a0 = *(const LAS v2u*)vp, a1 = *(const LAS v2u*)(vp + 32);
                    const bf16x8 vf = as_bf8((v4u){a0.x, a0.y, a1.x, a1.y});
                    o[dt][0] = mfma16(vf, pf[0][kp], o[dt][0]); o[dt][1] = mfma16(vf, pf[1][kp], o[dt][1]);
                }
        }
        if (kt + 1 < nkt) ATT_LSTORE((kt + 1) & 1);
        __syncthreads();
    }
#undef ATT_GLOAD
#undef ATT_LSTORE
#pragma unroll
    for (int qt = 0; qt < 2; ++qt) {
        float lt = l_run[qt]; lt += __shfl_xor(lt, 16); lt += __shfl_xor(lt, 32);
        const float inv = 1.0f / lt;
        bf16* gr = Gp + (size_t)(32 * w + 16 * qt + c16) * gpitch + 4 * q4;
#pragma unroll
        for (int dt = 0; dt < DT; ++dt) { const v2u g = *(const v2u*)(gr + dt * 16); v2u r;
            r.x = cvt_pk_bf16(o[dt][qt][0] * inv * bflo(g.x), o[dt][qt][1] * inv * bfhi(g.x)); r.y = cvt_pk_bf16(o[dt][qt][2] * inv * bflo(g.y), o[dt][qt][3] * inv * bfhi(g.y));
            if (st) *(v2u*)(gr + dt * 16) = r; }
    }
}

__device__ __forceinline__ void ph_mla(const Args& a, LAS unsigned char* lds, int bid, int nb, bool st) {
    const bf16* Qb = (const bf16*)(a.ws + WS_Q); const bf16* Kb = (const bf16*)(a.ws + WS_K); const bf16* Vtb = (const bf16*)(a.ws + WS_VT); bf16* G = (bf16*)(a.ws + WS_G);
    const float sc = 0.10206207261596577f * 1.4426950408889634f;
    for (int u = bid; u < 256; u += nb) {
        const int b = u >> 5, h = (u >> 2) & 7, p = u & 3;
        for (int half = 0; half < 2; ++half) {
            const int jb = half ? p : 7 - p;
            const size_t bh = (size_t)(b * 8 + h);
            attn_block<96, 64, true, false>(lds, Qb + (bh * SEQ + 256 * jb) * 96, 96, nullptr, Kb + bh * SEQ * 96, Vtb + bh * 64 * SEQ, SEQ, 4 * (jb + 1), 256 * jb, sc,
                                            G + (size_t)(b * SEQ + 256 * jb) * GW + h * 64, GW, st);
        }
    }
}
__device__ __forceinline__ void ph_memattn(const Args& a, int l, LAS unsigned char* lds, int bid, int nb, bool st) {
    const bf16* MIX = (const bf16*)(a.ws + WS_MIX); bf16* G = (bf16*)(a.ws + WS_G);
    const bf16* mk = (const bf16*)(a.ws + WS_MEMK + l * 2 * MiB); const bf16* mv = (const bf16*)(a.ws + WS_MEMVT + l * 2 * MiB);
    const float sc = 0.08838834764831845f * 1.4426950408889634f;
    for (int u = bid; u < 256; u += nb) {
        const int tb = u >> 2, h = u & 3, t0 = tb * 256, b = t0 >> 11;
        attn_block<128, 128, false, true>(lds, MIX + (size_t)t0 * MIXW + MC_MQ + h * 128, MIXW, a.in[19] + l * 128, mk + (size_t)(b * 4 + h) * 256 * 128, mv + (size_t)(b * 4 + h) * 128 * 256, 256,
                                          4, 0, sc, G + (size_t)t0 * GW + 3 * 512 + h * 128, GW, st);
    }
}

__device__ __forceinline__ void ph_sg(const Args& a, int l, LAS unsigned char* lds, int bid, int nb, bool st) {
    const int tid = pg8::opaque_tid(), lane = tid & 63, w = tid >> 6, c16 = lane & 15, q4 = lane >> 4;
    const bf16* MIX = (const bf16*)(a.ws + WS_MIX); bf16* G = (bf16*)(a.ws + WS_G);
    const float* lng = a.in[13] + l * 512; const float* lnb = a.in[14] + l * 512; const float* ws_ = a.in[15] + (size_t)l * 4 * 128 * 128; const float* bs = a.in[16] + l * 4 * 128;
    LAS float* stat = (LAS float*)lds; LAS bf16* vT = (LAS bf16*)(lds + 1024); constexpr int VLD = 136;
    for (int u = bid; u < 512; u += nb) {
        const int c = u >> 2, g = u & 3, t0 = c * 128;
        __syncthreads();
        {   const int row = tid >> 2, part = tid & 3; const bf16* src = MIX + (size_t)(t0 + row) * MIXW + MC_V + part * 128;
            float s1 = 0.f, s2 = 0.f;
#pragma unroll 4
            for (int i = 0; i < 16; ++i) { const v4u x = *(const v4u*)(src + i * 8);
                const float f0 = bflo(x.x), f1 = bfhi(x.x), f2 = bflo(x.y), f3 = bfhi(x.y), f4 = bflo(x.z), f5 = bfhi(x.z), f6 = bflo(x.w), f7 = bfhi(x.w);
                s1 += ((f0 + f1) + (f2 + f3)) + ((f4 + f5) + (f6 + f7)); s2 += ((f0 * f0 + f1 * f1) + (f2 * f2 + f3 * f3)) + ((f4 * f4 + f5 * f5) + (f6 * f6 + f7 * f7)); }
            s1 += __shfl_xor(s1, 1); s1 += __shfl_xor(s1, 2); s2 += __shfl_xor(s2, 1); s2 += __shfl_xor(s2, 2);
            const float mean = s1 * (1.f / 512.f), var = fmaxf(s2 * (1.f / 512.f) - mean * mean, 0.f);
            if (part == 0) { stat[row * 2] = mean; stat[row * 2 + 1] = 1.0f / sqrtf(var + EPS); }
        }
        __syncthreads();
        {   const int s = tid & 127, dq = tid >> 7; const bf16* src = MIX + (size_t)(t0 + s) * MIXW + MC_V + g * 128 + dq * 32;
            const float mean = stat[s * 2], rstd = stat[s * 2 + 1];
#pragma unroll
            for (int i = 0; i < 4; ++i) { const v4u x = *(const v4u*)(src + i * 8); const int d0 = dq * 32 + i * 8; const float* gp = lng + g * 128 + d0; const float* bp = lnb + g * 128 + d0;
                float f[8] = {bflo(x.x), bfhi(x.x), bflo(x.y), bfhi(x.y), bflo(x.z), bfhi(x.z), bflo(x.w), bfhi(x.w)};
#pragma unroll
                for (int e = 0; e < 8; ++e) { const float y = (f[e] - mean) * rstd * gp[e] + bp[e]; vT[(d0 + e) * VLD + s] = (bf16)(cvt_pk_bf16(y, 0.f) & 0xffffu); } }
        }
        __syncthreads();
        {   f32x4 acc[8];
#pragma unroll
            for (int nt = 0; nt < 8; ++nt) acc[nt] = (f32x4){0.f, 0.f, 0.f, 0.f};
            const int tt = 16 * w + c16, nks = (w >> 1) + 1;
            const float* wrow = ws_ + ((size_t)g * 128 + tt) * 128;
            for (int ks = 0; ks < nks; ++ks) {
                const int s0 = ks * 32 + 8 * q4;
                const f32x4 w0 = *(const f32x4*)(wrow + s0), w1 = *(const f32x4*)(wrow + s0 + 4);
                float wv[8] = {w0[0], w0[1], w0[2], w0[3], w1[0], w1[1], w1[2], w1[3]};
#pragma unroll
                for (int e = 0; e < 8; ++e) wv[e] = (s0 + e <= tt) ? wv[e] : 0.f;
                v4u wp; wp.x = cvt_pk_bf16(wv[0], wv[1]); wp.y = cvt_pk_bf16(wv[2], wv[3]); wp.z = cvt_pk_bf16(wv[4], wv[5]); wp.w = cvt_pk_bf16(wv[6], wv[7]);
                const bf16x8 bfrag = as_bf8(wp);
#pragma unroll
                for (int nt = 0; nt < 8; ++nt) { const bf16x8 af = as_bf8(*(const LAS v4u*)(vT + (nt * 16 + c16) * VLD + s0)); acc[nt] = mfma16(af, bfrag, acc[nt]); }
            }
            const int t = t0 + tt; const float bias = bs[g * 128 + tt];
            const bf16* up = MIX + (size_t)t * MIXW + MC_U + g * 128 + 4 * q4; bf16* gp = G + (size_t)t * GW + 2 * 512 + g * 128 + 4 * q4;
#pragma unroll
            for (int nt = 0; nt < 8; ++nt) { const v2u uu = *(const v2u*)(up + nt * 16), gg = *(const v2u*)(gp + nt * 16); v2u r;
                r.x = cvt_pk_bf16(bflo(uu.x) * (acc[nt][0] + bias) * bflo(gg.x), bfhi(uu.x) * (acc[nt][1] + bias) * bfhi(gg.x));
                r.y = cvt_pk_bf16(bflo(uu.y) * (acc[nt][2] + bias) * bflo(gg.y), bfhi(uu.y) * (acc[nt][3] + bias) * bfhi(gg.y));
                if (st) *(v2u*)(gp + nt * 16) = r; }
        }
    }
}

__device__ __forceinline__ void ph_conv(const Args& a, int l, int bid, int nb, bool st) {
    const bf16* MIX = (const bf16*)(a.ws + WS_MIX); bf16* G = (bf16*)(a.ws + WS_G);
    const float* cw = a.in[11] + l * 3 * 512; const float* cb = a.in[12] + l * 512;
    for (int idx = bid * NTHR + pg8::opaque_tid(); idx < T * 64; idx += nb * NTHR) {
        const int t = idx >> 6, c = (idx & 63) * 8, s = t & 2047;
        const bf16* row = MIX + (size_t)t * MIXW;
        const v4u bg = *(const v4u*)(row + MC_BG + c);
        float z[3][8];
#pragma unroll
        for (int d = 0; d < 3; ++d) {
            if (s - d >= 0) { const v4u cgv = *(const v4u*)(row - (size_t)d * MIXW + MC_CG + c), xv = *(const v4u*)(row - (size_t)d * MIXW + MC_XIN + c);
                z[d][0] = bflo(cgv.x) * bflo(xv.x); z[d][1] = bfhi(cgv.x) * bfhi(xv.x); z[d][2] = bflo(cgv.y) * bflo(xv.y); z[d][3] = bfhi(cgv.y) * bfhi(xv.y);
                z[d][4] = bflo(cgv.z) * bflo(xv.z); z[d][5] = bfhi(cgv.z) * bfhi(xv.z); z[d][6] = bflo(cgv.w) * bflo(xv.w); z[d][7] = bfhi(cgv.w) * bfhi(xv.w); }
            else {
#pragma unroll
                for (int e = 0; e < 8; ++e) z[d][e] = 0.f; }
        }
        bf16* gp = G + (size_t)t * GW + 512 + c; const v4u gg = *(const v4u*)gp;
        const float bgf[8] = {bflo(bg.x), bfhi(bg.x), bflo(bg.y), bfhi(bg.y), bflo(bg.z), bfhi(bg.z), bflo(bg.w), bfhi(bg.w)};
        const float ggf[8] = {bflo(gg.x), bfhi(gg.x), bflo(gg.y), bfhi(gg.y), bflo(gg.z), bfhi(gg.z), bflo(gg.w), bfhi(gg.w)};
        float y[8];
#pragma unroll
        for (int e = 0; e < 8; ++e) y[e] = bgf[e] * (cb[c + e] + cw[c + e] * z[2][e] + cw[512 + c + e] * z[1][e] + cw[1024 + c + e] * z[0][e]) * ggf[e];
        v4u r; r.x = cvt_pk_bf16(y[0], y[1]); r.y = cvt_pk_bf16(y[2], y[3]); r.z = cvt_pk_bf16(y[4], y[5]); r.w = cvt_pk_bf16(y[6], y[7]);
        if (st) *(v4u*)gp = r;
    }
}
#define XB_TMO      128
#define XB_XCNT(j)  (256  + 64 * (j))
#define XB_XSUB(j)  (1280 + 64 * (j))
#define XB_XGEN(j)  (2304 + 64 * (j))
#define XB_TOP      3328
#define XB_TOPGEN   3392
#define XCD_BAR_WORDS 3456
#define XB_SPIN_CAP (1u << 18)

__device__ __forceinline__ unsigned xb_ld(unsigned* p)              { return __hip_atomic_load(p, __ATOMIC_RELAXED, __HIP_MEMORY_SCOPE_AGENT); }
__device__ __forceinline__ unsigned xb_add(unsigned* p, unsigned v) { return __hip_atomic_fetch_add(p, v, __ATOMIC_RELAXED, __HIP_MEMORY_SCOPE_AGENT); }
__device__ __forceinline__ unsigned xb_xcc_id() { return (unsigned)__builtin_amdgcn_s_getreg((3 << 11) | 20) & 0xFu; }
#define XB_SPIN(cond, bar) do { unsigned _sp = 0; while (cond) { __builtin_amdgcn_s_sleep(1); \
    if ((++_sp & 255u) == 0u) { if (xb_ld(&(bar)[XB_TMO])) break; if (_sp > XB_SPIN_CAP) { atomicAdd(&(bar)[XB_TMO], 1u); break; } } } } while (0)

struct XcdBarrier {
    unsigned* bar; unsigned x;
    volatile LAS unsigned* st;
};

__device__ __forceinline__ XcdBarrier xcd_barrier_post(unsigned* bar, volatile LAS unsigned* st) {
    XcdBarrier b; b.bar = bar; b.x = xb_xcc_id(); b.st = st;
    if (threadIdx.x == 0) (void)xb_add(&bar[XB_XCNT(b.x)], 1u);
    return b;
}
__device__ __forceinline__ void xcd_barrier_complete(unsigned* bar, unsigned x, unsigned& nloc, unsigned& nx) {
    const unsigned G = gridDim.x * gridDim.y * gridDim.z;
    unsigned sum, cnt, mine, sp = 0u;
    for (;;) {
        sum = 0u; cnt = 0u; mine = 0u;
#pragma unroll
        for (unsigned j = 0; j < 16; ++j) { const unsigned c = xb_ld(&bar[XB_XCNT(j)]); sum += c; cnt += (c > 0u) ? 1u : 0u; mine = (j == x) ? c : mine; }
        if (sum == G) break;
        __builtin_amdgcn_s_sleep(1);
        if ((++sp & 255u) == 0u) { if (xb_ld(&bar[XB_TMO])) break; if (sp > XB_SPIN_CAP) { atomicAdd(&bar[XB_TMO], 1u); break; } }
    }
    nloc = mine > 0u ? mine : 1u; nx = cnt > 0u ? cnt : 1u;
}

__device__ __forceinline__ void xcd_barrier(const XcdBarrier& b) {
    asm volatile("s_waitcnt vmcnt(0)" ::: "memory");
    __syncthreads();
    if (threadIdx.x == 0) {
        unsigned* bar = b.bar;
        __builtin_amdgcn_s_waitcnt(0);
        unsigned nloc = b.st[0], nx = b.st[1];
        if (nloc == 0u) { xcd_barrier_complete(bar, b.x, nloc, nx); b.st[0] = nloc; b.st[1] = nx; }
        const unsigned old = xb_add(&bar[XB_XSUB(b.x)], 1u);
        const unsigned gen = old / nloc;
        if (old + 1u == (gen + 1u) * nloc) {
            __builtin_amdgcn_fence(__ATOMIC_RELEASE, "agent");
            asm volatile("s_waitcnt vmcnt(0)" ::: "memory");
            const unsigned og = xb_add(&bar[XB_TOP], 1u);
            const unsigned tg = og / nx;
            if (og + 1u == (tg + 1u) * nx) xb_add(&bar[XB_TOPGEN], 1u);
            else XB_SPIN(xb_ld(&bar[XB_TOPGEN]) == tg, bar);
            __builtin_amdgcn_fence(__ATOMIC_ACQUIRE, "agent");
            xb_add(&bar[XB_XGEN(b.x)], 1u);
            asm volatile("s_waitcnt vmcnt(0)" ::: "memory");
        } else {
            XB_SPIN(xb_ld(&bar[XB_XGEN(b.x)]) == gen, bar);
            __builtin_amdgcn_fence(__ATOMIC_ACQUIRE, "agent");
            asm volatile("s_waitcnt vmcnt(0)" ::: "memory");
        }
    }
    __syncthreads();
}

#ifndef MK_PER_PHASE
#define MK_PER_PHASE 0
#endif
constexpr int NPH = 3 + 8 + 7;
__global__ void __launch_bounds__(NTHR, 2) mk_fwd(Args a) {
    extern __shared__ __attribute__((aligned(16))) unsigned char lds_raw[];
    LAS unsigned char* lds = (LAS unsigned char*)lds_raw;
    cg::grid_group grid = cg::this_grid();
    const int bid = blockIdx.x, nb = gridDim.x;
    const int lo = a.ph_lo, hi = a.ph_hi; const bool real = (hi > 0);
    volatile LAS unsigned* MISC = (volatile LAS unsigned*)(lds + 131072);
    if (threadIdx.x < 32) MISC[threadIdx.x] = 0u;
    __syncthreads();
    const XcdBarrier bar = xcd_barrier_post((unsigned*)a.ws + 1024, MISC + 8);
    bf16* H = (bf16*)(a.ws + WS_H); bf16* MIX = (bf16*)(a.ws + WS_MIX); bf16* G = (bf16*)(a.ws + WS_G); bf16* GATE = (bf16*)(a.ws + WS_GATE); bf16* MERGED = (bf16*)(a.ws + WS_MERGED);
#define IN(k) (lo <= (k) && (k) < hi)
#define SEAM(k) do { if (IN((k) + 1)) { if ((k) == 0) grid.sync(); else xcd_barrier(bar); } } while (0)
    if (IN(0)) {
#ifdef DUP_PRO
        ph_prologue(a, lds, bid, nb); __syncthreads();
#endif
#ifdef DUP_SYNC
        for (int i = 0; i < 16; ++i) grid.sync();
#endif
        ph_prologue(a, lds, bid, nb); SEAM(0); }
    if (IN(1)) {
        for (int l = 0; l < 2; ++l) {
            pg8::Gemm g{(const bf16*)(a.ws + WS_MEMN + l * 4 * MiB), DM, (const bf16*)(a.ws + WS_WMEMT + l * 2 * MiB), MEMT, 1024, DM};
            pg8::StaticOrder S; S.init(MEMT, 1024, nb, (bid + 128 * l) % nb);
            pg8::EpiAct<0> E{(bf16*)(a.ws + WS_KVRAW + l * 4 * MiB), 1024, 1 << 20, nullptr, 0, nullptr};
            pg8::gemm_phase<pg8::EpiAct<0>, pg8::StaticOrder, true, true>(lds, g, S, E);
        }
        SEAM(1);
    }
    if (IN(2)) { ph_mempost(a, bid, nb); SEAM(2); }
    for (int l = 0; l < 2; ++l) {
        const int base = 3 + 8 * l;
        const unsigned char* wb = a.ws + (l ? WS_W1 : WS_W0);
        const bf16* WinT = (const bf16*)(wb + WO_WIN);
        const float* xl = l ? a.out : a.in[0];
        if (IN(base + 0)) {
            pg8::Gemm g{H, DM, WinT, T, NA, DM};
            pg8::StaticOrder S; S.init(T, NA, nb, bid);
            pg8::EpiAct<1> E{MIX, MIXW, 14, G, GW, nullptr};
            pg8::gemm_phase<pg8::EpiAct<1>, pg8::StaticOrder, true, true>(lds, g, S, E);
            SEAM(base + 0);
        }
        if (IN(base + 1)) {
#ifdef DUP_P2
            ph_p2(a, l, lds, bid, nb);
#endif
            ph_p2(a, l, lds, bid, nb); SEAM(base + 1); }
        if (IN(base + 2)) {
#ifdef DUP_MLA
            ph_mla(a, lds, bid, nb, !real);
#endif
#ifdef DUP_MIX3
            ph_memattn(a, l, lds, bid, nb, !real); ph_sg(a, l, lds, bid, nb, !real); ph_conv(a, l, bid, nb, !real);
#endif
            ph_mla(a, lds, bid, nb, real); ph_memattn(a, l, lds, bid, nb, real); ph_sg(a, l, lds, bid, nb, real); ph_conv(a, l, bid, nb, real); __syncthreads(); SEAM(base + 2); }
        if (IN(base + 3)) { norm_rows(xl, a.in[3] + l * DM, H, T, bid, nb); SEAM(base + 3); }
        if (IN(base + 4)) {
            pg8::Gemm g{H, DM, WinT + (size_t)NA * DM, T, GATEW, DM};
            pg8::StaticOrder S; S.init(T, GATEW, nb, bid);
            pg8::EpiAct<2> E{nullptr, 0, 0, GATE, GATEW, a.in[21] + l * 4096};
            pg8::gemm_phase<pg8::EpiAct<2>, pg8::StaticOrder, true, true>(lds, g, S, E);
            SEAM(base + 4);
        }
        if (IN(base + 5)) {
            pg8::Gemm g{G, GW, (const bf16*)(wb + WO_WBR), T, DM, 2048};
            pg8::StaticOrder S; S.init(T, DM, nb, bid);
            pg8::EpiGate E{GATE, MERGED};
            pg8::gemm_phase<pg8::EpiGate, pg8::StaticOrder, false, true>(lds, g, S, E);
            SEAM(base + 5);
        }
        if (IN(base + 6)) {
            pg8::Gemm g{MERGED, DM, (const bf16*)(wb + WO_WOUT), T, DM, DM};
            pg8::StaticOrder S; S.init(T, DM, nb, bid);
            pg8::EpiRes E{xl, a.out, DM};
            pg8::gemm_phase<pg8::EpiRes, pg8::StaticOrder, false, true>(lds, g, S, E);
            if (l == 0) SEAM(base + 6);
        }
        if (l == 0 && IN(base + 7)) { norm_rows(a.out, a.in[3] + DM, H, T, bid, nb); SEAM(base + 7); }
    }
#undef IN
#undef SEAM
}

extern "C" void kernel_launch(void* const* d_in, const int* in_sizes, int n_in, void* d_out, int out_size, void* d_ws, size_t ws_size, hipStream_t stream) {
    static int grid = 0;
    if (grid == 0) {
        if (n_in != 24 || out_size != T * DM || ws_size < WS_END) { fprintf(stderr, "kernel_launch: unexpected problem (n_in %d out %d ws %zu)\n", n_in, out_size, ws_size); grid = -1; return; }
        int dev = 0, cus = 0, per_cu = 0;
        hipGetDevice(&dev); hipDeviceGetAttribute(&cus, hipDeviceAttributeMultiprocessorCount, dev);
        if (hipFuncSetAttribute((const void*)mk_fwd, hipFuncAttributeMaxDynamicSharedMemorySize, LDS_BYTES) != hipSuccess) { fprintf(stderr, "kernel_launch: hipFuncSetAttribute failed\n"); grid = -1; return; }
        if (hipOccupancyMaxActiveBlocksPerMultiprocessor(&per_cu, (const void*)mk_fwd, NTHR, LDS_BYTES) != hipSuccess || per_cu < 1) { fprintf(stderr, "kernel_launch: occupancy query says %d\n", per_cu); per_cu = 1; }
        (void)hipGetLastError();
        grid = cus;
    }
    if (grid < 0) return;
    if (hipMemsetAsync(d_ws, 0, 65536, stream) != hipSuccess) { fprintf(stderr, "kernel_launch: memset failed\n"); return; }
    Args a{};
    for (int i = 0; i < 24; ++i) a.in[i] = (const float*)d_in[i];
    a.out = (float*)d_out; a.ws = (unsigned char*)d_ws;
#if MK_PER_PHASE
    for (int p = 0; p < NPH; ++p) { a.ph_lo = p; a.ph_hi = p + 1; void* args[] = {&a};
        hipError_t e = hipLaunchCooperativeKernel((void*)mk_fwd, dim3(grid), dim3(NTHR), args, LDS_BYTES, stream);
        if (e != hipSuccess) { fprintf(stderr, "launch %d failed: %s\n", p, hipGetErrorString(e)); break; } }
#else
    a.ph_lo = 0; a.ph_hi = NPH; void* args[] = {&a};
    hipError_t e = hipLaunchCooperativeKernel((void*)mk_fwd, dim3(grid), dim3(NTHR), args, LDS_BYTES, stream);
    if (e != hipSuccess) fprintf(stderr, "cooperative launch failed: %s (grid %d)\n", hipGetErrorString(e), grid);
#endif
}
```

```cpp
#include <hip/hip_runtime.h>
#include <hip/hip_cooperative_groups.h>
#include <cstdio>
#include <cstdint>
namespace cg = cooperative_groups;
namespace pg8 {
#define PG8_LAS __attribute__((address_space(3)))
typedef unsigned short bf16_t;
typedef short bf16x8 __attribute__((ext_vector_type(8)));
typedef float f32x4 __attribute__((ext_vector_type(4)));
typedef unsigned u32x4 __attribute__((ext_vector_type(4)));
constexpr int BM = 256, BK = 64, HALF = 128, HTB = HALF * BK * 2  , STAGE_BYTES = 8 * HTB, NXCD = 8, WGM = 8;

__host__ __device__ __forceinline__ int lds_byte(int r, int c) { const int st = (r >> 4) * 2 + (c >> 5), rr = r & 15, cc = c & 31, ob = rr * 64 + cc * 2; return st * 1024 + (ob ^ (((ob >> 9) & 1) << 5)); }
__host__ __device__ __forceinline__ void stage_rc(int b, int& R, int& C) { const int st = b / 1024, sb = b % 1024, swz = sb ^ (((sb >> 9) & 1) << 5); R = (st >> 1) * 16 + swz / 64; C = (st & 1) * 32 + (swz % 64) / 2; }
__host__ __device__ __forceinline__ int perm32(int rho) { const int n = rho >> 4, i = rho & 15; return 8 * (i >> 2) + 4 * n + (i & 3); }

struct Unit { int pm, pn; };
struct Gemm { const bf16_t* A; int lda; const bf16_t* Bt; int M, N, K; };

struct StaticOrder {
    int nM, nN, nwg, G, c;
    __host__ __device__ void init(int M, int N, int G_, int c_) { nM = M / BM; nN = N / BM; nwg = nM * nN; G = G_; c = c_; }
    __host__ __device__ bool next(int i, Unit& u) const {
        const long L = (long)i * G + c; if (L >= nwg) return false;
        int wgid = (int)L; { const int q = nwg / NXCD, r = nwg % NXCD, xcd = wgid % NXCD, off = wgid / NXCD; wgid = (xcd < r ? xcd * (q + 1) : r * (q + 1) + (xcd - r) * q) + off; }
        const int nig = WGM * nN, gid = wgid / nig, fm = gid * WGM, gsz = (nM - fm) < WGM ? (nM - fm) : WGM;
        u.pm = fm + ((wgid % nig) % gsz); u.pn = (wgid % nig) / gsz; return true;
    }
    __device__ __forceinline__ void a_ready(const Unit&) const {}
    __device__ __forceinline__ void done(const Unit&) const {}
};

__device__ __forceinline__ unsigned cvt_pk_bf16(float lo, float hi) { unsigned r; asm volatile("v_cvt_pk_bf16_f32 %0, %1, %2" : "=v"(r) : "v"(lo), "v"(hi)); return r; }
__device__ __forceinline__ int opaque_tid() { int t = threadIdx.x; asm volatile("" : "+v"(t)); return t; }
__device__ __forceinline__ float bflo(unsigned u) { return __uint_as_float(u << 16); }
__device__ __forceinline__ float bfhi(unsigned u) { return __uint_as_float(u & 0xffff0000u); }
__device__ __forceinline__ float sigm(float x) { return __builtin_amdgcn_rcpf(1.0f + __expf(-x)); }

template <int ACT> struct EpiAct {
    static constexpr bool PERM = true, AFTER_DRAIN = false, HAS_MID = false;
    bf16_t* O0; int ld0; int npn0; bf16_t* O1; int ld1; const float* bias;
    __device__ __forceinline__ void operator()(const f32x4 (&acc)[2][2][4][2], const Unit& u, int wr, int wc, int fr, int fq) const {
        const int row0 = u.pm * BM + wr * 64 + fr;
        const bool second = (u.pn >= npn0);
        bf16_t* base = second ? O1 : O0; const int ld = second ? ld1 : ld0; const int colt = second ? (u.pn - npn0) * BM : u.pn * BM;
        const int col0 = colt + wc * 32 + 8 * fq;
#pragma unroll
        for (int bj = 0; bj < 2; ++bj) {
            f32x4 b0 = (f32x4){0.f, 0.f, 0.f, 0.f}, b1 = b0;
            if (ACT == 2) { b0 = *(const f32x4*)(bias + col0 + bj * HALF); b1 = *(const f32x4*)(bias + col0 + bj * HALF + 4); }
#pragma unroll
            for (int ai = 0; ai < 2; ++ai)
#pragma unroll
                for (int m = 0; m < 4; ++m) {
                    bf16_t* rowp = base + (size_t)(row0 + ai * HALF + m * 16) * ld + col0 + bj * HALF;
                    f32x4 v0 = acc[ai][bj][m][0], v1 = acc[ai][bj][m][1];
                    if (ACT != 0 && second) {
#pragma unroll
                        for (int e = 0; e < 4; ++e) {
                            if (ACT == 1) { v0[e] = v0[e] * sigm(v0[e]); v1[e] = v1[e] * sigm(v1[e]); }
                            if (ACT == 2) { v0[e] = sigm(v0[e] + b0[e]); v1[e] = sigm(v1[e] + b1[e]); }
                        }
                    }
                    u32x4 w; w.x = cvt_pk_bf16(v0[0], v0[1]); w.y = cvt_pk_bf16(v0[2], v0[3]); w.z = cvt_pk_bf16(v1[0], v1[1]); w.w = cvt_pk_bf16(v1[2], v1[3]);
                    *(u32x4*)rowp = w;
                }
        }
    }
};

struct EpiGate {
    static constexpr bool PERM = true, AFTER_DRAIN = false, HAS_MID = true;
    const bf16_t* GATE; bf16_t* O;
    __device__ __forceinline__ void mid(f32x4 (&acc)[2][2][4][2], const Unit& u, int nb, int wr, int wc, int fr_, int fq_) const {
        int fr = fr_, fq = fq_; asm volatile("" : "+v"(fr), "+v"(fq));
        const int row0 = u.pm * BM + wr * 64 + fr, col0 = u.pn * BM + wc * 32 + 8 * fq;
#pragma unroll
        for (int ai = 0; ai < 2; ++ai)
#pragma unroll
            for (int bj = 0; bj < 2; ++bj) {
                u32x4 ga[4], gb[4];
#pragma unroll
                for (int m = 0; m < 4; ++m) { const bf16_t* gp = GATE + (size_t)(row0 + ai * HALF + m * 16) * 4096 + (nb - 1) * 1024 + col0 + bj * HALF; ga[m] = *(const u32x4*)gp; gb[m] = *(const u32x4*)(gp + 1024); }
                __builtin_amdgcn_sched_barrier(0);
#pragma unroll
                for (int m = 0; m < 4; ++m) { const u32x4 a = ga[m], b = gb[m];
                    f32x4 r0, r1;
                    r0[0] = bflo(a.x) * __builtin_amdgcn_rcpf(bflo(b.x)); r0[1] = bfhi(a.x) * __builtin_amdgcn_rcpf(bfhi(b.x));
                    r0[2] = bflo(a.y) * __builtin_amdgcn_rcpf(bflo(b.y)); r0[3] = bfhi(a.y) * __builtin_amdgcn_rcpf(bfhi(b.y));
                    r1[0] = bflo(a.z) * __builtin_amdgcn_rcpf(bflo(b.z)); r1[1] = bfhi(a.z) * __builtin_amdgcn_rcpf(bfhi(b.z));
                    r1[2] = bflo(a.w) * __builtin_amdgcn_rcpf(bflo(b.w)); r1[3] = bfhi(a.w) * __builtin_amdgcn_rcpf(bfhi(b.w));
                    acc[ai][bj][m][0] = acc[ai][bj][m][0] * r0; acc[ai][bj][m][1] = acc[ai][bj][m][1] * r1; }
                __builtin_amdgcn_sched_barrier(0);
            }
    }
    __device__ __forceinline__ void operator()(const f32x4 (&acc)[2][2][4][2], const Unit& u, int wr, int wc, int fr, int fq) const {
        const int row0 = u.pm * BM + wr * 64 + fr, col0 = u.pn * BM + wc * 32 + 8 * fq;
#pragma unroll
        for (int ai = 0; ai < 2; ++ai)
#pragma unroll
            for (int bj = 0; bj < 2; ++bj) {
                u32x4 ga[4];
#pragma unroll
                for (int m = 0; m < 4; ++m) ga[m] = *(const u32x4*)(GATE + (size_t)(row0 + ai * HALF + m * 16) * 4096 + 3 * 1024 + col0 + bj * HALF);
                __builtin_amdgcn_sched_barrier(0);
#pragma unroll
                for (int m = 0; m < 4; ++m) { const u32x4 a = ga[m]; const f32x4 v0 = acc[ai][bj][m][0], v1 = acc[ai][bj][m][1];
                    u32x4 w; w.x = cvt_pk_bf16(v0[0] * bflo(a.x), v0[1] * bfhi(a.x)); w.y = cvt_pk_bf16(v0[2] * bflo(a.y), v0[3] * bfhi(a.y));
                    w.z = cvt_pk_bf16(v1[0] * bflo(a.z), v1[1] * bfhi(a.z)); w.w = cvt_pk_bf16(v1[2] * bflo(a.w), v1[3] * bfhi(a.w));
                    *(u32x4*)(O + (size_t)(row0 + ai * HALF + m * 16) * 1024 + col0 + bj * HALF) = w; }
                __builtin_amdgcn_sched_barrier(0);
            }
    }
};

struct EpiRes {
    static constexpr bool PERM = false, AFTER_DRAIN = false, HAS_MID = false;
    const float* base; float* out; int ldc; bool st;
    __device__ __forceinline__ void operator()(const f32x4 (&acc)[2][2][4][2], const Unit& u, int wr, int wc, int fr, int fq) const {
        const int row0 = u.pm * BM + wr * 64 + fr, col0 = u.pn * BM + wc * 32 + 4 * fq;
#pragma unroll
        for (int ai = 0; ai < 2; ++ai)
#pragma unroll
            for (int m = 0; m < 4; ++m)
#pragma unroll
                for (int bj = 0; bj < 2; ++bj)
#pragma unroll
                    for (int n = 0; n < 2; ++n) {
                        const size_t o = (size_t)(row0 + ai * HALF + m * 16) * ldc + col0 + bj * HALF + 16 * n;
                        const f32x4 x = *(const f32x4*)(base + o);
                        if (st) *(f32x4*)(out + o) = x + acc[ai][bj][m][n];
                    }
    }
};
template <class Epi, class Sched, bool ALIGN_EPI = false, bool SP2 = false>
__device__ __forceinline__ void gemm_phase(PG8_LAS unsigned char* lds, const Gemm g, const Sched& S, const Epi& E) {
    const int tid = pg8::opaque_tid(), wid = __builtin_amdgcn_readfirstlane(tid >> 6), lane = tid & 63, wr = wid >> 2, wc = wid & 3, fr = lane & 15, fq = lane >> 4;
    const int K = g.K, nt = K / BK;
    unsigned voffA[2], voffB[2];
#pragma unroll
    for (int i = 0; i < 2; ++i) { int R, C; stage_rc(tid * 16 + i * 8192, R, C); const int Rb = Epi::PERM ? ((R & ~31) + perm32(R & 31)) : R;
        voffA[i] = (unsigned)(R * g.lda + C) * 2u; voffB[i] = (unsigned)(Rb * K + C) * 2u; }
    const size_t kstep = (size_t)(BK * 2);
    const size_t hstepA = (size_t)HALF * g.lda * 2, hstepB = (size_t)HALF * K * 2;
    const size_t tstepA = 2 * hstepA, tstepB = 2 * hstepB;
    const unsigned ldsw = (unsigned)wid * 1024u;
    const int aoff = lds_byte(wr * 64 + fr, fq * 8), boff = lds_byte(wc * 32 + fr, fq * 8);
#define PG8_SA(b, h) (((b) * 2 + (h)) * HTB)
#define PG8_SB(b, h) ((4 + (b) * 2 + (h)) * HTB)
#define PG8_STAGE(bufoff, gbase, voff) do { _Pragma("unroll") for (int _i = 0; _i < 2; ++_i) \
        __builtin_amdgcn_global_load_lds((const unsigned*)((const char*)(gbase) + (voff)[_i]), (PG8_LAS unsigned*)(lds + (bufoff) + ldsw + _i * 8192), 16, 0, 0); } while (0)
#define PG8_LDA(dst, b, h) do { _Pragma("unroll") for (int m = 0; m < 4; ++m) _Pragma("unroll") for (int k = 0; k < 2; ++k) dst[m][k] = *(const PG8_LAS bf16x8*)(lds + PG8_SA(b, h) + aoff + m * 2048 + k * 1024); } while (0)
#define PG8_LDB(dst, b, h) do { _Pragma("unroll") for (int n = 0; n < 2; ++n) _Pragma("unroll") for (int k = 0; k < 2; ++k) dst[n][k] = *(const PG8_LAS bf16x8*)(lds + PG8_SB(b, h) + boff + n * 2048 + k * 1024); } while (0)
#define PG8_MMA(ai, bj, At, Bt) do { __builtin_amdgcn_s_setprio(1); _Pragma("unroll") for (int m = 0; m < 4; ++m) _Pragma("unroll") for (int n = 0; n < 2; ++n) _Pragma("unroll") for (int k = 0; k < 2; ++k) \
        acc[ai][bj][m][n] = __builtin_amdgcn_mfma_f32_16x16x32_bf16(Bt[n][k], At[m][k], acc[ai][bj][m][n], 0, 0, 0); __builtin_amdgcn_s_setprio(0); } while (0)
#define PG8_WAIT_V(n) asm volatile("s_waitcnt vmcnt(" #n ")" ::: "memory")
#define PG8_WAIT_L(n) asm volatile("s_waitcnt lgkmcnt(" #n ")" ::: "memory")
#define PG8_BAR __builtin_amdgcn_s_barrier()
#define PG8_SCHED __builtin_amdgcn_sched_barrier(0)
    Unit cur, nxt; int ui = 0;
    if (!S.next(0, cur)) return;
    f32x4 acc[2][2][4][2];
#pragma unroll
    for (int a = 0; a < 2; ++a)
#pragma unroll
        for (int b = 0; b < 2; ++b)
#pragma unroll
            for (int m = 0; m < 4; ++m)
#pragma unroll
                for (int n = 0; n < 2; ++n) acc[a][b][m][n] = (f32x4){0.f, 0.f, 0.f, 0.f};
    bf16x8 At[4][2], B0[2][2], B1[2][2];
    const char* cA = (const char*)g.A + (size_t)cur.pm * tstepA; const char* cB = (const char*)g.Bt + (size_t)cur.pn * tstepB;
    S.a_ready(cur);
    if constexpr (SP2) {
        PG8_STAGE(PG8_SB(0, 0), cB, voffB); PG8_STAGE(PG8_SB(0, 1), cB + hstepB, voffB); PG8_STAGE(PG8_SA(0, 0), cA, voffA); PG8_STAGE(PG8_SA(0, 1), cA + hstepA, voffA);
        if (wr == 1) PG8_BAR;
        PG8_WAIT_V(2); PG8_BAR;
        PG8_STAGE(PG8_SB(1, 0), cB + kstep, voffB); PG8_STAGE(PG8_SA(1, 0), cA + kstep, voffA); PG8_STAGE(PG8_SB(1, 1), cB + hstepB + kstep, voffB);
        PG8_WAIT_V(6); PG8_BAR;
    } else {
        PG8_STAGE(PG8_SB(0, 0), cB, voffB); PG8_STAGE(PG8_SA(0, 0), cA, voffA); PG8_STAGE(PG8_SB(0, 1), cB + hstepB, voffB); PG8_STAGE(PG8_SA(0, 1), cA + hstepA, voffA);
        if (wr == 1) PG8_BAR;
        PG8_WAIT_V(4); PG8_BAR;
        PG8_STAGE(PG8_SB(1, 0), cB + kstep, voffB); PG8_STAGE(PG8_SA(1, 0), cA + kstep, voffA); PG8_STAGE(PG8_SB(1, 1), cB + hstepB + kstep, voffB);
        PG8_WAIT_V(6); PG8_BAR;
    }
    for (;;) {
        const bool has_next = S.next(ui + 1, nxt);
        const char* nA = has_next ? (const char*)g.A + (size_t)nxt.pm * tstepA : cA; const char* nB = has_next ? (const char*)g.Bt + (size_t)nxt.pn * tstepB : cB;
        for (int t = 0; t < nt; t += 2) {
            if constexpr (Epi::HAS_MID) { if (t != 0 && (t & 7) == 0) E.mid(acc, cur, t >> 3, wr, wc, fr, fq); }
            const bool last = (t == nt - 2);
            const char* a1 = cA + (size_t)(t + 1) * kstep;
            const char* a2 = last ? nA : cA + (size_t)(t + 2) * kstep; const char* b2 = last ? nB : cB + (size_t)(t + 2) * kstep;
            const char* a3 = a2 + kstep; const char* b3 = b2 + kstep;
            if (last && has_next) S.a_ready(nxt);
            if constexpr (SP2) {
            PG8_LDB(B0, 0, 0); PG8_LDB(B1, 0, 1); PG8_SCHED; PG8_LDA(At, 0, 0); PG8_STAGE(PG8_SA(1, 1), a1 + hstepA, voffA);
            PG8_WAIT_V(8); PG8_WAIT_L(0); PG8_BAR; PG8_MMA(0, 0, At, B0); PG8_MMA(0, 1, At, B1); PG8_BAR; PG8_SCHED;
            PG8_LDA(At, 0, 1); PG8_STAGE(PG8_SB(0, 0), b2, voffB); PG8_STAGE(PG8_SB(0, 1), b2 + hstepB, voffB); PG8_STAGE(PG8_SA(0, 0), a2, voffA);
            PG8_WAIT_V(8); PG8_WAIT_L(0); PG8_BAR; PG8_MMA(1, 0, At, B0); PG8_MMA(1, 1, At, B1); PG8_BAR; PG8_SCHED;
            PG8_LDB(B0, 1, 0); PG8_LDB(B1, 1, 1); PG8_SCHED; PG8_LDA(At, 1, 0); PG8_STAGE(PG8_SA(0, 1), a2 + hstepA, voffA);
            PG8_WAIT_V(8); PG8_WAIT_L(0); PG8_BAR; PG8_MMA(0, 0, At, B0); PG8_MMA(0, 1, At, B1); PG8_BAR; PG8_SCHED;
            PG8_LDA(At, 1, 1); PG8_STAGE(PG8_SB(1, 0), b3, voffB); PG8_STAGE(PG8_SB(1, 1), b3 + hstepB, voffB); PG8_STAGE(PG8_SA(1, 0), a3, voffA);
            PG8_WAIT_V(8); PG8_WAIT_L(0); PG8_BAR; PG8_MMA(1, 0, At, B0); PG8_MMA(1, 1, At, B1); PG8_BAR; PG8_SCHED;
            } else {
            PG8_LDB(B0, 0, 0); PG8_SCHED; PG8_LDA(At, 0, 0); PG8_STAGE(PG8_SA(1, 1), a1 + hstepA, voffA);
            PG8_WAIT_L(8); PG8_BAR; PG8_WAIT_L(0); PG8_MMA(0, 0, At, B0); PG8_BAR; PG8_SCHED;
            PG8_LDB(B1, 0, 1); PG8_STAGE(PG8_SB(0, 0), b2, voffB);
            PG8_BAR; PG8_WAIT_L(0); PG8_MMA(0, 1, At, B1); PG8_BAR;
            PG8_LDA(At, 0, 1); PG8_STAGE(PG8_SA(0, 0), a2, voffA);
            PG8_BAR; PG8_WAIT_L(0); PG8_MMA(1, 0, At, B0); PG8_BAR; PG8_SCHED;
            PG8_STAGE(PG8_SB(0, 1), b2 + hstepB, voffB);
            PG8_WAIT_V(6); PG8_BAR; PG8_MMA(1, 1, At, B1); PG8_BAR;
            PG8_LDB(B0, 1, 0); PG8_SCHED; PG8_LDA(At, 1, 0); PG8_STAGE(PG8_SA(0, 1), a2 + hstepA, voffA);
            PG8_WAIT_L(8); PG8_BAR; PG8_WAIT_L(0); PG8_MMA(0, 0, At, B0); PG8_BAR; PG8_SCHED;
            PG8_LDB(B1, 1, 1); PG8_STAGE(PG8_SB(1, 0), b3, voffB);
            PG8_BAR; PG8_WAIT_L(0); PG8_MMA(0, 1, At, B1); PG8_BAR;
            PG8_LDA(At, 1, 1); PG8_STAGE(PG8_SA(1, 0), a3, voffA);
            PG8_BAR; PG8_WAIT_L(0); PG8_MMA(1, 0, At, B0); PG8_BAR; PG8_SCHED;
            PG8_STAGE(PG8_SB(1, 1), b3 + hstepB, voffB);
            PG8_WAIT_V(6); PG8_BAR; PG8_MMA(1, 1, At, B1); PG8_BAR;
            }
        }
        if constexpr (ALIGN_EPI) { if (wr == 0) PG8_BAR; }
        if constexpr (!Epi::AFTER_DRAIN) { E(acc, cur, wr, wc, fr, fq); S.done(cur); }
        if (!has_next) break;
#pragma unroll
        for (int a = 0; a < 2; ++a)
#pragma unroll
            for (int b = 0; b < 2; ++b)
#pragma unroll
                for (int m = 0; m < 4; ++m)
#pragma unroll
                    for (int n = 0; n < 2; ++n) acc[a][b][m][n] = (f32x4){0.f, 0.f, 0.f, 0.f};
        cur = nxt; cA = nA; cB = nB; ++ui;
        if constexpr (ALIGN_EPI) { if (wr == 1) PG8_BAR; }
    }
    PG8_WAIT_V(0);
    if constexpr (!ALIGN_EPI) { if (wr == 0) PG8_BAR; }
    PG8_BAR;
    if constexpr (Epi::AFTER_DRAIN) { E.fused(acc, cur, wr, wc, fr, fq, lds, wid, lane); S.done(cur); }
#undef PG8_SA
#undef PG8_SB
#undef PG8_STAGE
#undef PG8_LDA
#undef PG8_LDB
#undef PG8_MMA
#undef PG8_WAIT_V
#undef PG8_WAIT_L
#undef PG8_BAR
#undef PG8_SCHED
}
}
constexpr int NWAVES = 8, NTHR = 512;
constexpr int BATCH = 8, SEQ = 2048, DM = 1024, T = BATCH * SEQ, DEPTH = 2, MEML = 256, MEMT = BATCH * MEML;
constexpr int INW = 9632, INWP = 9728, NA = 5632  , MIXW = 3584, GW = 2048, GATEW = 4096;
constexpr float EPS = 1e-6f;
constexpr int MC_CQ = 0, MC_CKV = 256, MC_KR = 384, MC_BG = 512, MC_CG = 1024, MC_XIN = 1536, MC_U = 2048, MC_V = 2560, MC_MQ = 3072;
constexpr size_t MiB = 1u << 20;
constexpr size_t WS_W0 = 1 * MiB, WS_W1 = 275 * MiB;
constexpr size_t WO_WIN = 0, WO_WUQ = 19 * MiB, WO_WUKV = WO_WUQ + 768 * 256 * 2, WO_WBR = WO_WUKV + 1024 * 128 * 2, WO_WOUT = WO_WBR + 4 * MiB, WO_END = WO_WOUT + 2 * MiB;
static_assert(WO_END <= 26 * MiB, "weights");
constexpr size_t WS_MEMK = 27 * MiB, WS_MEMVT = 31 * MiB;
constexpr size_t WS_MIX = 35 * MiB, WS_GATE = 35 * MiB;
constexpr size_t WS_Q = 147 * MiB, WS_K = 171 * MiB, WS_VT = 195 * MiB, WS_H = 179 * MiB, WS_MERGED = 179 * MiB;
constexpr size_t WS_WMEMT = 147 * MiB, WS_MEMN = 151 * MiB, WS_KVRAW = 159 * MiB;
constexpr size_t WS_G = 211 * MiB, WS_END = 301 * MiB;
constexpr int LDS_BYTES = 147456;

#define LAS __attribute__((address_space(3)))
typedef unsigned short bf16;
typedef unsigned v4u __attribute__((ext_vector_type(4)));
typedef unsigned v2u __attribute__((ext_vector_type(2)));
typedef float f32x4 __attribute__((ext_vector_type(4)));
typedef short bf16x8 __attribute__((ext_vector_type(8)));
using pg8::cvt_pk_bf16; using pg8::bflo; using pg8::bfhi; using pg8::sigm;

__device__ __forceinline__ float wave_sum(float v) {
#pragma unroll
    for (int o = 1; o < 64; o <<= 1) v += __shfl_xor(v, o);
    return v;
}
__device__ __forceinline__ f32x4 mfma16(bf16x8 a, bf16x8 b, f32x4 c) { return __builtin_amdgcn_mfma_f32_16x16x32_bf16(a, b, c, 0, 0, 0); }
__device__ __forceinline__ bf16x8 as_bf8(v4u v) { return __builtin_bit_cast(bf16x8, v); }

struct Args { const float* in[24]; float* out; unsigned char* ws; int ph_lo, ph_hi; };

__device__ __forceinline__ void tr_item(const float* W, int K, int N, bf16* WT, int ldt, int coff, int win, LAS float* scr, int item, int lane) {
    const int nblk = N / 32, kb = item / nblk, nb = item % nblk, k0 = 64 * kb, n0 = 32 * nb;
    const int radd = (win && n0 >= 416) ? 96 : 0;
#pragma unroll 8
    for (int i = 0; i < 32; ++i) { const int kk = 2 * i + (lane >> 5); scr[kk * 33 + (lane & 31)] = W[(size_t)(k0 + kk) * N + n0 + (lane & 31)]; }
    asm volatile("s_waitcnt lgkmcnt(0)" ::: "memory");
    const int c = lane & 7;
#pragma unroll
    for (int j = 0; j < 4; ++j) { const int n = (lane >> 3) + 8 * j; const LAS float* s = scr + (8 * c) * 33 + n;
        v4u o; o.x = cvt_pk_bf16(s[0 * 33], s[1 * 33]); o.y = cvt_pk_bf16(s[2 * 33], s[3 * 33]); o.z = cvt_pk_bf16(s[4 * 33], s[5 * 33]); o.w = cvt_pk_bf16(s[6 * 33], s[7 * 33]);
        *(v4u*)(WT + (size_t)(radd + n0 + n) * ldt + coff + k0 + 8 * c) = o; }
    asm volatile("s_waitcnt lgkmcnt(0)" ::: "memory");
}
__device__ __forceinline__ void rms_row(const float* xrow, const float* g, bf16* orow, int lane) {
    const f32x4* xr = (const f32x4*)xrow + lane; const f32x4* gr = (const f32x4*)g + lane;
    f32x4 v[4]; float s = 0.f;
#pragma unroll
    for (int j = 0; j < 4; ++j) { v[j] = xr[64 * j]; s += (v[j].x * v[j].x + v[j].y * v[j].y) + (v[j].z * v[j].z + v[j].w * v[j].w); }
    const float rstd = 1.0f / sqrtf(wave_sum(s) * (1.f / 1024.f) + EPS);
    v2u* o8 = (v2u*)orow + lane;
#pragma unroll
    for (int j = 0; j < 4; ++j) { const f32x4 gg = gr[64 * j]; v2u o; o.x = cvt_pk_bf16(v[j].x * rstd * gg.x, v[j].y * rstd * gg.y); o.y = cvt_pk_bf16(v[j].z * rstd * gg.z, v[j].w * rstd * gg.w); o8[64 * j] = o; }
}
__device__ __forceinline__ void norm_rows(const float* x, const float* g, bf16* H, int rows, int bid, int nb) {
    const int tid = pg8::opaque_tid(), lane = tid & 63, gw = bid * NWAVES + (tid >> 6), ngw = nb * NWAVES;
    const f32x4* gr = (const f32x4*)g + lane;
    for (int m = gw; m < rows; m += 2 * ngw) {
        const int m2 = m + ngw; const bool has2 = m2 < rows;
        const f32x4* xa = (const f32x4*)(x + (size_t)m * DM) + lane; const f32x4* xb = (const f32x4*)(x + (size_t)(has2 ? m2 : m) * DM) + lane;
        f32x4 va[4], vb[4]; float sa = 0.f, sb = 0.f;
#pragma unroll
        for (int j = 0; j < 4; ++j) { va[j] = xa[64 * j]; vb[j] = xb[64 * j]; }
#pragma unroll
        for (int j = 0; j < 4; ++j) { sa += (va[j].x * va[j].x + va[j].y * va[j].y) + (va[j].z * va[j].z + va[j].w * va[j].w); sb += (vb[j].x * vb[j].x + vb[j].y * vb[j].y) + (vb[j].z * vb[j].z + vb[j].w * vb[j].w); }
        const float ra = 1.0f / sqrtf(wave_sum(sa) * (1.f / 1024.f) + EPS), rb = 1.0f / sqrtf(wave_sum(sb) * (1.f / 1024.f) + EPS);
        v2u* oa = (v2u*)(H + (size_t)m * DM) + lane; v2u* ob = (v2u*)(H + (size_t)m2 * DM) + lane;
#pragma unroll
        for (int j = 0; j < 4; ++j) { const f32x4 gg = gr[64 * j]; v2u o;
            o.x = cvt_pk_bf16(va[j].x * ra * gg.x, va[j].y * ra * gg.y); o.y = cvt_pk_bf16(va[j].z * ra * gg.z, va[j].w * ra * gg.w); oa[64 * j] = o;
            if (has2) { o.x = cvt_pk_bf16(vb[j].x * rb * gg.x, vb[j].y * rb * gg.y); o.y = cvt_pk_bf16(vb[j].z * rb * gg.z, vb[j].w * rb * gg.w); ob[64 * j] = o; } }
    }
}

__device__ __forceinline__ void ph_prologue(const Args& a, LAS unsigned char* lds, int bid, int nb) {
    const int tid = pg8::opaque_tid(), lane = tid & 63, wave = tid >> 6;
    LAS float* scr = (LAS float*)(lds + wave * 16384);
    const int gw = bid * NWAVES + wave, ngw = nb * NWAVES;
    constexpr int I_IN = 16 * 301, I_UQ = 4 * 24, I_UKV = 2 * 32, I_MEM = 16 * 32, I_BR = 8 * 32, I_OUT = 16 * 32;
    constexpr int PER_L = I_IN + I_UQ + I_UKV + I_MEM + 4 * I_BR + I_OUT;
    for (int it0 = gw; it0 < 2 * PER_L; it0 += ngw) {
        const int l = it0 / PER_L; int r = it0 % PER_L;
        unsigned char* wb = a.ws + (l ? WS_W1 : WS_W0);
        if (r < I_IN) { tr_item(a.in[4] + (size_t)l * DM * INW, DM, INW, (bf16*)(wb + WO_WIN), DM, 0, 1, scr, r, lane); continue; } r -= I_IN;
        if (r < I_UQ) { tr_item(a.in[7] + (size_t)l * 256 * 768, 256, 768, (bf16*)(wb + WO_WUQ), 256, 0, 0, scr, r, lane); continue; } r -= I_UQ;
        if (r < I_UKV) { tr_item(a.in[8] + (size_t)l * 128 * 1024, 128, 1024, (bf16*)(wb + WO_WUKV), 128, 0, 0, scr, r, lane); continue; } r -= I_UKV;
        if (r < I_MEM) { tr_item(a.in[18] + (size_t)l * DM * 1024, DM, 1024, (bf16*)(a.ws + WS_WMEMT + l * 2 * MiB), DM, 0, 0, scr, r, lane); continue; } r -= I_MEM;
        if (r < 4 * I_BR) { const int n = r / I_BR; tr_item(a.in[22] + ((size_t)l * 4 + n) * 512 * DM, 512, DM, (bf16*)(wb + WO_WBR), 2048, n * 512, 0, scr, r % I_BR, lane); continue; } r -= 4 * I_BR;
        tr_item(a.in[23] + (size_t)l * DM * DM, DM, DM, (bf16*)(wb + WO_WOUT), DM, 0, 0, scr, r, lane);
    }
    for (int i = bid * NTHR + tid; i < 2 * 96 * 128; i += nb * NTHR) { const int l = i / (96 * 128), r = i % (96 * 128);
        *(v4u*)(a.ws + (l ? WS_W1 : WS_W0) + WO_WIN + (size_t)(416 * 1024) * 2 + (size_t)r * 16) = (v4u){0u, 0u, 0u, 0u}; }
    for (int l = 0; l < 2; ++l) norm_rows(a.in[1], a.in[17] + l * DM, (bf16*)(a.ws + WS_MEMN + l * 4 * MiB), MEMT, bid, nb);
    norm_rows(a.in[0], a.in[3], (bf16*)a.out, T, bid, nb);
}

__device__ __forceinline__ void ph_mempost(const Args& a, int bid, int nb) {
    const int tid = pg8::opaque_tid(), lane = tid & 63, wave = tid >> 6;
    const int gw = bid * NWAVES + wave, ngw = nb * NWAVES;
    for (int it = gw; it < 2 * MEMT * 4; it += ngw) {
        const int l = it / (MEMT * 4), r = (it / 4) % MEMT, h = it & 3, b = r >> 8, m = r & 255;
        const bf16* kv = (const bf16*)(a.ws + WS_KVRAW + l * 4 * MiB) + (size_t)r * 1024;
        const unsigned ku = *(const unsigned*)(kv + h * 128 + 2 * lane);
        const float k0 = bflo(ku), k1 = bfhi(ku);
        const float rstd = 1.0f / sqrtf(wave_sum(k0 * k0 + k1 * k1) * (1.f / 128.f) + EPS);
        const float* kg = a.in[20] + l * 128;
        bf16* mk = (bf16*)(a.ws + WS_MEMK + l * 2 * MiB) + ((size_t)(b * 4 + h) * 256 + m) * 128;
        *(unsigned*)(mk + 2 * lane) = cvt_pk_bf16(k0 * rstd * kg[2 * lane], k1 * rstd * kg[2 * lane + 1]);
        const unsigned vu = *(const unsigned*)(kv + 512 + h * 128 + 2 * lane);
        bf16* mv = (bf16*)(a.ws + WS_MEMVT + l * 2 * MiB) + ((size_t)(b * 4 + h) * 128 + 2 * lane) * 256 + m;
        mv[0] = (bf16)(vu & 0xffffu); mv[256] = (bf16)(vu >> 16);
    }
}

__device__ __forceinline__ void ph_p2(const Args& a, int l, LAS unsigned char* lds, int bid, int nb) {
    const int tid = pg8::opaque_tid(), lane = tid & 63, w = tid >> 6, c16 = lane & 15, q4 = lane >> 4;
    const bf16* MIX = (const bf16*)(a.ws + WS_MIX);
    const unsigned char* wb = a.ws + (l ? WS_W1 : WS_W0);
    const bf16* WuqT = (const bf16*)(wb + WO_WUQ); const bf16* WukvT = (const bf16*)(wb + WO_WUKV);
    const float* cqg = a.in[5] + l * 256; const float* ckvg = a.in[6] + l * 128; const float* qg = a.in[9] + l * 96; const float* kg = a.in[10] + l * 96;
    const int* pos = (const int*)a.in[2];
    bf16* Qb = (bf16*)(a.ws + WS_Q); bf16* Kb = (bf16*)(a.ws + WS_K); bf16* Vtb = (bf16*)(a.ws + WS_VT);
    constexpr int AQ_LD = 264, AKV_LD = 136;
    LAS bf16* Aq = (LAS bf16*)lds; LAS bf16* Akv = (LAS bf16*)(lds + 33792);
    LAS float* kr = (LAS float*)(lds + 51200); LAS float* cs = (LAS float*)(lds + 59392); LAS float* sn = (LAS float*)(lds + 63488);
    for (int u = bid; u < T / 64; u += nb) {
        const int t0 = u * 64;
        __syncthreads();
        {
            const int row = tid >> 3, part = tid & 7;
            const bf16* src = MIX + (size_t)(t0 + row) * MIXW;
            v4u x[4]; float ss = 0.f;
#pragma unroll
            for (int i = 0; i < 4; ++i) { x[i] = *(const v4u*)(src + MC_CQ + part * 32 + i * 8);
                ss += bflo(x[i].x) * bflo(x[i].x) + bfhi(x[i].x) * bfhi(x[i].x) + bflo(x[i].y) * bflo(x[i].y) + bfhi(x[i].y) * bfhi(x[i].y)
                    + bflo(x[i].z) * bflo(x[i].z) + bfhi(x[i].z) * bfhi(x[i].z) + bflo(x[i].w) * bflo(x[i].w) + bfhi(x[i].w) * bfhi(x[i].w); }
            ss += __shfl_xor(ss, 1); ss += __shfl_xor(ss, 2); ss += __shfl_xor(ss, 4);
            float rstd = 1.0f / sqrtf(ss * (1.f / 256.f) + EPS);
#pragma unroll
            for (int i = 0; i < 4; ++i) { const float* gp = cqg + part * 32 + i * 8; v4u o;
                o.x = cvt_pk_bf16(bflo(x[i].x) * rstd * gp[0], bfhi(x[i].x) * rstd * gp[1]); o.y = cvt_pk_bf16(bflo(x[i].y) * rstd * gp[2], bfhi(x[i].y) * rstd * gp[3]);
                o.z = cvt_pk_bf16(bflo(x[i].z) * rstd * gp[4], bfhi(x[i].z) * rstd * gp[5]); o.w = cvt_pk_bf16(bflo(x[i].w) * rstd * gp[6], bfhi(x[i].w) * rstd * gp[7]);
                *(LAS v4u*)(Aq + row * AQ_LD + part * 32 + i * 8) = o; }
            v4u y[2]; ss = 0.f;
#pragma unroll
            for (int i = 0; i < 2; ++i) { y[i] = *(const v4u*)(src + MC_CKV + part * 16 + i * 8);
                ss += bflo(y[i].x) * bflo(y[i].x) + bfhi(y[i].x) * bfhi(y[i].x) + bflo(y[i].y) * bflo(y[i].y) + bfhi(y[i].y) * bfhi(y[i].y)
                    + bflo(y[i].z) * bflo(y[i].z) + bfhi(y[i].z) * bfhi(y[i].z) + bflo(y[i].w) * bflo(y[i].w) + bfhi(y[i].w) * bfhi(y[i].w); }
            ss += __shfl_xor(ss, 1); ss += __shfl_xor(ss, 2); ss += __shfl_xor(ss, 4);
            rstd = 1.0f / sqrtf(ss * (1.f / 128.f) + EPS);
#pragma unroll
            for (int i = 0; i < 2; ++i) { const float* gp = ckvg + part * 16 + i * 8; v4u o;
                o.x = cvt_pk_bf16(bflo(y[i].x) * rstd * gp[0], bfhi(y[i].x) * rstd * gp[1]); o.y = cvt_pk_bf16(bflo(y[i].y) * rstd * gp[2], bfhi(y[i].y) * rstd * gp[3]);
                o.z = cvt_pk_bf16(bflo(y[i].z) * rstd * gp[4], bfhi(y[i].z) * rstd * gp[5]); o.w = cvt_pk_bf16(bflo(y[i].w) * rstd * gp[6], bfhi(y[i].w) * rstd * gp[7]);
                *(LAS v4u*)(Akv + row * AKV_LD + part * 16 + i * 8) = o; }
            const v2u z = *(const v2u*)(src + MC_KR + part * 4);
            kr[row * 32 + part * 4 + 0] = bflo(z.x); kr[row * 32 + part * 4 + 1] = bfhi(z.x); kr[row * 32 + part * 4 + 2] = bflo(z.y); kr[row * 32 + part * 4 + 3] = bfhi(z.y);
#pragma unroll
            for (int i = 0; i < 2; ++i) { const int e = tid * 2 + i, r = e >> 4, f = e & 15;
                const float invf = exp2f(-(float)f * (13.287712379549449f / 16.0f));
                const float ang = (float)pos[t0 + r] * invf; float sv, cv; sincosf(ang, &sv, &cv); cs[e] = cv; sn[e] = sv; }
        }
        __syncthreads();
        const int h = w;
        {
            f32x4 acc[4][6];
#pragma unroll
            for (int mt = 0; mt < 4; ++mt)
#pragma unroll
                for (int nt = 0; nt < 6; ++nt) acc[mt][nt] = (f32x4){0.f, 0.f, 0.f, 0.f};
#pragma unroll 1
            for (int ks = 0; ks < 8; ++ks) {
                bf16x8 tf[4];
#pragma unroll
                for (int mt = 0; mt < 4; ++mt) tf[mt] = as_bf8(*(const LAS v4u*)(Aq + (mt * 16 + c16) * AQ_LD + ks * 32 + 8 * q4));
#pragma unroll
                for (int nt = 0; nt < 6; ++nt) {
                    const bf16x8 wf = as_bf8(*(const v4u*)(WuqT + (size_t)(h * 96 + nt * 16 + c16) * 256 + ks * 32 + 8 * q4));
#pragma unroll
                    for (int mt = 0; mt < 4; ++mt) acc[mt][nt] = mfma16(wf, tf[mt], acc[mt][nt]);
                }
            }
#pragma unroll
            for (int mt = 0; mt < 4; ++mt) {
                float ss = 0.f;
#pragma unroll
                for (int nt = 0; nt < 6; ++nt) ss += acc[mt][nt][0] * acc[mt][nt][0] + acc[mt][nt][1] * acc[mt][nt][1] + acc[mt][nt][2] * acc[mt][nt][2] + acc[mt][nt][3] * acc[mt][nt][3];
                ss += __shfl_xor(ss, 16); ss += __shfl_xor(ss, 32);
                const float rstd = 1.0f / sqrtf(ss * (1.f / 96.f) + EPS);
                const int r = mt * 16 + c16, t = t0 + r, b = t >> 11, s = t & 2047;
                bf16* qrow = Qb + ((size_t)(b * 8 + h) * SEQ + s) * 96;
#pragma unroll
                for (int nt = 0; nt < 4; ++nt) { const float* gp = qg + nt * 16 + 4 * q4; v2u o;
                    o.x = cvt_pk_bf16(acc[mt][nt][0] * rstd * gp[0], acc[mt][nt][1] * rstd * gp[1]); o.y = cvt_pk_bf16(acc[mt][nt][2] * rstd * gp[2], acc[mt][nt][3] * rstd * gp[3]);
                    *(v2u*)(qrow + nt * 16 + 4 * q4) = o; }
                float o1[4], o2[4];
#pragma unroll
                for (int j = 0; j < 4; ++j) { const int f = 4 * q4 + j; const float x1 = acc[mt][4][j] * rstd * qg[64 + f], x2 = acc[mt][5][j] * rstd * qg[80 + f];
                    const float cv = cs[r * 16 + f], sv = sn[r * 16 + f]; o1[j] = x1 * cv - x2 * sv; o2[j] = x1 * sv + x2 * cv; }
                v2u p1, p2; p1.x = cvt_pk_bf16(o1[0], o1[1]); p1.y = cvt_pk_bf16(o1[2], o1[3]); p2.x = cvt_pk_bf16(o2[0], o2[1]); p2.y = cvt_pk_bf16(o2[2], o2[3]);
                *(v2u*)(qrow + 64 + 4 * q4) = p1; *(v2u*)(qrow + 80 + 4 * q4) = p2;
            }
        }
        __builtin_amdgcn_sched_barrier(0);
        {
            f32x4 acc[4][4];
#pragma unroll
            for (int mt = 0; mt < 4; ++mt)
#pragma unroll
                for (int nt = 0; nt < 4; ++nt) acc[mt][nt] = (f32x4){0.f, 0.f, 0.f, 0.f};
#pragma unroll 1
            for (int ks = 0; ks < 4; ++ks) {
                bf16x8 tf[4];
#pragma unroll
                for (int mt = 0; mt < 4; ++mt) tf[mt] = as_bf8(*(const LAS v4u*)(Akv + (mt * 16 + c16) * AKV_LD + ks * 32 + 8 * q4));
#pragma unroll
                for (int nt = 0; nt < 4; ++nt) {
                    const bf16x8 wf = as_bf8(*(const v4u*)(WukvT + (size_t)(h * 128 + nt * 16 + c16) * 128 + ks * 32 + 8 * q4));
#pragma unroll
                    for (int mt = 0; mt < 4; ++mt) acc[mt][nt] = mfma16(wf, tf[mt], acc[mt][nt]);
                }
            }
#pragma unroll
            for (int mt = 0; mt < 4; ++mt) {
                const int r = mt * 16 + c16, t = t0 + r, b = t >> 11, s = t & 2047;
                float kr1[4], kr2[4]; float ss = 0.f;
#pragma unroll
                for (int j = 0; j < 4; ++j) { kr1[j] = kr[r * 32 + 4 * q4 + j]; kr2[j] = kr[r * 32 + 16 + 4 * q4 + j]; ss += kr1[j] * kr1[j] + kr2[j] * kr2[j]; }
#pragma unroll
                for (int nt = 0; nt < 4; ++nt) ss += acc[mt][nt][0] * acc[mt][nt][0] + acc[mt][nt][1] * acc[mt][nt][1] + acc[mt][nt][2] * acc[mt][nt][2] + acc[mt][nt][3] * acc[mt][nt][3];
                ss += __shfl_xor(ss, 16); ss += __shfl_xor(ss, 32);
                const float rstd = 1.0f / sqrtf(ss * (1.f / 96.f) + EPS);
                bf16* krow = Kb + ((size_t)(b * 8 + h) * SEQ + s) * 96;
#pragma unroll
                for (int nt = 0; nt < 4; ++nt) { const float* gp = kg + nt * 16 + 4 * q4; v2u o;
                    o.x = cvt_pk_bf16(acc[mt][nt][0] * rstd * gp[0], acc[mt][nt][1] * rstd * gp[1]); o.y = cvt_pk_bf16(acc[mt][nt][2] * rstd * gp[2], acc[mt][nt][3] * rstd * gp[3]);
                    *(v2u*)(krow + nt * 16 + 4 * q4) = o; }
                float o1[4], o2[4];
#pragma unroll
                for (int j = 0; j < 4; ++j) { const int f = 4 * q4 + j; const float x1 = kr1[j] * rstd * kg[64 + f], x2 = kr2[j] * rstd * kg[80 + f];
                    const float cv = cs[r * 16 + f], sv = sn[r * 16 + f]; o1[j] = x1 * cv - x2 * sv; o2[j] = x1 * sv + x2 * cv; }
                v2u p1, p2; p1.x = cvt_pk_bf16(o1[0], o1[1]); p1.y = cvt_pk_bf16(o1[2], o1[3]); p2.x = cvt_pk_bf16(o2[0], o2[1]); p2.y = cvt_pk_bf16(o2[2], o2[3]);
                *(v2u*)(krow + 64 + 4 * q4) = p1; *(v2u*)(krow + 80 + 4 * q4) = p2;
            }
        }
        __builtin_amdgcn_sched_barrier(0);
        {
            f32x4 acc[4][4];
#pragma unroll
            for (int mt = 0; mt < 4; ++mt)
#pragma unroll
                for (int nt = 0; nt < 4; ++nt) acc[mt][nt] = (f32x4){0.f, 0.f, 0.f, 0.f};
#pragma unroll 1
            for (int ks = 0; ks < 4; ++ks) {
                bf16x8 tf[4];
#pragma unroll
                for (int mt = 0; mt < 4; ++mt) tf[mt] = as_bf8(*(const LAS v4u*)(Akv + (mt * 16 + c16) * AKV_LD + ks * 32 + 8 * q4));
#pragma unroll
                for (int nt = 0; nt < 4; ++nt) {
                    const bf16x8 wf = as_bf8(*(const v4u*)(WukvT + (size_t)(h * 128 + 64 + nt * 16 + c16) * 128 + ks * 32 + 8 * q4));
#pragma unroll
                    for (int mt = 0; mt < 4; ++mt) acc[mt][nt] = mfma16(wf, tf[mt], acc[mt][nt]);
                }
            }
#pragma unroll
            for (int mt = 0; mt < 4; ++mt) {
                const int r = mt * 16 + c16, t = t0 + r, b = t >> 11, s = t & 2047;
                bf16* vcol = Vtb + (size_t)(b * 8 + h) * 64 * SEQ + s;
#pragma unroll
                for (int nt = 0; nt < 4; ++nt)
#pragma unroll
                    for (int j = 0; j < 4; ++j) { const int d = nt * 16 + 4 * q4 + j; vcol[(size_t)d * SEQ] = (bf16)(cvt_pk_bf16(acc[mt][nt][j], 0.f) & 0xffffu); }
            }
        }
    }
}
template <int DQK, int DV, bool CAUSAL, bool QNORM>
__device__ __forceinline__ void attn_block(LAS unsigned char* lds, const bf16* Qp, int qpitch, const float* qg, const bf16* Kp, const bf16* Vtp, int vpitch,
                                           int nkt, int row0seq, float scale_log2, bf16* Gp, int gpitch, bool st) {
    constexpr int KS = DQK / 32, DT = DV / 16, KROW = DQK + 8, VROW = 72, KBUF = 64 * KROW * 2, VBUF = DV * VROW * 2;
    constexpr int NKC = 8 * DQK, NVC = 8 * DV, KPT = (NKC + NTHR - 1) / NTHR, VPT = (NVC + NTHR - 1) / NTHR;
    static_assert(2 * KBUF + 2 * VBUF <= 131072, "attention LDS");
    const int tid = pg8::opaque_tid(), lane = tid & 63, w = tid >> 6, c16 = lane & 15, q4 = lane >> 4;
    __syncthreads();
    bf16x8 qf[2][KS];
    {
        v4u raw[2][KS];
#pragma unroll
        for (int qt = 0; qt < 2; ++qt)
#pragma unroll
            for (int ks = 0; ks < KS; ++ks) raw[qt][ks] = *(const v4u*)(Qp + (size_t)(32 * w + 16 * qt + c16) * qpitch + ks * 32 + 8 * q4);
        if (QNORM) {
#pragma unroll
            for (int qt = 0; qt < 2; ++qt) {
                float ss = 0.f;
#pragma unroll
                for (int ks = 0; ks < KS; ++ks) { const v4u x = raw[qt][ks];
                    ss += bflo(x.x) * bflo(x.x) + bfhi(x.x) * bfhi(x.x) + bflo(x.y) * bflo(x.y) + bfhi(x.y) * bfhi(x.y) + bflo(x.z) * bflo(x.z) + bfhi(x.z) * bfhi(x.z) + bflo(x.w) * bflo(x.w) + bfhi(x.w) * bfhi(x.w); }
                ss += __shfl_xor(ss, 16); ss += __shfl_xor(ss, 32);
                const float rstd = 1.0f / sqrtf(ss * (1.f / DQK) + EPS);
#pragma unroll
                for (int ks = 0; ks < KS; ++ks) { const v4u x = raw[qt][ks]; const float* gp = qg + ks * 32 + 8 * q4; v4u o;
                    o.x = cvt_pk_bf16(bflo(x.x) * rstd * gp[0], bfhi(x.x) * rstd * gp[1]); o.y = cvt_pk_bf16(bflo(x.y) * rstd * gp[2], bfhi(x.y) * rstd * gp[3]);
                    o.z = cvt_pk_bf16(bflo(x.z) * rstd * gp[4], bfhi(x.z) * rstd * gp[5]); o.w = cvt_pk_bf16(bflo(x.w) * rstd * gp[6], bfhi(x.w) * rstd * gp[7]);
                    raw[qt][ks] = o; }
            }
        }
#pragma unroll
        for (int qt = 0; qt < 2; ++qt)
#pragma unroll
            for (int ks = 0; ks < KS; ++ks) qf[qt][ks] = as_bf8(raw[qt][ks]);
    }
    v4u kreg[KPT], vreg[VPT];
#define ATT_GLOAD(kt) do { \
    _Pragma("unroll") for (int i = 0; i < KPT; ++i) { const int ch = tid + i * NTHR; if (ch < NKC) kreg[i] = *(const v4u*)(Kp + (size_t)(kt) * 64 * DQK + (size_t)ch * 8); } \
    _Pragma("unroll") for (int i = 0; i < VPT; ++i) { const int ch = tid + i * NTHR; if (ch < NVC) vreg[i] = *(const v4u*)(Vtp + (size_t)(ch >> 3) * vpitch + (kt) * 64 + (ch & 7) * 8); } } while (0)
#define ATT_LSTORE(buf) do { \
    _Pragma("unroll") for (int i = 0; i < KPT; ++i) { const int ch = tid + i * NTHR; if (ch < NKC) *(LAS v4u*)(lds + (buf) * KBUF + (ch / (DQK / 8)) * (KROW * 2) + (ch % (DQK / 8)) * 16) = kreg[i]; } \
    _Pragma("unroll") for (int i = 0; i < VPT; ++i) { const int ch = tid + i * NTHR; if (ch < NVC) *(LAS v4u*)(lds + 2 * KBUF + (buf) * VBUF + (ch >> 3) * (VROW * 2) + (ch & 7) * 16) = vreg[i]; } } while (0)
    ATT_GLOAD(0); ATT_LSTORE(0);
    __syncthreads();
    float m_run[2] = {-1e30f, -1e30f}, l_run[2] = {0.f, 0.f};
    f32x4 o[DT][2];
#pragma unroll
    for (int dt = 0; dt < DT; ++dt) { o[dt][0] = (f32x4){0.f, 0.f, 0.f, 0.f}; o[dt][1] = (f32x4){0.f, 0.f, 0.f, 0.f}; }
    const int rw0 = row0seq + 32 * w;
    for (int kt = 0; kt < nkt; ++kt) {
        if (kt + 1 < nkt) ATT_GLOAD(kt + 1);
        const int k0 = kt * 64;
        const bool active = !CAUSAL || (k0 <= rw0 + 31);
        if (active) {
            const LAS unsigned char* kb = lds + (kt & 1) * KBUF; const LAS unsigned char* vb = lds + 2 * KBUF + (kt & 1) * VBUF;
            f32x4 s[4][2];
#pragma unroll
            for (int kk = 0; kk < 4; ++kk) { s[kk][0] = (f32x4){0.f, 0.f, 0.f, 0.f}; s[kk][1] = (f32x4){0.f, 0.f, 0.f, 0.f}; }
#pragma unroll
            for (int kk = 0; kk < 4; ++kk)
#pragma unroll
                for (int ks = 0; ks < KS; ++ks) { const bf16x8 kf = as_bf8(*(const LAS v4u*)(kb + (kk * 16 + c16) * (KROW * 2) + (ks * 32 + 8 * q4) * 2));
                    s[kk][0] = mfma16(kf, qf[0][ks], s[kk][0]); s[kk][1] = mfma16(kf, qf[1][ks], s[kk][1]); }
            const bool needmask = CAUSAL && (k0 + 63 > rw0);
            bf16x8 pf[2][2];
#pragma unroll
            for (int qt = 0; qt < 2; ++qt) {
                const int rowi = rw0 + 16 * qt + c16;
                float tmax = -INFINITY;
#pragma unroll
                for (int kk = 0; kk < 4; ++kk)
#pragma unroll
                    for (int j = 0; j < 4; ++j) { float v = s[kk][qt][j] * scale_log2;
                        if (needmask) { const int key = k0 + kk * 16 + 4 * q4 + j; v = (key > rowi) ? -INFINITY : v; }
                        s[kk][qt][j] = v; tmax = fmaxf(tmax, v); }
                tmax = fmaxf(tmax, __shfl_xor(tmax, 16)); tmax = fmaxf(tmax, __shfl_xor(tmax, 32));
                const float mnew = fmaxf(m_run[qt], tmax), alpha = __builtin_amdgcn_exp2f(m_run[qt] - mnew);
                m_run[qt] = mnew;
                float psum = 0.f;
#pragma unroll
                for (int kk = 0; kk < 4; ++kk)
#pragma unroll
                    for (int j = 0; j < 4; ++j) { const float p = __builtin_amdgcn_exp2f(s[kk][qt][j] - mnew); s[kk][qt][j] = p; psum += p; }
                l_run[qt] = l_run[qt] * alpha + psum;
#pragma unroll
                for (int dt = 0; dt < DT; ++dt) o[dt][qt] = o[dt][qt] * alpha;
#pragma unroll
                for (int kp = 0; kp < 2; ++kp) { v4u pp;
                    pp.x = cvt_pk_bf16(s[2 * kp][qt][0], s[2 * kp][qt][1]); pp.y = cvt_pk_bf16(s[2 * kp][qt][2], s[2 * kp][qt][3]);
                    pp.z = cvt_pk_bf16(s[2 * kp + 1][qt][0], s[2 * kp + 1][qt][1]); pp.w = cvt_pk_bf16(s[2 * kp + 1][qt][2], s[2 * kp + 1][qt][3]);
                    pf[qt][kp] = as_bf8(pp); }
            }
#pragma unroll
            for (int dt = 0; dt < DT; ++dt)
#pragma unroll
                for (int kp = 0; kp < 2; ++kp) {
                    const LAS unsigned char* vp = vb + (dt * 16 + c16) * (VROW * 2) + (32 * kp + 4 * q4) * 2;
                    const v2u a0 = *(const LAS v2u*)vp, a1 = *(const LAS v2u*)(vp + 32);
                    const bf16x8 vf = as_bf8((v4u){a0.x, a0.y, a1.x, a1.y});
                    o[dt][0] = mfma16(vf, pf[0][kp], o[dt][0]); o[dt][1] = mfma16(vf, pf[1][kp], o[dt][1]);
                }
        }
        if (kt + 1 < nkt) ATT_LSTORE((kt + 1) & 1);
        __syncthreads();
    }
#undef ATT_GLOAD
#undef ATT_LSTORE
#pragma unroll
    for (int qt = 0; qt < 2; ++qt) {
        float lt = l_run[qt]; lt += __shfl_xor(lt, 16); lt += __shfl_xor(lt, 32);
        const float inv = 1.0f / lt;
        bf16* gr = Gp + (size_t)(32 * w + 16 * qt + c16) * gpitch + 4 * q4;
#pragma unroll
        for (int dt = 0; dt < DT; ++dt) { const v2u g = *(const v2u*)(gr + dt * 16); v2u r;
            r.x = cvt_pk_bf16(o[dt][qt][0] * inv * bflo(g.x), o[dt][qt][1] * inv * bfhi(g.x)); r.y = cvt_pk_bf16(o[dt][qt][2] * inv * bflo(g.y), o[dt][qt][3] * inv * bfhi(g.y));
            if (st) *(v2u*)(gr + dt * 16) = r; }
    }
}

__device__ __forceinline__ void ph_mla(const Args& a, LAS unsigned char* lds, int bid, int nb, bool st) {
    const bf16* Qb = (const bf16*)(a.ws + WS_Q); const bf16* Kb = (const bf16*)(a.ws + WS_K); const bf16* Vtb = (const bf16*)(a.ws + WS_VT); bf16* G = (bf16*)(a.ws + WS_G);
    const float sc = 0.10206207261596577f * 1.4426950408889634f;
    for (int u = bid; u < 256; u += nb) {
        const int b = u >> 5, h = (u >> 2) & 7, p = u & 3;
        for (int half = 0; half < 2; ++half) {
            const int jb = half ? p : 7 - p;
            const size_t bh = (size_t)(b * 8 + h);
            attn_block<96, 64, true, false>(lds, Qb + (bh * SEQ + 256 * jb) * 96, 96, nullptr, Kb + bh * SEQ * 96, Vtb + bh * 64 * SEQ, SEQ, 4 * (jb + 1), 256 * jb, sc,
                                            G + (size_t)(b * SEQ + 256 * jb) * GW + h * 64, GW, st);
        }
    }
}
__device__ __forceinline__ void ph_memattn(const Args& a, int l, LAS unsigned char* lds, int bid, int nb, bool st) {
    const bf16* MIX = (const bf16*)(a.ws + WS_MIX); bf16* G = (bf16*)(a.ws + WS_G);
    const bf16* mk = (const bf16*)(a.ws + WS_MEMK + l * 2 * MiB); const bf16* mv = (const bf16*)(a.ws + WS_MEMVT + l * 2 * MiB);
    const float sc = 0.08838834764831845f * 1.4426950408889634f;
    for (int u = bid; u < 256; u += nb) {
        const int tb = u >> 2, h = u & 3, t0 = tb * 256, b = t0 >> 11;
        attn_block<128, 128, false, true>(lds, MIX + (size_t)t0 * MIXW + MC_MQ + h * 128, MIXW, a.in[19] + l * 128, mk + (size_t)(b * 4 + h) * 256 * 128, mv + (size_t)(b * 4 + h) * 128 * 256, 256,
                                          4, 0, sc, G + (size_t)t0 * GW + 3 * 512 + h * 128, GW, st);
    }
}

__device__ __forceinline__ void ph_sg(const Args& a, int l, LAS unsigned char* lds, int bid, int nb, bool st) {
    const int tid = pg8::opaque_tid(), lane = tid & 63, w = tid >> 6, c16 = lane & 15, q4 = lane >> 4;
    const bf16* MIX = (const bf16*)(a.ws + WS_MIX); bf16* G = (bf16*)(a.ws + WS_G);
    const float* lng = a.in[13] + l * 512; const float* lnb = a.in[14] + l * 512; const float* ws_ = a.in[15] + (size_t)l * 4 * 128 * 128; const float* bs = a.in[16] + l * 4 * 128;
    LAS float* stat = (LAS float*)lds; LAS bf16* vT = (LAS bf16*)(lds + 1024); constexpr int VLD = 136;
    for (int u = bid; u < 512; u += nb) {
        const int c = u >> 2, g = u & 3, t0 = c * 128;
        __syncthreads();
        {   const int row = tid >> 2, part = tid & 3; const bf16* src = MIX + (size_t)(t0 + row) * MIXW + MC_V + part * 128;
            float s1 = 0.f, s2 = 0.f;
#pragma unroll 4
            for (int i = 0; i < 16; ++i) { const v4u x = *(const v4u*)(src + i * 8);
                const float f0 = bflo(x.x), f1 = bfhi(x.x), f2 = bflo(x.y), f3 = bfhi(x.y), f4 = bflo(x.z), f5 = bfhi(x.z), f6 = bflo(x.w), f7 = bfhi(x.w);
                s1 += ((f0 + f1) + (f2 + f3)) + ((f4 + f5) + (f6 + f7)); s2 += ((f0 * f0 + f1 * f1) + (f2 * f2 + f3 * f3)) + ((f4 * f4 + f5 * f5) + (f6 * f6 + f7 * f7)); }
            s1 += __shfl_xor(s1, 1); s1 += __shfl_xor(s1, 2); s2 += __shfl_xor(s2, 1); s2 += __shfl_xor(s2, 2);
            const float mean = s1 * (1.f / 512.f), var = fmaxf(s2 * (1.f / 512.f) - mean * mean, 0.f);
            if (part == 0) { stat[row * 2] = mean; stat[row * 2 + 1] = 1.0f / sqrtf(var + EPS); }
        }
        __syncthreads();
        {   const int s = tid & 127, dq = tid >> 7; const bf16* src = MIX + (size_t)(t0 + s) * MIXW + MC_V + g * 128 + dq * 32;
            const float mean = stat[s * 2], rstd = stat[s * 2 + 1];
#pragma unroll
            for (int i = 0; i < 4; ++i) { const v4u x = *(const v4u*)(src + i * 8); const int d0 = dq * 32 + i * 8; const float* gp = lng + g * 128 + d0; const float* bp = lnb + g * 128 + d0;
                float f[8] = {bflo(x.x), bfhi(x.x), bflo(x.y), bfhi(x.y), bflo(x.z), bfhi(x.z), bflo(x.w), bfhi(x.w)};
#pragma unroll
                for (int e = 0; e < 8; ++e) { const float y = (f[e] - mean) * rstd * gp[e] + bp[e]; vT[(d0 + e) * VLD + s] = (bf16)(cvt_pk_bf16(y, 0.f) & 0xffffu); } }
        }
        __syncthreads();
        {   f32x4 acc[8];
#pragma unroll
            for (int nt = 0; nt < 8; ++nt) acc[nt] = (f32x4){0.f, 0.f, 0.f, 0.f};
            const int tt = 16 * w + c16, nks = (w >> 1) + 1;
            const float* wrow = ws_ + ((size_t)g * 128 + tt) * 128;
            for (int ks = 0; ks < nks; ++ks) {
                const int s0 = ks * 32 + 8 * q4;
                const f32x4 w0 = *(const f32x4*)(wrow + s0), w1 = *(const f32x4*)(wrow + s0 + 4);
                float wv[8] = {w0[0], w0[1], w0[2], w0[3], w1[0], w1[1], w1[2], w1[3]};
#pragma unroll
                for (int e = 0; e < 8; ++e) wv[e] = (s0 + e <= tt) ? wv[e] : 0.f;
                v4u wp; wp.x = cvt_pk_bf16(wv[0], wv[1]); wp.y = cvt_pk_bf16(wv[2], wv[3]); wp.z = cvt_pk_bf16(wv[4], wv[5]); wp.w = cvt_pk_bf16(wv[6], wv[7]);
                const bf16x8 bfrag = as_bf8(wp);
#pragma unroll
                for (int nt = 0; nt < 8; ++nt) { const bf16x8 af = as_bf8(*(const LAS v4u*)(vT + (nt * 16 + c16) * VLD + s0)); acc[nt] = mfma16(af, bfrag, acc[nt]); }
            }
            const int t = t0 + tt; const float bias = bs[g * 128 + tt];
            const bf16* up = MIX + (size_t)t * MIXW + MC_U + g * 128 + 4 * q4; bf16* gp = G + (size_t)t * GW + 2 * 512 + g * 128 + 4 * q4;
#pragma unroll
            for (int nt = 0; nt < 8; ++nt) { const v2u uu = *(const v2u*)(up + nt * 16), gg = *(const v2u*)(gp + nt * 16); v2u r;
                r.x = cvt_pk_bf16(bflo(uu.x) * (acc[nt][0] + bias) * bflo(gg.x), bfhi(uu.x) * (acc[nt][1] + bias) * bfhi(gg.x));
                r.y = cvt_pk_bf16(bflo(uu.y) * (acc[nt][2] + bias) * bflo(gg.y), bfhi(uu.y) * (acc[nt][3] + bias) * bfhi(gg.y));
                if (st) *(v2u*)(gp + nt * 16) = r; }
        }
    }
}

__device__ __forceinline__ void ph_conv(const Args& a, int l, int bid, int nb, bool st) {
    const bf16* MIX = (const bf16*)(a.ws + WS_MIX); bf16* G = (bf16*)(a.ws + WS_G);
    const float* cw = a.in[11] + l * 3 * 512; const float* cb = a.in[12] + l * 512;
    for (int idx = bid * NTHR + pg8::opaque_tid(); idx < T * 64; idx += nb * NTHR) {
        const int t = idx >> 6, c = (idx & 63) * 8, s = t & 2047;
        const bf16* row = MIX + (size_t)t * MIXW;
        const v4u bg = *(const v4u*)(row + MC_BG + c);
        float z[3][8];
#pragma unroll
        for (int d = 0; d < 3; ++d) {
            if (s - d >= 0) { const v4u cgv = *(const v4u*)(row - (size_t)d * MIXW + MC_CG + c), xv = *(const v4u*)(row - (size_t)d * MIXW + MC_XIN + c);
                z[d][0] = bflo(cgv.x) * bflo(xv.x); z[d][1] = bfhi(cgv.x) * bfhi(xv.x); z[d][2] = bflo(cgv.y) * bflo(xv.y); z[d][3] = bfhi(cgv.y) * bfhi(xv.y);
                z[d][4] = bflo(cgv.z) * bflo(xv.z); z[d][5] = bfhi(cgv.z) * bfhi(xv.z); z[d][6] = bflo(cgv.w) * bflo(xv.w); z[d][7] = bfhi(cgv.w) * bfhi(xv.w); }
            else {
#pragma unroll
                for (int e = 0; e < 8; ++e) z[d][e] = 0.f; }
        }
        bf16* gp = G + (size_t)t * GW + 512 + c; const v4u gg = *(const v4u*)gp;
        const float bgf[8] = {bflo(bg.x), bfhi(bg.x), bflo(bg.y), bfhi(bg.y), bflo(bg.z), bfhi(bg.z), bflo(bg.w), bfhi(bg.w)};
        const float ggf[8] = {bflo(gg.x), bfhi(gg.x), bflo(gg.y), bfhi(gg.y), bflo(gg.z), bfhi(gg.z), bflo(gg.w), bfhi(gg.w)};
        float y[8];
#pragma unroll
        for (int e = 0; e < 8; ++e) y[e] = bgf[e] * (cb[c + e] + cw[c + e] * z[2][e] + cw[512 + c + e] * z[1][e] + cw[1024 + c + e] * z[0][e]) * ggf[e];
        v4u r; r.x = cvt_pk_bf16(y[0], y[1]); r.y = cvt_pk_bf16(y[2], y[3]); r.z = cvt_pk_bf16(y[4], y[5]); r.w = cvt_pk_bf16(y[6], y[7]);
        if (st) *(v4u*)gp = r;
    }
}
#define XB_TMO      128
#define XB_XCNT(j)  (256  + 64 * (j))
#define XB_XSUB(j)  (1280 + 64 * (j))
#define XB_XGEN(j)  (2304 + 64 * (j))
#define XB_TOP      3328
#define XB_TOPGEN   3392
#define XCD_BAR_WORDS 3456
#define XB_SPIN_CAP (1u << 18)

__device__ __forceinline__ unsigned xb_ld(unsigned* p)              { return __hip_atomic_load(p, __ATOMIC_RELAXED, __HIP_MEMORY_SCOPE_AGENT); }
__device__ __forceinline__ unsigned xb_add(unsigned* p, unsigned v) { return __hip_atomic_fetch_add(p, v, __ATOMIC_RELAXED, __HIP_MEMORY_SCOPE_AGENT); }
__device__ __forceinline__ unsigned xb_xcc_id() { return (unsigned)__builtin_amdgcn_s_getreg((3 << 11) | 20) & 0xFu; }
#define XB_SPIN(cond, bar) do { unsigned _sp = 0; while (cond) { __builtin_amdgcn_s_sleep(1); \
    if ((++_sp & 255u) == 0u) { if (xb_ld(&(bar)[XB_TMO])) break; if (_sp > XB_SPIN_CAP) { atomicAdd(&(bar)[XB_TMO], 1u); break; } } } } while (0)

struct XcdBarrier {
    unsigned* bar; unsigned x;
    volatile LAS unsigned* st;
};

__device__ __forceinline__ XcdBarrier xcd_barrier_post(unsigned* bar, volatile LAS unsigned* st) {
    XcdBarrier b; b.bar = bar; b.x = xb_xcc_id(); b.st = st;
    if (threadIdx.x == 0) (void)xb_add(&bar[XB_XCNT(b.x)], 1u);
    return b;
}
__device__ __forceinline__ void xcd_barrier_complete(unsigned* bar, unsigned x, unsigned& nloc, unsigned& nx) {
    const unsigned G = gridDim.x * gridDim.y * gridDim.z;
    unsigned sum, cnt, mine, sp = 0u;
    for (;;) {
        sum = 0u; cnt = 0u; mine = 0u;
#pragma unroll
        for (unsigned j = 0; j < 16; ++j) { const unsigned c = xb_ld(&bar[XB_XCNT(j)]); sum += c; cnt += (c > 0u) ? 1u : 0u; mine = (j == x) ? c : mine; }
        if (sum == G) break;
        __builtin_amdgcn_s_sleep(1);
        if ((++sp & 255u) == 0u) { if (xb_ld(&bar[XB_TMO])) break; if (sp > XB_SPIN_CAP) { atomicAdd(&bar[XB_TMO], 1u); break; } }
    }
    nloc = mine > 0u ? mine : 1u; nx = cnt > 0u ? cnt : 1u;
}

__device__ __forceinline__ void xcd_barrier(const XcdBarrier& b) {
    asm volatile("s_waitcnt vmcnt(0)" ::: "memory");
    __syncthreads();
    if (threadIdx.x == 0) {
        unsigned* bar = b.bar;
        __builtin_amdgcn_s_waitcnt(0);
        unsigned nloc = b.st[0], nx = b.st[1];
        if (nloc == 0u) { xcd_barrier_complete(bar, b.x, nloc, nx); b.st[0] = nloc; b.st[1] = nx; }
        const unsigned old = xb_add(&bar[XB_XSUB(b.x)], 1u);
        const unsigned gen = old / nloc;
        if (old + 1u == (gen + 1u) * nloc) {
            __builtin_amdgcn_fence(__ATOMIC_RELEASE, "agent");
            asm volatile("s_waitcnt vmcnt(0)" ::: "memory");
            const unsigned og = xb_add(&bar[XB_TOP], 1u);
            const unsigned tg = og / nx;
            if (og + 1u == (tg + 1u) * nx) xb_add(&bar[XB_TOPGEN], 1u);
            else XB_SPIN(xb_ld(&bar[XB_TOPGEN]) == tg, bar);
            __builtin_amdgcn_fence(__ATOMIC_ACQUIRE, "agent");
            xb_add(&bar[XB_XGEN(b.x)], 1u);
            asm volatile("s_waitcnt vmcnt(0)" ::: "memory");
        } else {
            XB_SPIN(xb_ld(&bar[XB_XGEN(b.x)]) == gen, bar);
            __builtin_amdgcn_fence(__ATOMIC_ACQUIRE, "agent");
            asm volatile("s_waitcnt vmcnt(0)" ::: "memory");
        }
    }
    __syncthreads();
}

#ifndef MK_PER_PHASE
#define MK_PER_PHASE 0
#endif
constexpr int NPH = 3 + 8 + 7;
__global__ void __launch_bounds__(NTHR, 2) mk_fwd(Args a) {
    extern __shared__ __attribute__((aligned(16))) unsigned char lds_raw[];
    LAS unsigned char* lds = (LAS unsigned char*)lds_raw;
    cg::grid_group grid = cg::this_grid();
    const int bid = blockIdx.x, nb = gridDim.x;
    const int lo = a.ph_lo, hi = a.ph_hi; const bool real = (hi > 0);
    volatile LAS unsigned* MISC = (volatile LAS unsigned*)(lds + 131072);
    if (threadIdx.x < 32) MISC[threadIdx.x] = 0u;
    __syncthreads();
    const XcdBarrier bar = xcd_barrier_post((unsigned*)a.ws + 1024, MISC + 8);
    bf16* H = (bf16*)(a.ws + WS_H); bf16* MIX = (bf16*)(a.ws + WS_MIX); bf16* G = (bf16*)(a.ws + WS_G); bf16* GATE = (bf16*)(a.ws + WS_GATE); bf16* MERGED = (bf16*)(a.ws + WS_MERGED);
#define IN(k) (lo <= (k) && (k) < hi)
#define SEAM(k) do { if (IN((k) + 1)) { if ((k) == 0) grid.sync(); else xcd_barrier(bar); } } while (0)
    if (IN(0)) {
#ifdef DUP_PRO
        ph_prologue(a, lds, bid, nb); __syncthreads();
#endif
#ifdef DUP_SYNC
        for (int i = 0; i < 16; ++i) grid.sync();
#endif
        ph_prologue(a, lds, bid, nb); SEAM(0); }
    if (IN(1)) {
#ifdef DUP_MKV
        for (int l = 0; l < 2; ++l) {
            pg8::Gemm g{(const bf16*)(a.ws + WS_MEMN + l * 4 * MiB), DM, (const bf16*)(a.ws + WS_WMEMT + l * 2 * MiB), MEMT, 1024, DM};
            pg8::StaticOrder S; S.init(MEMT, 1024, nb, (bid + 128 * l) % nb);
            pg8::EpiAct<0> E{(bf16*)(a.ws + WS_KVRAW + l * 4 * MiB), 1024, 1 << 20, nullptr, 0, nullptr};
            pg8::gemm_phase<pg8::EpiAct<0>, pg8::StaticOrder, true, true>(lds, g, S, E);
        }
#endif
        for (int l = 0; l < 2; ++l) {
            pg8::Gemm g{(const bf16*)(a.ws + WS_MEMN + l * 4 * MiB), DM, (const bf16*)(a.ws + WS_WMEMT + l * 2 * MiB), MEMT, 1024, DM};
            pg8::StaticOrder S; S.init(MEMT, 1024, nb, (bid + 128 * l) % nb);
            pg8::EpiAct<0> E{(bf16*)(a.ws + WS_KVRAW + l * 4 * MiB), 1024, 1 << 20, nullptr, 0, nullptr};
            pg8::gemm_phase<pg8::EpiAct<0>, pg8::StaticOrder, true, true>(lds, g, S, E);
        }
        SEAM(1);
    }
    if (IN(2)) {
#ifdef DUP_MKV
        ph_mempost(a, bid, nb);
#endif
        ph_mempost(a, bid, nb); SEAM(2); }
    for (int l = 0; l < 2; ++l) {
        const int base = 3 + 8 * l;
        const unsigned char* wb = a.ws + (l ? WS_W1 : WS_W0);
        const bf16* WinT = (const bf16*)(wb + WO_WIN);
        const float* xl = l ? a.out : a.in[0];
        const bf16* Hl = l ? H : (const bf16*)a.out;
        if (IN(base + 0)) {
            pg8::Gemm g{Hl, DM, WinT, T, NA, DM};
            pg8::StaticOrder S; S.init(T, NA, nb, bid);
            pg8::EpiAct<1> E{MIX, MIXW, 14, G, GW, nullptr};
#ifdef DUP_P1A
            pg8::gemm_phase<pg8::EpiAct<1>, pg8::StaticOrder, true, true>(lds, g, S, E);
#endif
            pg8::gemm_phase<pg8::EpiAct<1>, pg8::StaticOrder, true, true>(lds, g, S, E);
            SEAM(base + 0);
        }
        if (IN(base + 1)) {
#ifdef DUP_P2
            ph_p2(a, l, lds, bid, nb);
#endif
            ph_p2(a, l, lds, bid, nb); SEAM(base + 1); }
        if (IN(base + 2)) {
#ifdef DUP_MLA
            ph_mla(a, lds, bid, nb, !real);
#endif
#ifdef DUP_MIX3
            ph_memattn(a, l, lds, bid, nb, !real); ph_sg(a, l, lds, bid, nb, !real); ph_conv(a, l, bid, nb, !real);
#endif
            ph_mla(a, lds, bid, nb, real); ph_memattn(a, l, lds, bid, nb, real); ph_sg(a, l, lds, bid, nb, real); ph_conv(a, l, bid, nb, real); __syncthreads(); SEAM(base + 2); }
        if (l == 1 && IN(base + 3)) {
#ifdef DUP_NP
            norm_rows(xl, a.in[3] + l * DM, H, T, bid, nb);
#endif
            norm_rows(xl, a.in[3] + l * DM, H, T, bid, nb); SEAM(base + 3); }
        if (IN(base + 4)) {
            pg8::Gemm g{Hl, DM, WinT + (size_t)NA * DM, T, GATEW, DM};
            pg8::StaticOrder S; S.init(T, GATEW, nb, bid);
            pg8::EpiAct<2> E{nullptr, 0, 0, GATE, GATEW, a.in[21] + l * 4096};
#ifdef DUP_P1B
            pg8::gemm_phase<pg8::EpiAct<2>, pg8::StaticOrder, true, true>(lds, g, S, E);
#endif
            pg8::gemm_phase<pg8::EpiAct<2>, pg8::StaticOrder, true, true>(lds, g, S, E);
            SEAM(base + 4);
        }
        if (IN(base + 5)) {
            pg8::Gemm g{G, GW, (const bf16*)(wb + WO_WBR), T, DM, 2048};
            pg8::StaticOrder S; S.init(T, DM, nb, bid);
            pg8::EpiGate E{GATE, MERGED};
#ifdef DUP_P4
            pg8::gemm_phase<pg8::EpiGate, pg8::StaticOrder, false, true>(lds, g, S, E);
#endif
            pg8::gemm_phase<pg8::EpiGate, pg8::StaticOrder, false, true>(lds, g, S, E);
            SEAM(base + 5);
        }
        if (IN(base + 6)) {
            pg8::Gemm g{MERGED, DM, (const bf16*)(wb + WO_WOUT), T, DM, DM};
            pg8::StaticOrder S; S.init(T, DM, nb, bid);
#ifdef DUP_P5
            { pg8::EpiRes E0{xl, a.out, DM, !real}; pg8::gemm_phase<pg8::EpiRes, pg8::StaticOrder, false, true>(lds, g, S, E0); }
#endif
            pg8::EpiRes E{xl, a.out, DM, real};
            pg8::gemm_phase<pg8::EpiRes, pg8::StaticOrder, false, true>(lds, g, S, E);
            if (l == 0) SEAM(base + 6);
        }
        if (l == 0 && IN(base + 7)) { norm_rows(a.out, a.in[3] + DM, H, T, bid, nb); SEAM(base + 7); }
    }
#undef IN
#undef SEAM
}

extern "C" void kernel_launch(void* const* d_in, const int* in_sizes, int n_in, void* d_out, int out_size, void* d_ws, size_t ws_size, hipStream_t stream) {
    static int grid = 0;
    if (grid == 0) {
        if (n_in != 24 || out_size != T * DM || ws_size < WS_END) { fprintf(stderr, "kernel_launch: unexpected problem (n_in %d out %d ws %zu)\n", n_in, out_size, ws_size); grid = -1; return; }
        int dev = 0, cus = 0, per_cu = 0;
        hipGetDevice(&dev); hipDeviceGetAttribute(&cus, hipDeviceAttributeMultiprocessorCount, dev);
        if (hipFuncSetAttribute((const void*)mk_fwd, hipFuncAttributeMaxDynamicSharedMemorySize, LDS_BYTES) != hipSuccess) { fprintf(stderr, "kernel_launch: hipFuncSetAttribute failed\n"); grid = -1; return; }
        if (hipOccupancyMaxActiveBlocksPerMultiprocessor(&per_cu, (const void*)mk_fwd, NTHR, LDS_BYTES) != hipSuccess || per_cu < 1) { fprintf(stderr, "kernel_launch: occupancy query says %d\n", per_cu); per_cu = 1; }
        (void)hipGetLastError();
        grid = cus;
    }
    if (grid < 0) return;
    if (hipMemsetAsync(d_ws, 0, 65536, stream) != hipSuccess) { fprintf(stderr, "kernel_launch: memset failed\n"); return; }
    Args a{};
    for (int i = 0; i < 24; ++i) a.in[i] = (const float*)d_in[i];
    a.out = (float*)d_out; a.ws = (unsigned char*)d_ws;
#if MK_PER_PHASE
    for (int p = 0; p < NPH; ++p) { a.ph_lo = p; a.ph_hi = p + 1; void* args[] = {&a};
        hipError_t e = hipLaunchCooperativeKernel((void*)mk_fwd, dim3(grid), dim3(NTHR), args, LDS_BYTES, stream);
        if (e != hipSuccess) { fprintf(stderr, "launch %d failed: %s\n", p, hipGetErrorString(e)); break; } }
#else
    a.ph_lo = 0; a.ph_hi = NPH; void* args[] = {&a};
    hipError_t e = hipLaunchCooperativeKernel((void*)mk_fwd, dim3(grid), dim3(NTHR), args, LDS_BYTES, stream);
    if (e != hipSuccess) fprintf(stderr, "cooperative launch failed: %s (grid %d)\n", hipGetErrorString(e), grid);
#endif
}
```

```cpp
#include <hip/hip_runtime.h>
#include <hip/hip_cooperative_groups.h>
#include <cstdio>
#include <cstdint>
namespace cg = cooperative_groups;
namespace pg8 {
#define PG8_LAS __attribute__((address_space(3)))
typedef unsigned short bf16_t;
typedef short bf16x8 __attribute__((ext_vector_type(8)));
typedef float f32x4 __attribute__((ext_vector_type(4)));
typedef unsigned u32x4 __attribute__((ext_vector_type(4)));
constexpr int BM = 256, BK = 64, HALF = 128, HTB = HALF * BK * 2  , STAGE_BYTES = 8 * HTB, NXCD = 8, WGM = 8;

__host__ __device__ __forceinline__ int lds_byte(int r, int c) { const int st = (r >> 4) * 2 + (c >> 5), rr = r & 15, cc = c & 31, ob = rr * 64 + cc * 2; return st * 1024 + (ob ^ (((ob >> 9) & 1) << 5)); }
__host__ __device__ __forceinline__ void stage_rc(int b, int& R, int& C) { const int st = b / 1024, sb = b % 1024, swz = sb ^ (((sb >> 9) & 1) << 5); R = (st >> 1) * 16 + swz / 64; C = (st & 1) * 32 + (swz % 64) / 2; }
__host__ __device__ __forceinline__ int perm32(int rho) { const int n = rho >> 4, i = rho & 15; return 8 * (i >> 2) + 4 * n + (i & 3); }

struct Unit { int pm, pn; };
struct Gemm { const bf16_t* A; int lda; const bf16_t* Bt; int M, N, K; };

struct StaticOrder {
    int nM, nN, nwg, G, c;
    __host__ __device__ void init(int M, int N, int G_, int c_) { nM = M / BM; nN = N / BM; nwg = nM * nN; G = G_; c = c_; }
    __host__ __device__ bool next(int i, Unit& u) const {
        const long L = (long)i * G + c; if (L >= nwg) return false;
        int wgid = (int)L; { const int q = nwg / NXCD, r = nwg % NXCD, xcd = wgid % NXCD, off = wgid / NXCD; wgid = (xcd < r ? xcd * (q + 1) : r * (q + 1) + (xcd - r) * q) + off; }
        const int nig = WGM * nN, gid = wgid / nig, fm = gid * WGM, gsz = (nM - fm) < WGM ? (nM - fm) : WGM;
        u.pm = fm + ((wgid % nig) % gsz); u.pn = (wgid % nig) / gsz; return true;
    }
    __device__ __forceinline__ void a_ready(const Unit&) const {}
    __device__ __forceinline__ void done(const Unit&) const {}
};

__device__ __forceinline__ unsigned cvt_pk_bf16(float lo, float hi) { unsigned r; asm volatile("v_cvt_pk_bf16_f32 %0, %1, %2" : "=v"(r) : "v"(lo), "v"(hi)); return r; }
__device__ __forceinline__ int opaque_tid() { int t = threadIdx.x; asm volatile("" : "+v"(t)); return t; }
__device__ __forceinline__ float bflo(unsigned u) { return __uint_as_float(u << 16); }
__device__ __forceinline__ float bfhi(unsigned u) { return __uint_as_float(u & 0xffff0000u); }
__device__ __forceinline__ float sigm(float x) { return __builtin_amdgcn_rcpf(1.0f + __expf(-x)); }

template <int ACT> struct EpiAct {
    static constexpr bool PERM = true, AFTER_DRAIN = false, HAS_MID = false;
    bf16_t* O0; int ld0; int npn0; bf16_t* O1; int ld1; const float* bias;
    __device__ __forceinline__ void operator()(const f32x4 (&acc)[2][2][4][2], const Unit& u, int wr, int wc, int fr, int fq) const {
        const int row0 = u.pm * BM + wr * 64 + fr;
        const bool second = (u.pn >= npn0);
        bf16_t* base = second ? O1 : O0; const int ld = second ? ld1 : ld0; const int colt = second ? (u.pn - npn0) * BM : u.pn * BM;
        const int col0 = colt + wc * 32 + 8 * fq;
#pragma unroll
        for (int bj = 0; bj < 2; ++bj) {
            f32x4 b0 = (f32x4){0.f, 0.f, 0.f, 0.f}, b1 = b0;
            if (ACT == 2) { b0 = *(const f32x4*)(bias + col0 + bj * HALF); b1 = *(const f32x4*)(bias + col0 + bj * HALF + 4); }
#pragma unroll
            for (int ai = 0; ai < 2; ++ai)
#pragma unroll
                for (int m = 0; m < 4; ++m) {
                    bf16_t* rowp = base + (size_t)(row0 + ai * HALF + m * 16) * ld + col0 + bj * HALF;
                    f32x4 v0 = acc[ai][bj][m][0], v1 = acc[ai][bj][m][1];
                    if (ACT != 0 && second) {
#pragma unroll
                        for (int e = 0; e < 4; ++e) {
                            if (ACT == 1) { v0[e] = v0[e] * sigm(v0[e]); v1[e] = v1[e] * sigm(v1[e]); }
                            if (ACT == 2) { v0[e] = sigm(v0[e] + b0[e]); v1[e] = sigm(v1[e] + b1[e]); }
                        }
                    }
                    u32x4 w; w.x = cvt_pk_bf16(v0[0], v0[1]); w.y = cvt_pk_bf16(v0[2], v0[3]); w.z = cvt_pk_bf16(v1[0], v1[1]); w.w = cvt_pk_bf16(v1[2], v1[3]);
                    *(u32x4*)rowp = w;
                }
        }
    }
};

struct EpiGate {
    static constexpr bool PERM = true, AFTER_DRAIN = false, HAS_MID = true;
    const bf16_t* GATE; bf16_t* O;
    __device__ __forceinline__ void mid(f32x4 (&acc)[2][2][4][2], const Unit& u, int nb, int wr, int wc, int fr_, int fq_) const {
        int fr = fr_, fq = fq_; asm volatile("" : "+v"(fr), "+v"(fq));
        const int row0 = u.pm * BM + wr * 64 + fr, col0 = u.pn * BM + wc * 32 + 8 * fq;
#pragma unroll
        for (int ai = 0; ai < 2; ++ai)
#pragma unroll
            for (int bj = 0; bj < 2; ++bj) {
                u32x4 ga[4], gb[4];
#pragma unroll
                for (int m = 0; m < 4; ++m) { const bf16_t* gp = GATE + (size_t)(row0 + ai * HALF + m * 16) * 4096 + (nb - 1) * 1024 + col0 + bj * HALF; ga[m] = *(const u32x4*)gp; gb[m] = *(const u32x4*)(gp + 1024); }
                __builtin_amdgcn_sched_barrier(0);
#pragma unroll
                for (int m = 0; m < 4; ++m) { const u32x4 a = ga[m], b = gb[m];
                    f32x4 r0, r1;
                    r0[0] = bflo(a.x) * __builtin_amdgcn_rcpf(bflo(b.x)); r0[1] = bfhi(a.x) * __builtin_amdgcn_rcpf(bfhi(b.x));
                    r0[2] = bflo(a.y) * __builtin_amdgcn_rcpf(bflo(b.y)); r0[3] = bfhi(a.y) * __builtin_amdgcn_rcpf(bfhi(b.y));
                    r1[0] = bflo(a.z) * __builtin_amdgcn_rcpf(bflo(b.z)); r1[1] = bfhi(a.z) * __builtin_amdgcn_rcpf(bfhi(b.z));
                    r1[2] = bflo(a.w) * __builtin_amdgcn_rcpf(bflo(b.w)); r1[3] = bfhi(a.w) * __builtin_amdgcn_rcpf(bfhi(b.w));
                    acc[ai][bj][m][0] = acc[ai][bj][m][0] * r0; acc[ai][bj][m][1] = acc[ai][bj][m][1] * r1; }
                __builtin_amdgcn_sched_barrier(0);
            }
    }
    __device__ __forceinline__ void operator()(const f32x4 (&acc)[2][2][4][2], const Unit& u, int wr, int wc, int fr, int fq) const {
        const int row0 = u.pm * BM + wr * 64 + fr, col0 = u.pn * BM + wc * 32 + 8 * fq;
#pragma unroll
        for (int ai = 0; ai < 2; ++ai)
#pragma unroll
            for (int bj = 0; bj < 2; ++bj) {
                u32x4 ga[4];
#pragma unroll
                for (int m = 0; m < 4; ++m) ga[m] = *(const u32x4*)(GATE + (size_t)(row0 + ai * HALF + m * 16) * 4096 + 3 * 1024 + col0 + bj * HALF);
                __builtin_amdgcn_sched_barrier(0);
#pragma unroll
                for (int m = 0; m < 4; ++m) { const u32x4 a = ga[m]; const f32x4 v0 = acc[ai][bj][m][0], v1 = acc[ai][bj][m][1];
                    u32x4 w; w.x = cvt_pk_bf16(v0[0] * bflo(a.x), v0[1] * bfhi(a.x)); w.y = cvt_pk_bf16(v0[2] * bflo(a.y), v0[3] * bfhi(a.y));
                    w.z = cvt_pk_bf16(v1[0] * bflo(a.z), v1[1] * bfhi(a.z)); w.w = cvt_pk_bf16(v1[2] * bflo(a.w), v1[3] * bfhi(a.w));
                    *(u32x4*)(O + (size_t)(row0 + ai * HALF + m * 16) * 1024 + col0 + bj * HALF) = w; }
                __builtin_amdgcn_sched_barrier(0);
            }
    }
};

struct EpiRes {
    static constexpr bool PERM = false, AFTER_DRAIN = false, HAS_MID = false;
    const float* base; float* out; int ldc; bool st;
    __device__ __forceinline__ void operator()(const f32x4 (&acc)[2][2][4][2], const Unit& u, int wr, int wc, int fr, int fq) const {
        const int row0 = u.pm * BM + wr * 64 + fr, col0 = u.pn * BM + wc * 32 + 4 * fq;
#pragma unroll
        for (int ai = 0; ai < 2; ++ai)
#pragma unroll
            for (int m = 0; m < 4; ++m)
#pragma unroll
                for (int bj = 0; bj < 2; ++bj)
#pragma unroll
                    for (int n = 0; n < 2; ++n) {
                        const size_t o = (size_t)(row0 + ai * HALF + m * 16) * ldc + col0 + bj * HALF + 16 * n;
                        const f32x4 x = *(const f32x4*)(base + o);
                        if (st) *(f32x4*)(out + o) = x + acc[ai][bj][m][n];
                    }
    }
};
template <class Epi, class Sched, bool ALIGN_EPI = false, bool SP2 = false>
__device__ __forceinline__ void gemm_phase(PG8_LAS unsigned char* lds, const Gemm g, const Sched& S, const Epi& E) {
    const int tid = pg8::opaque_tid(), wid = __builtin_amdgcn_readfirstlane(tid >> 6), lane = tid & 63, wr = wid >> 2, wc = wid & 3, fr = lane & 15, fq = lane >> 4;
    const int K = g.K, nt = K / BK;
    unsigned voffA[2], voffB[2];
#pragma unroll
    for (int i = 0; i < 2; ++i) { int R, C; stage_rc(tid * 16 + i * 8192, R, C); const int Rb = Epi::PERM ? ((R & ~31) + perm32(R & 31)) : R;
        voffA[i] = (unsigned)(R * g.lda + C) * 2u; voffB[i] = (unsigned)(Rb * K + C) * 2u; }
    const size_t kstep = (size_t)(BK * 2);
    const size_t hstepA = (size_t)HALF * g.lda * 2, hstepB = (size_t)HALF * K * 2;
    const size_t tstepA = 2 * hstepA, tstepB = 2 * hstepB;
    const unsigned ldsw = (unsigned)wid * 1024u;
    const int aoff = lds_byte(wr * 64 + fr, fq * 8), boff = lds_byte(wc * 32 + fr, fq * 8);
#define PG8_SA(b, h) (((b) * 2 + (h)) * HTB)
#define PG8_SB(b, h) ((4 + (b) * 2 + (h)) * HTB)
#define PG8_STAGE(bufoff, gbase, voff) do { _Pragma("unroll") for (int _i = 0; _i < 2; ++_i) \
        __builtin_amdgcn_global_load_lds((const unsigned*)((const char*)(gbase) + (voff)[_i]), (PG8_LAS unsigned*)(lds + (bufoff) + ldsw + _i * 8192), 16, 0, 0); } while (0)
#define PG8_LDA(dst, b, h) do { _Pragma("unroll") for (int m = 0; m < 4; ++m) _Pragma("unroll") for (int k = 0; k < 2; ++k) dst[m][k] = *(const PG8_LAS bf16x8*)(lds + PG8_SA(b, h) + aoff + m * 2048 + k * 1024); } while (0)
#define PG8_LDB(dst, b, h) do { _Pragma("unroll") for (int n = 0; n < 2; ++n) _Pragma("unroll") for (int k = 0; k < 2; ++k) dst[n][k] = *(const PG8_LAS bf16x8*)(lds + PG8_SB(b, h) + boff + n * 2048 + k * 1024); } while (0)
#define PG8_MMA(ai, bj, At, Bt) do { __builtin_amdgcn_s_setprio(1); _Pragma("unroll") for (int m = 0; m < 4; ++m) _Pragma("unroll") for (int n = 0; n < 2; ++n) _Pragma("unroll") for (int k = 0; k < 2; ++k) \
        acc[ai][bj][m][n] = __builtin_amdgcn_mfma_f32_16x16x32_bf16(Bt[n][k], At[m][k], acc[ai][bj][m][n], 0, 0, 0); __builtin_amdgcn_s_setprio(0); } while (0)
#define PG8_WAIT_V(n) asm volatile("s_waitcnt vmcnt(" #n ")" ::: "memory")
#define PG8_WAIT_L(n) asm volatile("s_waitcnt lgkmcnt(" #n ")" ::: "memory")
#define PG8_BAR __builtin_amdgcn_s_barrier()
#define PG8_SCHED __builtin_amdgcn_sched_barrier(0)
    Unit cur, nxt; int ui = 0;
    if (!S.next(0, cur)) return;
    f32x4 acc[2][2][4][2];
#pragma unroll
    for (int a = 0; a < 2; ++a)
#pragma unroll
        for (int b = 0; b < 2; ++b)
#pragma unroll
            for (int m = 0; m < 4; ++m)
#pragma unroll
                for (int n = 0; n < 2; ++n) acc[a][b][m][n] = (f32x4){0.f, 0.f, 0.f, 0.f};
    bf16x8 At[4][2], B0[2][2], B1[2][2];
    const char* cA = (const char*)g.A + (size_t)cur.pm * tstepA; const char* cB = (const char*)g.Bt + (size_t)cur.pn * tstepB;
    S.a_ready(cur);
    if constexpr (SP2) {
        PG8_STAGE(PG8_SB(0, 0), cB, voffB); PG8_STAGE(PG8_SB(0, 1), cB + hstepB, voffB); PG8_STAGE(PG8_SA(0, 0), cA, voffA); PG8_STAGE(PG8_SA(0, 1), cA + hstepA, voffA);
        if (wr == 1) PG8_BAR;
        PG8_WAIT_V(2); PG8_BAR;
        PG8_STAGE(PG8_SB(1, 0), cB + kstep, voffB); PG8_STAGE(PG8_SA(1, 0), cA + kstep, voffA); PG8_STAGE(PG8_SB(1, 1), cB + hstepB + kstep, voffB);
        PG8_WAIT_V(6); PG8_BAR;
    } else {
        PG8_STAGE(PG8_SB(0, 0), cB, voffB); PG8_STAGE(PG8_SA(0, 0), cA, voffA); PG8_STAGE(PG8_SB(0, 1), cB + hstepB, voffB); PG8_STAGE(PG8_SA(0, 1), cA + hstepA, voffA);
        if (wr == 1) PG8_BAR;
        PG8_WAIT_V(4); PG8_BAR;
        PG8_STAGE(PG8_SB(1, 0), cB + kstep, voffB); PG8_STAGE(PG8_SA(1, 0), cA + kstep, voffA); PG8_STAGE(PG8_SB(1, 1), cB + hstepB + kstep, voffB);
        PG8_WAIT_V(6); PG8_BAR;
    }
    for (;;) {
        const bool has_next = S.next(ui + 1, nxt);
        const char* nA = has_next ? (const char*)g.A + (size_t)nxt.pm * tstepA : cA; const char* nB = has_next ? (const char*)g.Bt + (size_t)nxt.pn * tstepB : cB;
        for (int t = 0; t < nt; t += 2) {
            if constexpr (Epi::HAS_MID) { if (t != 0 && (t & 7) == 0) E.mid(acc, cur, t >> 3, wr, wc, fr, fq); }
            const bool last = (t == nt - 2);
            const char* a1 = cA + (size_t)(t + 1) * kstep;
            const char* a2 = last ? nA : cA + (size_t)(t + 2) * kstep; const char* b2 = last ? nB : cB + (size_t)(t + 2) * kstep;
            const char* a3 = a2 + kstep; const char* b3 = b2 + kstep;
            if (last && has_next) S.a_ready(nxt);
            if constexpr (SP2) {
            PG8_LDB(B0, 0, 0); PG8_LDB(B1, 0, 1); PG8_SCHED; PG8_LDA(At, 0, 0); PG8_STAGE(PG8_SA(1, 1), a1 + hstepA, voffA);
            PG8_WAIT_V(8); PG8_WAIT_L(0); PG8_BAR; PG8_MMA(0, 0, At, B0); PG8_MMA(0, 1, At, B1); PG8_BAR; PG8_SCHED;
            PG8_LDA(At, 0, 1); PG8_STAGE(PG8_SB(0, 0), b2, voffB); PG8_STAGE(PG8_SB(0, 1), b2 + hstepB, voffB); PG8_STAGE(PG8_SA(0, 0), a2, voffA);
            PG8_WAIT_V(8); PG8_WAIT_L(0); PG8_BAR; PG8_MMA(1, 0, At, B0); PG8_MMA(1, 1, At, B1); PG8_BAR; PG8_SCHED;
            PG8_LDB(B0, 1, 0); PG8_LDB(B1, 1, 1); PG8_SCHED; PG8_LDA(At, 1, 0); PG8_STAGE(PG8_SA(0, 1), a2 + hstepA, voffA);
            PG8_WAIT_V(8); PG8_WAIT_L(0); PG8_BAR; PG8_MMA(0, 0, At, B0); PG8_MMA(0, 1, At, B1); PG8_BAR; PG8_SCHED;
            PG8_LDA(At, 1, 1); PG8_STAGE(PG8_SB(1, 0), b3, voffB); PG8_STAGE(PG8_SB(1, 1), b3 + hstepB, voffB); PG8_STAGE(PG8_SA(1, 0), a3, voffA);
            PG8_WAIT_V(8); PG8_WAIT_L(0); PG8_BAR; PG8_MMA(1, 0, At, B0); PG8_MMA(1, 1, At, B1); PG8_BAR; PG8_SCHED;
            } else {
            PG8_LDB(B0, 0, 0); PG8_SCHED; PG8_LDA(At, 0, 0); PG8_STAGE(PG8_SA(1, 1), a1 + hstepA, voffA);
            PG8_WAIT_L(8); PG8_BAR; PG8_WAIT_L(0); PG8_MMA(0, 0, At, B0); PG8_BAR; PG8_SCHED;
            PG8_LDB(B1, 0, 1); PG8_STAGE(PG8_SB(0, 0), b2, voffB);
            PG8_BAR; PG8_WAIT_L(0); PG8_MMA(0, 1, At, B1); PG8_BAR;
            PG8_LDA(At, 0, 1); PG8_STAGE(PG8_SA(0, 0), a2, voffA);
            PG8_BAR; PG8_WAIT_L(0); PG8_MMA(1, 0, At, B0); PG8_BAR; PG8_SCHED;
            PG8_STAGE(PG8_SB(0, 1), b2 + hstepB, voffB);
            PG8_WAIT_V(6); PG8_BAR; PG8_MMA(1, 1, At, B1); PG8_BAR;
            PG8_LDB(B0, 1, 0); PG8_SCHED; PG8_LDA(At, 1, 0); PG8_STAGE(PG8_SA(0, 1), a2 + hstepA, voffA);
            PG8_WAIT_L(8); PG8_BAR; PG8_WAIT_L(0); PG8_MMA(0, 0, At, B0); PG8_BAR; PG8_SCHED;
            PG8_LDB(B1, 1, 1); PG8_STAGE(PG8_SB(1, 0), b3, voffB);
            PG8_BAR; PG8_WAIT_L(0); PG8_MMA(0, 1, At, B1); PG8_BAR;
            PG8_LDA(At, 1, 1); PG8_STAGE(PG8_SA(1, 0), a3, voffA);
            PG8_BAR; PG8_WAIT_L(0); PG8_MMA(1, 0, At, B0); PG8_BAR; PG8_SCHED;
            PG8_STAGE(PG8_SB(1, 1), b3 + hstepB, voffB);
            PG8_WAIT_V(6); PG8_BAR; PG8_MMA(1, 1, At, B1); PG8_BAR;
            }
        }
        if constexpr (ALIGN_EPI) { if (wr == 0) PG8_BAR; }
        if constexpr (!Epi::AFTER_DRAIN) { E(acc, cur, wr, wc, fr, fq); S.done(cur); }
        if (!has_next) break;
#pragma unroll
        for (int a = 0; a < 2; ++a)
#pragma unroll
            for (int b = 0; b < 2; ++b)
#pragma unroll
                for (int m = 0; m < 4; ++m)
#pragma unroll
                    for (int n = 0; n < 2; ++n) acc[a][b][m][n] = (f32x4){0.f, 0.f, 0.f, 0.f};
        cur = nxt; cA = nA; cB = nB; ++ui;
        if constexpr (ALIGN_EPI) { if (wr == 1) PG8_BAR; }
    }
    PG8_WAIT_V(0);
    if constexpr (!ALIGN_EPI) { if (wr == 0) PG8_BAR; }
    PG8_BAR;
    if constexpr (Epi::AFTER_DRAIN) { E.fused(acc, cur, wr, wc, fr, fq, lds, wid, lane); S.done(cur); }
#undef PG8_SA
#undef PG8_SB
#undef PG8_STAGE
#undef PG8_LDA
#undef PG8_LDB
#undef PG8_MMA
#undef PG8_WAIT_V
#undef PG8_WAIT_L
#undef PG8_BAR
#undef PG8_SCHED
}
}
constexpr int NWAVES = 8, NTHR = 512;
constexpr int BATCH = 8, SEQ = 2048, DM = 1024, T = BATCH * SEQ, DEPTH = 2, MEML = 256, MEMT = BATCH * MEML;
constexpr int INW = 9632, INWP = 9728, NA = 5632  , MIXW = 3584, GW = 2048, GATEW = 4096;
constexpr float EPS = 1e-6f;
constexpr int MC_CQ = 0, MC_CKV = 256, MC_KR = 384, MC_BG = 512, MC_CG = 1024, MC_XIN = 1536, MC_U = 2048, MC_V = 2560, MC_MQ = 3072;
constexpr size_t MiB = 1u << 20;
constexpr size_t WS_W0 = 1 * MiB, WS_W1 = 275 * MiB;
constexpr size_t WO_WIN = 0, WO_WUQ = 19 * MiB, WO_WUKV = WO_WUQ + 768 * 256 * 2, WO_WBR = WO_WUKV + 1024 * 128 * 2, WO_WOUT = WO_WBR + 4 * MiB, WO_END = WO_WOUT + 2 * MiB;
static_assert(WO_END <= 26 * MiB, "weights");
constexpr size_t WS_MEMK = 27 * MiB, WS_MEMVT = 31 * MiB;
constexpr size_t WS_MIX = 35 * MiB, WS_GATE = 35 * MiB;
constexpr size_t WS_Q = 147 * MiB, WS_K = 171 * MiB, WS_VT = 195 * MiB, WS_H = 179 * MiB, WS_MERGED = 179 * MiB;
constexpr size_t WS_WMEMT = 147 * MiB, WS_MEMN = 151 * MiB, WS_KVRAW = 27 * MiB;
constexpr size_t WS_G = 211 * MiB, WS_END = 301 * MiB;
constexpr int LDS_BYTES = 147456;

#define LAS __attribute__((address_space(3)))
typedef unsigned short bf16;
typedef unsigned v4u __attribute__((ext_vector_type(4)));
typedef unsigned v2u __attribute__((ext_vector_type(2)));
typedef float f32x4 __attribute__((ext_vector_type(4)));
typedef short bf16x8 __attribute__((ext_vector_type(8)));
using pg8::cvt_pk_bf16; using pg8::bflo; using pg8::bfhi; using pg8::sigm;

__device__ __forceinline__ float wave_sum(float v) {
#pragma unroll
    for (int o = 1; o < 64; o <<= 1) v += __shfl_xor(v, o);
    return v;
}
__device__ __forceinline__ f32x4 mfma16(bf16x8 a, bf16x8 b, f32x4 c) { return __builtin_amdgcn_mfma_f32_16x16x32_bf16(a, b, c, 0, 0, 0); }
__device__ __forceinline__ bf16x8 as_bf8(v4u v) { return __builtin_bit_cast(bf16x8, v); }

struct Args { const float* in[24]; float* out; unsigned char* ws; int ph_lo, ph_hi; };

__device__ __forceinline__ void tr_item(const float* W, int K, int N, bf16* WT, int ldt, int coff, int win, LAS float* scr, int item, int lane) {
    const int nblk = N / 32, kb = item / nblk, nb = item % nblk, k0 = 64 * kb, n0 = 32 * nb;
    const int radd = (win && n0 >= 416) ? 96 : 0;
#pragma unroll 8
    for (int i = 0; i < 32; ++i) { const int kk = 2 * i + (lane >> 5); scr[kk * 33 + (lane & 31)] = W[(size_t)(k0 + kk) * N + n0 + (lane & 31)]; }
    asm volatile("s_waitcnt lgkmcnt(0)" ::: "memory");
    const int c = lane & 7;
#pragma unroll
    for (int j = 0; j < 4; ++j) { const int n = (lane >> 3) + 8 * j; const LAS float* s = scr + (8 * c) * 33 + n;
        v4u o; o.x = cvt_pk_bf16(s[0 * 33], s[1 * 33]); o.y = cvt_pk_bf16(s[2 * 33], s[3 * 33]); o.z = cvt_pk_bf16(s[4 * 33], s[5 * 33]); o.w = cvt_pk_bf16(s[6 * 33], s[7 * 33]);
        *(v4u*)(WT + (size_t)(radd + n0 + n) * ldt + coff + k0 + 8 * c) = o; }
    asm volatile("s_waitcnt lgkmcnt(0)" ::: "memory");
}
__device__ __forceinline__ void rms_row(const float* xrow, const float* g, bf16* orow, int lane) {
    const f32x4* xr = (const f32x4*)xrow + lane; const f32x4* gr = (const f32x4*)g + lane;
    f32x4 v[4]; float s = 0.f;
#pragma unroll
    for (int j = 0; j < 4; ++j) { v[j] = xr[64 * j]; s += (v[j].x * v[j].x + v[j].y * v[j].y) + (v[j].z * v[j].z + v[j].w * v[j].w); }
    const float rstd = 1.0f / sqrtf(wave_sum(s) * (1.f / 1024.f) + EPS);
    v2u* o8 = (v2u*)orow + lane;
#pragma unroll
    for (int j = 0; j < 4; ++j) { const f32x4 gg = gr[64 * j]; v2u o; o.x = cvt_pk_bf16(v[j].x * rstd * gg.x, v[j].y * rstd * gg.y); o.y = cvt_pk_bf16(v[j].z * rstd * gg.z, v[j].w * rstd * gg.w); o8[64 * j] = o; }
}
__device__ __forceinline__ void norm_rows(const float* x, const float* g, bf16* H, int rows, int bid, int nb) {
    const int tid = pg8::opaque_tid(), lane = tid & 63, gw = bid * NWAVES + (tid >> 6), ngw = nb * NWAVES;
    const f32x4* gr = (const f32x4*)g + lane;
    for (int m = gw; m < rows; m += 2 * ngw) {
        const int m2 = m + ngw; const bool has2 = m2 < rows;
        const f32x4* xa = (const f32x4*)(x + (size_t)m * DM) + lane; const f32x4* xb = (const f32x4*)(x + (size_t)(has2 ? m2 : m) * DM) + lane;
        f32x4 va[4], vb[4]; float sa = 0.f, sb = 0.f;
#pragma unroll
        for (int j = 0; j < 4; ++j) { va[j] = xa[64 * j]; vb[j] = xb[64 * j]; }
#pragma unroll
        for (int j = 0; j < 4; ++j) { sa += (va[j].x * va[j].x + va[j].y * va[j].y) + (va[j].z * va[j].z + va[j].w * va[j].w); sb += (vb[j].x * vb[j].x + vb[j].y * vb[j].y) + (vb[j].z * vb[j].z + vb[j].w * vb[j].w); }
        const float ra = 1.0f / sqrtf(wave_sum(sa) * (1.f / 1024.f) + EPS), rb = 1.0f / sqrtf(wave_sum(sb) * (1.f / 1024.f) + EPS);
        v2u* oa = (v2u*)(H + (size_t)m * DM) + lane; v2u* ob = (v2u*)(H + (size_t)m2 * DM) + lane;
#pragma unroll
        for (int j = 0; j < 4; ++j) { const f32x4 gg = gr[64 * j]; v2u o;
            o.x = cvt_pk_bf16(va[j].x * ra * gg.x, va[j].y * ra * gg.y); o.y = cvt_pk_bf16(va[j].z * ra * gg.z, va[j].w * ra * gg.w); oa[64 * j] = o;
            if (has2) { o.x = cvt_pk_bf16(vb[j].x * rb * gg.x, vb[j].y * rb * gg.y); o.y = cvt_pk_bf16(vb[j].z * rb * gg.z, vb[j].w * rb * gg.w); ob[64 * j] = o; } }
    }
}

__device__ __forceinline__ void ph_prologue(const Args& a, LAS unsigned char* lds, int bid, int nb) {
    const int tid = pg8::opaque_tid(), lane = tid & 63, wave = tid >> 6;
    LAS float* scr = (LAS float*)(lds + wave * 16384);
    const int gw = bid * NWAVES + wave, ngw = nb * NWAVES;
    constexpr int I_IN = 16 * 301, I_UQ = 4 * 24, I_UKV = 2 * 32, I_MEM = 16 * 32, I_BR = 8 * 32, I_OUT = 16 * 32;
    constexpr int PER_L = I_IN + I_UQ + I_UKV + I_MEM + 4 * I_BR + I_OUT;
    for (int it0 = gw; it0 < 2 * PER_L; it0 += ngw) {
        const int l = it0 / PER_L; int r = it0 % PER_L;
        unsigned char* wb = a.ws + (l ? WS_W1 : WS_W0);
        if (r < I_IN) { tr_item(a.in[4] + (size_t)l * DM * INW, DM, INW, (bf16*)(wb + WO_WIN), DM, 0, 1, scr, r, lane); continue; } r -= I_IN;
        if (r < I_UQ) { tr_item(a.in[7] + (size_t)l * 256 * 768, 256, 768, (bf16*)(wb + WO_WUQ), 256, 0, 0, scr, r, lane); continue; } r -= I_UQ;
        if (r < I_UKV) { tr_item(a.in[8] + (size_t)l * 128 * 1024, 128, 1024, (bf16*)(wb + WO_WUKV), 128, 0, 0, scr, r, lane); continue; } r -= I_UKV;
        if (r < I_MEM) { tr_item(a.in[18] + (size_t)l * DM * 1024, DM, 1024, (bf16*)(a.ws + WS_WMEMT + l * 2 * MiB), DM, 0, 0, scr, r, lane); continue; } r -= I_MEM;
        if (r < 4 * I_BR) { const int n = r / I_BR; tr_item(a.in[22] + ((size_t)l * 4 + n) * 512 * DM, 512, DM, (bf16*)(wb + WO_WBR), 2048, n * 512, 0, scr, r % I_BR, lane); continue; } r -= 4 * I_BR;
        tr_item(a.in[23] + (size_t)l * DM * DM, DM, DM, (bf16*)(wb + WO_WOUT), DM, 0, 0, scr, r, lane);
    }
    for (int i = bid * NTHR + tid; i < 2 * 96 * 128; i += nb * NTHR) { const int l = i / (96 * 128), r = i % (96 * 128);
        *(v4u*)(a.ws + (l ? WS_W1 : WS_W0) + WO_WIN + (size_t)(416 * 1024) * 2 + (size_t)r * 16) = (v4u){0u, 0u, 0u, 0u}; }
    for (int l = 0; l < 2; ++l) norm_rows(a.in[1], a.in[17] + l * DM, (bf16*)(a.ws + WS_MEMN + l * 4 * MiB), MEMT, bid, nb);
    norm_rows(a.in[0], a.in[3], (bf16*)a.out, T, bid, nb);
}

__device__ __forceinline__ void ph_mempost(const Args& a, int bid, int nb) {
    const int tid = pg8::opaque_tid(), lane = tid & 63, wave = tid >> 6;
    const int gw = bid * NWAVES + wave, ngw = nb * NWAVES;
    for (int it = gw; it < 2 * MEMT * 4; it += ngw) {
        const int l = it / (MEMT * 4), r = (it / 4) % MEMT, h = it & 3, b = r >> 8, m = r & 255;
        const bf16* kv = (const bf16*)(a.ws + WS_KVRAW + l * 4 * MiB) + (size_t)r * 1024;
        const unsigned ku = *(const unsigned*)(kv + h * 128 + 2 * lane);
        const float k0 = bflo(ku), k1 = bfhi(ku);
        const float rstd = 1.0f / sqrtf(wave_sum(k0 * k0 + k1 * k1) * (1.f / 128.f) + EPS);
        const float* kg = a.in[20] + l * 128;
        bf16* mk = (bf16*)(a.ws + WS_MEMK + l * 2 * MiB) + ((size_t)(b * 4 + h) * 256 + m) * 128;
        *(unsigned*)(mk + 2 * lane) = cvt_pk_bf16(k0 * rstd * kg[2 * lane], k1 * rstd * kg[2 * lane + 1]);
        const unsigned vu = *(const unsigned*)(kv + 512 + h * 128 + 2 * lane);
        bf16* mv = (bf16*)(a.ws + WS_MEMVT + l * 2 * MiB) + ((size_t)(b * 4 + h) * 128 + 2 * lane) * 256 + m;
        mv[0] = (bf16)(vu & 0xffffu); mv[256] = (bf16)(vu >> 16);
    }
}

__device__ __forceinline__ void ph_p2(const Args& a, int l, LAS unsigned char* lds, int bid, int nb) {
    const int tid = pg8::opaque_tid(), lane = tid & 63, w = tid >> 6;
    const bf16* MIX = (const bf16*)(a.ws + WS_MIX);
    const unsigned char* wb = a.ws + (l ? WS_W1 : WS_W0);
    const bf16* WuqT = (const bf16*)(wb + WO_WUQ); const bf16* WukvT = (const bf16*)(wb + WO_WUKV);
    const float* cqg = a.in[5] + l * 256; const float* ckvg = a.in[6] + l * 128; const float* qg = a.in[9] + l * 96; const float* kg = a.in[10] + l * 96;
    const int* pos = (const int*)a.in[2];
    bf16* Qb = (bf16*)(a.ws + WS_Q); bf16* Kb = (bf16*)(a.ws + WS_K); bf16* Vtb = (bf16*)(a.ws + WS_VT);
    constexpr int AQ_LD = 264, AKV_LD = 136;
    LAS bf16* Aq = (LAS bf16*)lds; LAS bf16* Akv = (LAS bf16*)(lds + 33792);
    LAS float* kr = (LAS float*)(lds + 51200); LAS float* cs = (LAS float*)(lds + 59392); LAS float* sn = (LAS float*)(lds + 63488);
    const float* cqg0 = cqg; const float* ckvg0 = ckvg; const float* qg0 = qg; const float* kg0 = kg;
    for (int u = bid; u < T / 64; u += nb) {
        const int t0 = u * 64;
        int c16 = lane & 15, q4 = lane >> 4; asm volatile("" : "+v"(c16), "+v"(q4));
        int zo = 0; asm volatile("" : "+s"(zo));
        const float* cqg = cqg0 + zo; const float* ckvg = ckvg0 + zo; const float* qg = qg0 + zo; const float* kg = kg0 + zo;
        __syncthreads();
        {
            const int row = tid >> 3, part = tid & 7;
            const bf16* src = MIX + (size_t)(t0 + row) * MIXW;
            v4u x[4]; float ss = 0.f;
#pragma unroll
            for (int i = 0; i < 4; ++i) { x[i] = *(const v4u*)(src + MC_CQ + part * 32 + i * 8);
                ss += bflo(x[i].x) * bflo(x[i].x) + bfhi(x[i].x) * bfhi(x[i].x) + bflo(x[i].y) * bflo(x[i].y) + bfhi(x[i].y) * bfhi(x[i].y)
                    + bflo(x[i].z) * bflo(x[i].z) + bfhi(x[i].z) * bfhi(x[i].z) + bflo(x[i].w) * bflo(x[i].w) + bfhi(x[i].w) * bfhi(x[i].w); }
            ss += __shfl_xor(ss, 1); ss += __shfl_xor(ss, 2); ss += __shfl_xor(ss, 4);
            float rstd = 1.0f / sqrtf(ss * (1.f / 256.f) + EPS);
#pragma unroll
            for (int i = 0; i < 4; ++i) { const float* gp = cqg + part * 32 + i * 8; v4u o;
                o.x = cvt_pk_bf16(bflo(x[i].x) * rstd * gp[0], bfhi(x[i].x) * rstd * gp[1]); o.y = cvt_pk_bf16(bflo(x[i].y) * rstd * gp[2], bfhi(x[i].y) * rstd * gp[3]);
                o.z = cvt_pk_bf16(bflo(x[i].z) * rstd * gp[4], bfhi(x[i].z) * rstd * gp[5]); o.w = cvt_pk_bf16(bflo(x[i].w) * rstd * gp[6], bfhi(x[i].w) * rstd * gp[7]);
                *(LAS v4u*)(Aq + row * AQ_LD + part * 32 + i * 8) = o; }
            v4u y[2]; ss = 0.f;
#pragma unroll
            for (int i = 0; i < 2; ++i) { y[i] = *(const v4u*)(src + MC_CKV + part * 16 + i * 8);
                ss += bflo(y[i].x) * bflo(y[i].x) + bfhi(y[i].x) * bfhi(y[i].x) + bflo(y[i].y) * bflo(y[i].y) + bfhi(y[i].y) * bfhi(y[i].y)
                    + bflo(y[i].z) * bflo(y[i].z) + bfhi(y[i].z) * bfhi(y[i].z) + bflo(y[i].w) * bflo(y[i].w) + bfhi(y[i].w) * bfhi(y[i].w); }
            ss += __shfl_xor(ss, 1); ss += __shfl_xor(ss, 2); ss += __shfl_xor(ss, 4);
            rstd = 1.0f / sqrtf(ss * (1.f / 128.f) + EPS);
#pragma unroll
            for (int i = 0; i < 2; ++i) { const float* gp = ckvg + part * 16 + i * 8; v4u o;
                o.x = cvt_pk_bf16(bflo(y[i].x) * rstd * gp[0], bfhi(y[i].x) * rstd * gp[1]); o.y = cvt_pk_bf16(bflo(y[i].y) * rstd * gp[2], bfhi(y[i].y) * rstd * gp[3]);
                o.z = cvt_pk_bf16(bflo(y[i].z) * rstd * gp[4], bfhi(y[i].z) * rstd * gp[5]); o.w = cvt_pk_bf16(bflo(y[i].w) * rstd * gp[6], bfhi(y[i].w) * rstd * gp[7]);
                *(LAS v4u*)(Akv + row * AKV_LD + part * 16 + i * 8) = o; }
            const v2u z = *(const v2u*)(src + MC_KR + part * 4);
            kr[row * 32 + part * 4 + 0] = bflo(z.x); kr[row * 32 + part * 4 + 1] = bfhi(z.x); kr[row * 32 + part * 4 + 2] = bflo(z.y); kr[row * 32 + part * 4 + 3] = bfhi(z.y);
#pragma unroll
            for (int i = 0; i < 2; ++i) { const int e = tid * 2 + i, r = e >> 4, f = e & 15;
                const float invf = exp2f(-(float)f * (13.287712379549449f / 16.0f));
                const float ang = (float)pos[t0 + r] * invf; float sv, cv; sincosf(ang, &sv, &cv); cs[e] = cv; sn[e] = sv; }
        }
        __syncthreads();
        const int h = w;
        {
            f32x4 acc[4][6];
#pragma unroll
            for (int mt = 0; mt < 4; ++mt)
#pragma unroll
                for (int nt = 0; nt < 6; ++nt) acc[mt][nt] = (f32x4){0.f, 0.f, 0.f, 0.f};
            const bf16* wq0 = WuqT + (size_t)(h * 96 + c16) * 256 + 8 * q4;
            v4u wf[6], wn[6];
#pragma unroll
            for (int nt = 0; nt < 6; ++nt) wf[nt] = *(const v4u*)(wq0 + nt * 16 * 256);
#pragma unroll 1
            for (int ks = 0; ks < 8; ++ks) {
                if (ks + 1 < 8) {
#pragma unroll
                    for (int nt = 0; nt < 6; ++nt) wn[nt] = *(const v4u*)(wq0 + nt * 16 * 256 + (ks + 1) * 32); }
                bf16x8 tf[4];
#pragma unroll
                for (int mt = 0; mt < 4; ++mt) tf[mt] = as_bf8(*(const LAS v4u*)(Aq + (mt * 16 + c16) * AQ_LD + ks * 32 + 8 * q4));
#pragma unroll
                for (int nt = 0; nt < 6; ++nt)
#pragma unroll
                    for (int mt = 0; mt < 4; ++mt) acc[mt][nt] = mfma16(as_bf8(wf[nt]), tf[mt], acc[mt][nt]);
#pragma unroll
                for (int nt = 0; nt < 6; ++nt) wf[nt] = wn[nt];
            }
#pragma unroll
            for (int mt = 0; mt < 4; ++mt) {
                float ss = 0.f;
#pragma unroll
                for (int nt = 0; nt < 6; ++nt) ss += acc[mt][nt][0] * acc[mt][nt][0] + acc[mt][nt][1] * acc[mt][nt][1] + acc[mt][nt][2] * acc[mt][nt][2] + acc[mt][nt][3] * acc[mt][nt][3];
                ss += __shfl_xor(ss, 16); ss += __shfl_xor(ss, 32);
                const float rstd = 1.0f / sqrtf(ss * (1.f / 96.f) + EPS);
                const int r = mt * 16 + c16, t = t0 + r, b = t >> 11, s = t & 2047;
                bf16* qrow = Qb + ((size_t)(b * 8 + h) * SEQ + s) * 96;
#pragma unroll
                for (int nt = 0; nt < 4; ++nt) { const float* gp = qg + nt * 16 + 4 * q4; v2u o;
                    o.x = cvt_pk_bf16(acc[mt][nt][0] * rstd * gp[0], acc[mt][nt][1] * rstd * gp[1]); o.y = cvt_pk_bf16(acc[mt][nt][2] * rstd * gp[2], acc[mt][nt][3] * rstd * gp[3]);
                    *(v2u*)(qrow + nt * 16 + 4 * q4) = o; }
                float o1[4], o2[4];
#pragma unroll
                for (int j = 0; j < 4; ++j) { const int f = 4 * q4 + j; const float x1 = acc[mt][4][j] * rstd * qg[64 + f], x2 = acc[mt][5][j] * rstd * qg[80 + f];
                    const float cv = cs[r * 16 + f], sv = sn[r * 16 + f]; o1[j] = x1 * cv - x2 * sv; o2[j] = x1 * sv + x2 * cv; }
                v2u p1, p2; p1.x = cvt_pk_bf16(o1[0], o1[1]); p1.y = cvt_pk_bf16(o1[2], o1[3]); p2.x = cvt_pk_bf16(o2[0], o2[1]); p2.y = cvt_pk_bf16(o2[2], o2[3]);
                *(v2u*)(qrow + 64 + 4 * q4) = p1; *(v2u*)(qrow + 80 + 4 * q4) = p2;
            }
        }
        __builtin_amdgcn_sched_barrier(0);
        {
            f32x4 acc[4][4];
#pragma unroll
            for (int mt = 0; mt < 4; ++mt)
#pragma unroll
                for (int nt = 0; nt < 4; ++nt) acc[mt][nt] = (f32x4){0.f, 0.f, 0.f, 0.f};
            const bf16* wk0 = WukvT + (size_t)(h * 128 + c16) * 128 + 8 * q4;
            v4u wf[4], wn[4];
#pragma unroll
            for (int nt = 0; nt < 4; ++nt) wf[nt] = *(const v4u*)(wk0 + nt * 16 * 128);
#pragma unroll 1
            for (int ks = 0; ks < 4; ++ks) {
                if (ks + 1 < 4) {
#pragma unroll
                    for (int nt = 0; nt < 4; ++nt) wn[nt] = *(const v4u*)(wk0 + nt * 16 * 128 + (ks + 1) * 32); }
                bf16x8 tf[4];
#pragma unroll
                for (int mt = 0; mt < 4; ++mt) tf[mt] = as_bf8(*(const LAS v4u*)(Akv + (mt * 16 + c16) * AKV_LD + ks * 32 + 8 * q4));
#pragma unroll
                for (int nt = 0; nt < 4; ++nt)
#pragma unroll
                    for (int mt = 0; mt < 4; ++mt) acc[mt][nt] = mfma16(as_bf8(wf[nt]), tf[mt], acc[mt][nt]);
#pragma unroll
                for (int nt = 0; nt < 4; ++nt) wf[nt] = wn[nt];
            }
#pragma unroll
            for (int mt = 0; mt < 4; ++mt) {
                const int r = mt * 16 + c16, t = t0 + r, b = t >> 11, s = t & 2047;
                float kr1[4], kr2[4]; float ss = 0.f;
#pragma unroll
                for (int j = 0; j < 4; ++j) { kr1[j] = kr[r * 32 + 4 * q4 + j]; kr2[j] = kr[r * 32 + 16 + 4 * q4 + j]; ss += kr1[j] * kr1[j] + kr2[j] * kr2[j]; }
#pragma unroll
                for (int nt = 0; nt < 4; ++nt) ss += acc[mt][nt][0] * acc[mt][nt][0] + acc[mt][nt][1] * acc[mt][nt][1] + acc[mt][nt][2] * acc[mt][nt][2] + acc[mt][nt][3] * acc[mt][nt][3];
                ss += __shfl_xor(ss, 16); ss += __shfl_xor(ss, 32);
                const float rstd = 1.0f / sqrtf(ss * (1.f / 96.f) + EPS);
                bf16* krow = Kb + ((size_t)(b * 8 + h) * SEQ + s) * 96;
#pragma unroll
                for (int nt = 0; nt < 4; ++nt) { const float* gp = kg + nt * 16 + 4 * q4; v2u o;
                    o.x = cvt_pk_bf16(acc[mt][nt][0] * rstd * gp[0], acc[mt][nt][1] * rstd * gp[1]); o.y = cvt_pk_bf16(acc[mt][nt][2] * rstd * gp[2], acc[mt][nt][3] * rstd * gp[3]);
                    *(v2u*)(krow + nt * 16 + 4 * q4) = o; }
                float o1[4], o2[4];
#pragma unroll
                for (int j = 0; j < 4; ++j) { const int f = 4 * q4 + j; const float x1 = kr1[j] * rstd * kg[64 + f], x2 = kr2[j] * rstd * kg[80 + f];
                    const float cv = cs[r * 16 + f], sv = sn[r * 16 + f]; o1[j] = x1 * cv - x2 * sv; o2[j] = x1 * sv + x2 * cv; }
                v2u p1, p2; p1.x = cvt_pk_bf16(o1[0], o1[1]); p1.y = cvt_pk_bf16(o1[2], o1[3]); p2.x = cvt_pk_bf16(o2[0], o2[1]); p2.y = cvt_pk_bf16(o2[2], o2[3]);
                *(v2u*)(krow + 64 + 4 * q4) = p1; *(v2u*)(krow + 80 + 4 * q4) = p2;
            }
        }
        __builtin_amdgcn_sched_barrier(0);
        {
            f32x4 acc[4][4];
#pragma unroll
            for (int mt = 0; mt < 4; ++mt)
#pragma unroll
                for (int nt = 0; nt < 4; ++nt) acc[mt][nt] = (f32x4){0.f, 0.f, 0.f, 0.f};
            const bf16* wk0 = WukvT + (size_t)(h * 128 + 64 + c16) * 128 + 8 * q4;
            v4u wf[4], wn[4];
#pragma unroll
            for (int nt = 0; nt < 4; ++nt) wf[nt] = *(const v4u*)(wk0 + nt * 16 * 128);
#pragma unroll 1
            for (int ks = 0; ks < 4; ++ks) {
                if (ks + 1 < 4) {
#pragma unroll
                    for (int nt = 0; nt < 4; ++nt) wn[nt] = *(const v4u*)(wk0 + nt * 16 * 128 + (ks + 1) * 32); }
                bf16x8 tf[4];
#pragma unroll
                for (int mt = 0; mt < 4; ++mt) tf[mt] = as_bf8(*(const LAS v4u*)(Akv + (mt * 16 + c16) * AKV_LD + ks * 32 + 8 * q4));
#pragma unroll
                for (int nt = 0; nt < 4; ++nt)
#pragma unroll
                    for (int mt = 0; mt < 4; ++mt) acc[mt][nt] = mfma16(as_bf8(wf[nt]), tf[mt], acc[mt][nt]);
#pragma unroll
                for (int nt = 0; nt < 4; ++nt) wf[nt] = wn[nt];
            }
#pragma unroll
            for (int mt = 0; mt < 4; ++mt) {
                const int r = mt * 16 + c16, t = t0 + r, b = t >> 11, s = t & 2047;
                bf16* vcol = Vtb + (size_t)(b * 8 + h) * 64 * SEQ + s;
#pragma unroll
                for (int nt = 0; nt < 4; ++nt)
#pragma unroll
                    for (int j = 0; j < 4; ++j) { const int d = nt * 16 + 4 * q4 + j; vcol[(size_t)d * SEQ] = (bf16)(cvt_pk_bf16(acc[mt][nt][j], 0.f) & 0xffffu); }
            }
        }
    }
}
template <int DQK, int DV, bool CAUSAL, bool QNORM>
__device__ __forceinline__ void attn_block(LAS unsigned char* lds, const bf16* Qp, int qpitch, const float* qg, const bf16* Kp, const bf16* Vtp, int vpitch,
                                           int nkt, int row0seq, float scale_log2, bf16* Gp, int gpitch, bool st, const float* kg) {
    constexpr int KS = DQK / 32, DT = DV / 16, KROW = DQK + 8, VROW = 72, KBUF = 64 * KROW * 2, VBUF = DV * VROW * 2;
    constexpr int NKC = 8 * DQK, NVC = 8 * DV, KPT = (NKC + NTHR - 1) / NTHR, VPT = (NVC + NTHR - 1) / NTHR;
    static_assert(2 * KBUF + 2 * VBUF <= 131072, "attention LDS");
    const int tid = pg8::opaque_tid(), lane = tid & 63, w = tid >> 6, c16 = lane & 15, q4 = lane >> 4;
    __syncthreads();
    bf16x8 qf[2][KS];
    {
        v4u raw[2][KS];
#pragma unroll
        for (int qt = 0; qt < 2; ++qt)
#pragma unroll
            for (int ks = 0; ks < KS; ++ks) raw[qt][ks] = *(const v4u*)(Qp + (size_t)(32 * w + 16 * qt + c16) * qpitch + ks * 32 + 8 * q4);
        if (QNORM) {
#pragma unroll
            for (int qt = 0; qt < 2; ++qt) {
                float ss = 0.f;
#pragma unroll
                for (int ks = 0; ks < KS; ++ks) { const v4u x = raw[qt][ks];
                    ss += bflo(x.x) * bflo(x.x) + bfhi(x.x) * bfhi(x.x) + bflo(x.y) * bflo(x.y) + bfhi(x.y) * bfhi(x.y) + bflo(x.z) * bflo(x.z) + bfhi(x.z) * bfhi(x.z) + bflo(x.w) * bflo(x.w) + bfhi(x.w) * bfhi(x.w); }
                ss += __shfl_xor(ss, 16); ss += __shfl_xor(ss, 32);
                const float rstd = 1.0f / sqrtf(ss * (1.f / DQK) + EPS);
#pragma unroll
                for (int ks = 0; ks < KS; ++ks) { const v4u x = raw[qt][ks]; const float* gp = qg + ks * 32 + 8 * q4; v4u o;
                    o.x = cvt_pk_bf16(bflo(x.x) * rstd * gp[0], bfhi(x.x) * rstd * gp[1]); o.y = cvt_pk_bf16(bflo(x.y) * rstd * gp[2], bfhi(x.y) * rstd * gp[3]);
                    o.z = cvt_pk_bf16(bflo(x.z) * rstd * gp[4], bfhi(x.z) * rstd * gp[5]); o.w = cvt_pk_bf16(bflo(x.w) * rstd * gp[6], bfhi(x.w) * rstd * gp[7]);
                    raw[qt][ks] = o; }
            }
        }
#pragma unroll
        for (int qt = 0; qt < 2; ++qt)
#pragma unroll
            for (int ks = 0; ks < KS; ++ks) qf[qt][ks] = as_bf8(raw[qt][ks]);
    }
    v4u kreg[KPT], vreg[VPT];
#define ATT_GLOAD(kt) do { if constexpr (!QNORM) { \
    _Pragma("unroll") for (int i = 0; i < KPT; ++i) { const int ch = tid + i * NTHR; if (ch < NKC) kreg[i] = *(const v4u*)(Kp + (size_t)(kt) * 64 * DQK + (size_t)ch * 8); } \
    _Pragma("unroll") for (int i = 0; i < VPT; ++i) { const int ch = tid + i * NTHR; if (ch < NVC) vreg[i] = *(const v4u*)(Vtp + (size_t)(ch >> 3) * vpitch + (kt) * 64 + (ch & 7) * 8); } \
  } else { \
    _Pragma("unroll") for (int i = 0; i < KPT; ++i) { const int ch = tid + i * NTHR; kreg[i] = *(const v4u*)(Kp + (size_t)((kt) * 64 + (ch >> 4)) * 1024 + (ch & 15) * 8); } \
    _Pragma("unroll") for (int i = 0; i < VPT; ++i) { const int ch = tid + i * NTHR; vreg[i] = *(const v4u*)(Vtp + (size_t)((kt) * 64 + (ch & 63)) * 1024 + (ch >> 6) * 8); } \
  } } while (0)
#define ATT_LSTORE(buf) do { if constexpr (!QNORM) { \
    _Pragma("unroll") for (int i = 0; i < KPT; ++i) { const int ch = tid + i * NTHR; if (ch < NKC) *(LAS v4u*)(lds + (buf) * KBUF + (ch / (DQK / 8)) * (KROW * 2) + (ch % (DQK / 8)) * 16) = kreg[i]; } \
    _Pragma("unroll") for (int i = 0; i < VPT; ++i) { const int ch = tid + i * NTHR; if (ch < NVC) *(LAS v4u*)(lds + 2 * KBUF + (buf) * VBUF + (ch >> 3) * (VROW * 2) + (ch & 7) * 16) = vreg[i]; } \
  } else { \
    _Pragma("unroll") for (int i = 0; i < KPT; ++i) { const int ch = tid + i * NTHR; const v4u x = kreg[i]; \
        float ss = bflo(x.x) * bflo(x.x) + bfhi(x.x) * bfhi(x.x) + bflo(x.y) * bflo(x.y) + bfhi(x.y) * bfhi(x.y) + bflo(x.z) * bflo(x.z) + bfhi(x.z) * bfhi(x.z) + bflo(x.w) * bflo(x.w) + bfhi(x.w) * bfhi(x.w); \
        ss += __shfl_xor(ss, 1); ss += __shfl_xor(ss, 2); ss += __shfl_xor(ss, 4); ss += __shfl_xor(ss, 8); \
        const float rs = 1.0f / sqrtf(ss * (1.f / 128.f) + EPS); const float* gp = kg + (ch & 15) * 8; v4u o; \
        o.x = cvt_pk_bf16(bflo(x.x) * rs * gp[0], bfhi(x.x) * rs * gp[1]); o.y = cvt_pk_bf16(bflo(x.y) * rs * gp[2], bfhi(x.y) * rs * gp[3]); \
        o.z = cvt_pk_bf16(bflo(x.z) * rs * gp[4], bfhi(x.z) * rs * gp[5]); o.w = cvt_pk_bf16(bflo(x.w) * rs * gp[6], bfhi(x.w) * rs * gp[7]); \
        *(LAS v4u*)(lds + (buf) * KBUF + (ch >> 4) * (KROW * 2) + (ch & 15) * 16) = o; } \
    _Pragma("unroll") for (int i = 0; i < VPT; ++i) { const int ch = tid + i * NTHR; const v4u x = vreg[i]; \
        LAS bf16* vd = (LAS bf16*)(lds + 2 * KBUF + (buf) * VBUF) + ((ch >> 6) * 8) * VROW + (ch & 63); \
        vd[0 * VROW] = (bf16)(x.x & 0xffffu); vd[1 * VROW] = (bf16)(x.x >> 16); vd[2 * VROW] = (bf16)(x.y & 0xffffu); vd[3 * VROW] = (bf16)(x.y >> 16); \
        vd[4 * VROW] = (bf16)(x.z & 0xffffu); vd[5 * VROW] = (bf16)(x.z >> 16); vd[6 * VROW] = (bf16)(x.w & 0xffffu); vd[7 * VROW] = (bf16)(x.w >> 16); } \
  } } while (0)
    ATT_GLOAD(0); ATT_LSTORE(0);
    __syncthreads();
    float m_run[2] = {-1e30f, -1e30f}, l_run[2] = {0.f, 0.f};
    f32x4 o[DT][2];
#pragma unroll
    for (int dt = 0; dt < DT; ++dt) { o[dt][0] = (f32x4){0.f, 0.f, 0.f, 0.f}; o[dt][1] = (f32x4){0.f, 0.f, 0.f, 0.f}; }
    const int rw0 = row0seq + 32 * w;
    for (int kt = 0; kt < nkt; ++kt) {
        if (kt + 1 < nkt) ATT_GLOAD(kt + 1);
        const int k0 = kt * 64;
        const bool active = !CAUSAL || (k0 <= rw0 + 31);
        if (active) {
            const LAS unsigned char* kb = lds + (kt & 1) * KBUF; const LAS unsigned char* vb = lds + 2 * KBUF + (kt & 1) * VBUF;
            f32x4 s[4][2];
#pragma unroll
            for (int kk = 0; kk < 4; ++kk) { s[kk][0] = (f32x4){0.f, 0.f, 0.f, 0.f}; s[kk][1] = (f32x4){0.f, 0.f, 0.f, 0.f}; }
#pragma unroll
            for (int kk = 0; kk < 4; ++kk)
#pragma unroll
                for (int ks = 0; ks < KS; ++ks) { const bf16x8 kf = as_bf8(*(const LAS v4u*)(kb + (kk * 16 + c16) * (KROW * 2) + (ks * 32 + 8 * q4) * 2));
                    s[kk][0] = mfma16(kf, qf[0][ks], s[kk][0]); s[kk][1] = mfma16(kf, qf[1][ks], s[kk][1]); }
            const bool needmask = CAUSAL && (k0 + 63 > rw0);
            bf16x8 pf[2][2];
#pragma unroll
            for (int qt = 0; qt < 2; ++qt) {
                const int rowi = rw0 + 16 * qt + c16;
                float tmax = -INFINITY;
#pragma unroll
                for (int kk = 0; kk < 4; ++kk)
#pragma unroll
                    for (int j = 0; j < 4; ++j) { float v = s[kk][qt][j] * scale_log2;
                        if (needmask) { const int key = k0 + kk * 16 + 4 * q4 + j; v = (key > rowi) ? -INFINITY : v; }
                        s[kk][qt][j] = v; tmax = fmaxf(tmax, v); }
                tmax = fmaxf(tmax, __shfl_xor(tmax, 16)); tmax = fmaxf(tmax, __shfl_xor(tmax, 32));
                const float mnew = fmaxf(m_run[qt], tmax), alpha = __builtin_amdgcn_exp2f(m_run[qt] - mnew);
                m_run[qt] = mnew;
                float psum = 0.f;
#pragma unroll
                for (int kk = 0; kk < 4; ++kk)
#pragma unroll
                    for (int j = 0; j < 4; ++j) { const float p = __builtin_amdgcn_exp2f(s[kk][qt][j] - mnew); s[kk][qt][j] = p; psum += p; }
                l_run[qt] = l_run[qt] * alpha + psum;
#pragma unroll
                for (int dt = 0; dt < DT; ++dt) o[dt][qt] = o[dt][qt] * alpha;
#pragma unroll
                for (int kp = 0; kp < 2; ++kp) { v4u pp;
                    pp.x = cvt_pk_bf16(s[2 * kp][qt][0], s[2 * kp][qt][1]); pp.y = cvt_pk_bf16(s[2 * kp][qt][2], s[2 * kp][qt][3]);
                    pp.z = cvt_pk_bf16(s[2 * kp + 1][qt][0], s[2 * kp + 1][qt][1]); pp.w = cvt_pk_bf16(s[2 * kp + 1][qt][2], s[2 * kp + 1][qt][3]);
                    pf[qt][kp] = as_bf8(pp); }
            }
#pragma unroll
            for (int dt = 0; dt < DT; ++dt)
#pragma unroll
                for (int kp = 0; kp < 2; ++kp) {
                    const LAS unsigned char* vp = vb + (dt * 16 + c16) * (VROW * 2) + (32 * kp + 4 * q4) * 2;
                    const v2u a0 = *(const LAS v2u*)vp, a1 = *(const LAS v2u*)(vp + 32);
                    const bf16x8 vf = as_bf8((v4u){a0.x, a0.y, a1.x, a1.y});
                    o[dt][0] = mfma16(vf, pf[0][kp], o[dt][0]); o[dt][1] = mfma16(vf, pf[1][kp], o[dt][1]);
                }
        }
        if (kt + 1 < nkt) ATT_LSTORE((kt + 1) & 1);
        __syncthreads();
    }
#undef ATT_GLOAD
#undef ATT_LSTORE
#pragma unroll
    for (int qt = 0; qt < 2; ++qt) {
        float lt = l_run[qt]; lt += __shfl_xor(lt, 16); lt += __shfl_xor(lt, 32);
        const float inv = 1.0f / lt;
        bf16* gr = Gp + (size_t)(32 * w + 16 * qt + c16) * gpitch + 4 * q4;
#pragma unroll
        for (int dt = 0; dt < DT; ++dt) { const v2u g = *(const v2u*)(gr + dt * 16); v2u r;
            r.x = cvt_pk_bf16(o[dt][qt][0] * inv * bflo(g.x), o[dt][qt][1] * inv * bfhi(g.x)); r.y = cvt_pk_bf16(o[dt][qt][2] * inv * bflo(g.y), o[dt][qt][3] * inv * bfhi(g.y));
            if (st) *(v2u*)(gr + dt * 16) = r; }
    }
}

__device__ __forceinline__ void ph_mla(const Args& a, LAS unsigned char* lds, int bid, int nb, bool st) {
    const bf16* Qb = (const bf16*)(a.ws + WS_Q); const bf16* Kb = (const bf16*)(a.ws + WS_K); const bf16* Vtb = (const bf16*)(a.ws + WS_VT); bf16* G = (bf16*)(a.ws + WS_G);
    const float sc = 0.10206207261596577f * 1.4426950408889634f;
    for (int u = bid; u < 256; u += nb) {
        const int b = u >> 5, h = (u >> 2) & 7, p = u & 3;
        for (int half = 0; half < 2; ++half) {
            const int jb = half ? p : 7 - p;
            const size_t bh = (size_t)(b * 8 + h);
            attn_block<96, 64, true, false>(lds, Qb + (bh * SEQ + 256 * jb) * 96, 96, nullptr, Kb + bh * SEQ * 96, Vtb + bh * 64 * SEQ, SEQ, 4 * (jb + 1), 256 * jb, sc,
                                            G + (size_t)(b * SEQ + 256 * jb) * GW + h * 64, GW, st, nullptr);
        }
    }
}
__device__ __forceinline__ void ph_memattn(const Args& a, int l, LAS unsigned char* lds, int bid, int nb, bool st) {
    const bf16* MIX = (const bf16*)(a.ws + WS_MIX); bf16* G = (bf16*)(a.ws + WS_G);
    const bf16* kvraw = (const bf16*)(a.ws + WS_KVRAW + l * 4 * MiB);
    const float sc = 0.08838834764831845f * 1.4426950408889634f;
    for (int u = bid; u < 256; u += nb) {
        const int tb = u >> 2, h = u & 3, t0 = tb * 256, b = t0 >> 11;
        attn_block<128, 128, false, true>(lds, MIX + (size_t)t0 * MIXW + MC_MQ + h * 128, MIXW, a.in[19] + l * 128, kvraw + (size_t)(b * 256) * 1024 + h * 128, kvraw + (size_t)(b * 256) * 1024 + 512 + h * 128, 256,
                                          4, 0, sc, G + (size_t)t0 * GW + 3 * 512 + h * 128, GW, st, a.in[20] + l * 128);
    }
}

__device__ __forceinline__ void ph_sg(const Args& a, int l, LAS unsigned char* lds, int bid, int nb, bool st) {
    const int tid = pg8::opaque_tid(), lane = tid & 63, w = tid >> 6, c16 = lane & 15, q4 = lane >> 4;
    const bf16* MIX = (const bf16*)(a.ws + WS_MIX); bf16* G = (bf16*)(a.ws + WS_G);
    const float* lng = a.in[13] + l * 512; const float* lnb = a.in[14] + l * 512; const float* ws_ = a.in[15] + (size_t)l * 4 * 128 * 128; const float* bs = a.in[16] + l * 4 * 128;
    LAS float* stat = (LAS float*)lds; LAS bf16* vT = (LAS bf16*)(lds + 1024); constexpr int VLD = 136;
    for (int u = bid; u < 512; u += nb) {
        const int c = u >> 2, g = u & 3, t0 = c * 128;
        __syncthreads();
        {   const int row = tid >> 2, part = tid & 3; const bf16* src = MIX + (size_t)(t0 + row) * MIXW + MC_V + part * 128;
            float s1 = 0.f, s2 = 0.f;
#pragma unroll 4
            for (int i = 0; i < 16; ++i) { const v4u x = *(const v4u*)(src + i * 8);
                const float f0 = bflo(x.x), f1 = bfhi(x.x), f2 = bflo(x.y), f3 = bfhi(x.y), f4 = bflo(x.z), f5 = bfhi(x.z), f6 = bflo(x.w), f7 = bfhi(x.w);
                s1 += ((f0 + f1) + (f2 + f3)) + ((f4 + f5) + (f6 + f7)); s2 += ((f0 * f0 + f1 * f1) + (f2 * f2 + f3 * f3)) + ((f4 * f4 + f5 * f5) + (f6 * f6 + f7 * f7)); }
            s1 += __shfl_xor(s1, 1); s1 += __shfl_xor(s1, 2); s2 += __shfl_xor(s2, 1); s2 += __shfl_xor(s2, 2);
            const float mean = s1 * (1.f / 512.f), var = fmaxf(s2 * (1.f / 512.f) - mean * mean, 0.f);
            if (part == 0) { stat[row * 2] = mean; stat[row * 2 + 1] = 1.0f / sqrtf(var + EPS); }
        }
        __syncthreads();
        {   const int s = tid & 127, dq = tid >> 7; const bf16* src = MIX + (size_t)(t0 + s) * MIXW + MC_V + g * 128 + dq * 32;
            const float mean = stat[s * 2], rstd = stat[s * 2 + 1];
#pragma unroll
            for (int i = 0; i < 4; ++i) { const v4u x = *(const v4u*)(src + i * 8); const int d0 = dq * 32 + i * 8; const float* gp = lng + g * 128 + d0; const float* bp = lnb + g * 128 + d0;
                float f[8] = {bflo(x.x), bfhi(x.x), bflo(x.y), bfhi(x.y), bflo(x.z), bfhi(x.z), bflo(x.w), bfhi(x.w)};
#pragma unroll
                for (int e = 0; e < 8; ++e) { const float y = (f[e] - mean) * rstd * gp[e] + bp[e]; vT[(d0 + e) * VLD + s] = (bf16)(cvt_pk_bf16(y, 0.f) & 0xffffu); } }
        }
        __syncthreads();
        {   f32x4 acc[8];
#pragma unroll
            for (int nt = 0; nt < 8; ++nt) acc[nt] = (f32x4){0.f, 0.f, 0.f, 0.f};
            const int tt = 16 * w + c16, nks = (w >> 1) + 1;
            const float* wrow = ws_ + ((size_t)g * 128 + tt) * 128;
            for (int ks = 0; ks < nks; ++ks) {
                const int s0 = ks * 32 + 8 * q4;
                const f32x4 w0 = *(const f32x4*)(wrow + s0), w1 = *(const f32x4*)(wrow + s0 + 4);
                float wv[8] = {w0[0], w0[1], w0[2], w0[3], w1[0], w1[1], w1[2], w1[3]};
#pragma unroll
                for (int e = 0; e < 8; ++e) wv[e] = (s0 + e <= tt) ? wv[e] : 0.f;
                v4u wp; wp.x = cvt_pk_bf16(wv[0], wv[1]); wp.y = cvt_pk_bf16(wv[2], wv[3]); wp.z = cvt_pk_bf16(wv[4], wv[5]); wp.w = cvt_pk_bf16(wv[6], wv[7]);
                const bf16x8 bfrag = as_bf8(wp);
#pragma unroll
                for (int nt = 0; nt < 8; ++nt) { const bf16x8 af = as_bf8(*(const LAS v4u*)(vT + (nt * 16 + c16) * VLD + s0)); acc[nt] = mfma16(af, bfrag, acc[nt]); }
            }
            const int t = t0 + tt; const float bias = bs[g * 128 + tt];
            const bf16* up = MIX + (size_t)t * MIXW + MC_U + g * 128 + 4 * q4; bf16* gp = G + (size_t)t * GW + 2 * 512 + g * 128 + 4 * q4;
#pragma unroll
            for (int nt = 0; nt < 8; ++nt) { const v2u uu = *(const v2u*)(up + nt * 16), gg = *(const v2u*)(gp + nt * 16); v2u r;
                r.x = cvt_pk_bf16(bflo(uu.x) * (acc[nt][0] + bias) * bflo(gg.x), bfhi(uu.x) * (acc[nt][1] + bias) * bfhi(gg.x));
                r.y = cvt_pk_bf16(bflo(uu.y) * (acc[nt][2] + bias) * bflo(gg.y), bfhi(uu.y) * (acc[nt][3] + bias) * bfhi(gg.y));
                if (st) *(v2u*)(gp + nt * 16) = r; }
        }
    }
}

__device__ __forceinline__ void ph_conv(const Args& a, int l, int bid, int nb, bool st) {
    const bf16* MIX = (const bf16*)(a.ws + WS_MIX); bf16* G = (bf16*)(a.ws + WS_G);
    const float* cw = a.in[11] + l * 3 * 512; const float* cb = a.in[12] + l * 512;
    for (int idx = bid * NTHR + pg8::opaque_tid(); idx < T * 64; idx += nb * NTHR) {
        const int t = idx >> 6, c = (idx & 63) * 8, s = t & 2047;
        const bf16* row = MIX + (size_t)t * MIXW;
        const v4u bg = *(const v4u*)(row + MC_BG + c);
        float z[3][8];
#pragma unroll
        for (int d = 0; d < 3; ++d) {
            if (s - d >= 0) { const v4u cgv = *(const v4u*)(row - (size_t)d * MIXW + MC_CG + c), xv = *(const v4u*)(row - (size_t)d * MIXW + MC_XIN + c);
                z[d][0] = bflo(cgv.x) * bflo(xv.x); z[d][1] = bfhi(cgv.x) * bfhi(xv.x); z[d][2] = bflo(cgv.y) * bflo(xv.y); z[d][3] = bfhi(cgv.y) * bfhi(xv.y);
                z[d][4] = bflo(cgv.z) * bflo(xv.z); z[d][5] = bfhi(cgv.z) * bfhi(xv.z); z[d][6] = bflo(cgv.w) * bflo(xv.w); z[d][7] = bfhi(cgv.w) * bfhi(xv.w); }
            else {
#pragma unroll
                for (int e = 0; e < 8; ++e) z[d][e] = 0.f; }
        }
        bf16* gp = G + (size_t)t * GW + 512 + c; const v4u gg = *(const v4u*)gp;
        const float bgf[8] = {bflo(bg.x), bfhi(bg.x), bflo(bg.y), bfhi(bg.y), bflo(bg.z), bfhi(bg.z), bflo(bg.w), bfhi(bg.w)};
        const float ggf[8] = {bflo(gg.x), bfhi(gg.x), bflo(gg.y), bfhi(gg.y), bflo(gg.z), bfhi(gg.z), bflo(gg.w), bfhi(gg.w)};
        float y[8];
#pragma unroll
        for (int e = 0; e < 8; ++e) y[e] = bgf[e] * (cb[c + e] + cw[c + e] * z[2][e] + cw[512 + c + e] * z[1][e] + cw[1024 + c + e] * z[0][e]) * ggf[e];
        v4u r; r.x = cvt_pk_bf16(y[0], y[1]); r.y = cvt_pk_bf16(y[2], y[3]); r.z = cvt_pk_bf16(y[4], y[5]); r.w = cvt_pk_bf16(y[6], y[7]);
        if (st) *(v4u*)gp = r;
    }
}
#define XB_TMO      128
#define XB_XCNT(j)  (256  + 64 * (j))
#define XB_XSUB(j)  (1280 + 64 * (j))
#define XB_XGEN(j)  (2304 + 64 * (j))
#define XB_TOP      3328
#define XB_TOPGEN   3392
#define XCD_BAR_WORDS 3456
#define XB_SPIN_CAP (1u << 18)

__device__ __forceinline__ unsigned xb_ld(unsigned* p)              { return __hip_atomic_load(p, __ATOMIC_RELAXED, __HIP_MEMORY_SCOPE_AGENT); }
__device__ __forceinline__ unsigned xb_add(unsigned* p, unsigned v) { return __hip_atomic_fetch_add(p, v, __ATOMIC_RELAXED, __HIP_MEMORY_SCOPE_AGENT); }
__device__ __forceinline__ unsigned xb_xcc_id() { return (unsigned)__builtin_amdgcn_s_getreg((3 << 11) | 20) & 0xFu; }
#define XB_SPIN(cond, bar) do { unsigned _sp = 0; while (cond) { __builtin_amdgcn_s_sleep(1); \
    if ((++_sp & 255u) == 0u) { if (xb_ld(&(bar)[XB_TMO])) break; if (_sp > XB_SPIN_CAP) { atomicAdd(&(bar)[XB_TMO], 1u); break; } } } } while (0)

struct XcdBarrier {
    unsigned* bar; unsigned x;
    volatile LAS unsigned* st;
};

__device__ __forceinline__ XcdBarrier xcd_barrier_post(unsigned* bar, volatile LAS unsigned* st) {
    XcdBarrier b; b.bar = bar; b.x = xb_xcc_id(); b.st = st;
    if (threadIdx.x == 0) (void)xb_add(&bar[XB_XCNT(b.x)], 1u);
    return b;
}
__device__ __forceinline__ void xcd_barrier_complete(unsigned* bar, unsigned x, unsigned& nloc, unsigned& nx) {
    const unsigned G = gridDim.x * gridDim.y * gridDim.z;
    unsigned sum, cnt, mine, sp = 0u;
    for (;;) {
        sum = 0u; cnt = 0u; mine = 0u;
#pragma unroll
        for (unsigned j = 0; j < 16; ++j) { const unsigned c = xb_ld(&bar[XB_XCNT(j)]); sum += c; cnt += (c > 0u) ? 1u : 0u; mine = (j == x) ? c : mine; }
        if (sum == G) break;
        __builtin_amdgcn_s_sleep(1);
        if ((++sp & 255u) == 0u) { if (xb_ld(&bar[XB_TMO])) break; if (sp > XB_SPIN_CAP) { atomicAdd(&bar[XB_TMO], 1u); break; } }
    }
    nloc = mine > 0u ? mine : 1u; nx = cnt > 0u ? cnt : 1u;
}

__device__ __forceinline__ void xcd_barrier(const XcdBarrier& b) {
    asm volatile("s_waitcnt vmcnt(0)" ::: "memory");
    __syncthreads();
    if (threadIdx.x == 0) {
        unsigned* bar = b.bar;
        __builtin_amdgcn_s_waitcnt(0);
        unsigned nloc = b.st[0], nx = b.st[1];
        if (nloc == 0u) { xcd_barrier_complete(bar, b.x, nloc, nx); b.st[0] = nloc; b.st[1] = nx; }
        const unsigned old = xb_add(&bar[XB_XSUB(b.x)], 1u);
        const unsigned gen = old / nloc;
        if (old + 1u == (gen + 1u) * nloc) {
            __builtin_amdgcn_fence(__ATOMIC_RELEASE, "agent");
            asm volatile("s_waitcnt vmcnt(0)" ::: "memory");
            const unsigned og = xb_add(&bar[XB_TOP], 1u);
            const unsigned tg = og / nx;
            if (og + 1u == (tg + 1u) * nx) xb_add(&bar[XB_TOPGEN], 1u);
            else XB_SPIN(xb_ld(&bar[XB_TOPGEN]) == tg, bar);
            __builtin_amdgcn_fence(__ATOMIC_ACQUIRE, "agent");
            xb_add(&bar[XB_XGEN(b.x)], 1u);
            asm volatile("s_waitcnt vmcnt(0)" ::: "memory");
        } else {
            XB_SPIN(xb_ld(&bar[XB_XGEN(b.x)]) == gen, bar);
            __builtin_amdgcn_fence(__ATOMIC_ACQUIRE, "agent");
            asm volatile("s_waitcnt vmcnt(0)" ::: "memory");
        }
    }
    __syncthreads();
}

#ifndef MK_PER_PHASE
#define MK_PER_PHASE 0
#endif
constexpr int NPH = 1 + 8 + 7;
__global__ void __launch_bounds__(NTHR, 2) mk_fwd(Args a) {
    extern __shared__ __attribute__((aligned(16))) unsigned char lds_raw[];
    LAS unsigned char* lds = (LAS unsigned char*)lds_raw;
    cg::grid_group grid = cg::this_grid();
    const int bid = blockIdx.x, nb = gridDim.x;
    const int lo = a.ph_lo, hi = a.ph_hi; const bool real = (hi > 0);
    volatile LAS unsigned* MISC = (volatile LAS unsigned*)(lds + 131072);
    if (threadIdx.x < 32) MISC[threadIdx.x] = 0u;
    __syncthreads();
    const XcdBarrier bar = xcd_barrier_post((unsigned*)a.ws + 1024, MISC + 8);
    bf16* H = (bf16*)(a.ws + WS_H); bf16* MIX = (bf16*)(a.ws + WS_MIX); bf16* G = (bf16*)(a.ws + WS_G); bf16* GATE = (bf16*)(a.ws + WS_GATE); bf16* MERGED = (bf16*)(a.ws + WS_MERGED);
#define IN(k) (lo <= (k) && (k) < hi)
#define SEAM(k) do { if (IN((k) + 1)) { if ((k) == 0) grid.sync(); else xcd_barrier(bar); } } while (0)
    if (IN(0)) {
#ifdef DUP_PRO
        ph_prologue(a, lds, bid, nb); __syncthreads();
#endif
#ifdef DUP_SYNC
        for (int i = 0; i < 16; ++i) grid.sync();
#endif
        ph_prologue(a, lds, bid, nb); SEAM(0); }
    for (int l = 0; l < 2; ++l) {
        const int base = 1 + 8 * l;
        const unsigned char* wb = a.ws + (l ? WS_W1 : WS_W0);
        const bf16* WinT = (const bf16*)(wb + WO_WIN);
        const float* xl = l ? a.out : a.in[0];
        const bf16* Hl = l ? H : (const bf16*)a.out;
        if (IN(base + 0)) {
            pg8::Gemm g{Hl, DM, WinT, T, NA, DM};
            pg8::StaticOrder S; S.init(T, NA, nb, bid);
            pg8::EpiAct<1> E{MIX, MIXW, 14, G, GW, nullptr};
#ifdef DUP_P1A
            pg8::gemm_phase<pg8::EpiAct<1>, pg8::StaticOrder, true, true>(lds, g, S, E);
#endif
            pg8::gemm_phase<pg8::EpiAct<1>, pg8::StaticOrder, true, true>(lds, g, S, E);
            if (l == 0) {
                for (int ll = 0; ll < 2; ++ll) {
                    pg8::Gemm g2{(const bf16*)(a.ws + WS_MEMN + ll * 4 * MiB), DM, (const bf16*)(a.ws + WS_WMEMT + ll * 2 * MiB), MEMT, 1024, DM};
                    pg8::StaticOrder S2; S2.init(MEMT, 1024, nb, (bid + 2 * nb - 128 - 32 * ll) % nb);
                    pg8::EpiAct<0> E2{(bf16*)(a.ws + WS_KVRAW + ll * 4 * MiB), 1024, 1 << 20, nullptr, 0, nullptr};
                    pg8::gemm_phase<pg8::EpiAct<0>, pg8::StaticOrder, true, true>(lds, g2, S2, E2);
                }
            }
            SEAM(base + 0);
        }
        if (IN(base + 1)) {
#ifdef DUP_P2
            ph_p2(a, l, lds, bid, nb);
#endif
            ph_p2(a, l, lds, bid, nb); SEAM(base + 1); }
        if (IN(base + 2)) {
#ifdef DUP_MLA
            ph_mla(a, lds, bid, nb, !real);
#endif
#ifdef DUP_MIX3
            ph_memattn(a, l, lds, bid, nb, !real); ph_sg(a, l, lds, bid, nb, !real); ph_conv(a, l, bid, nb, !real);
#endif
            ph_mla(a, lds, bid, nb, real); ph_memattn(a, l, lds, bid, nb, real); ph_sg(a, l, lds, bid, nb, real); ph_conv(a, l, bid, nb, real); __syncthreads(); SEAM(base + 2); }
        if (l == 1 && IN(base + 3)) {
#ifdef DUP_NP
            norm_rows(xl, a.in[3] + l * DM, H, T, bid, nb);
#endif
            norm_rows(xl, a.in[3] + l * DM, H, T, bid, nb); SEAM(base + 3); }
        if (IN(base + 4)) {
            pg8::Gemm g{Hl, DM, WinT + (size_t)NA * DM, T, GATEW, DM};
            pg8::StaticOrder S; S.init(T, GATEW, nb, bid);
            pg8::EpiAct<2> E{nullptr, 0, 0, GATE, GATEW, a.in[21] + l * 4096};
#ifdef DUP_P1B
            pg8::gemm_phase<pg8::EpiAct<2>, pg8::StaticOrder, true, true>(lds, g, S, E);
#endif
            pg8::gemm_phase<pg8::EpiAct<2>, pg8::StaticOrder, true, true>(lds, g, S, E);
            SEAM(base + 4);
        }
        if (IN(base + 5)) {
            pg8::Gemm g{G, GW, (const bf16*)(wb + WO_WBR), T, DM, 2048};
            pg8::StaticOrder S; S.init(T, DM, nb, bid);
            pg8::EpiGate E{GATE, MERGED};
#ifdef DUP_P4
            pg8::gemm_phase<pg8::EpiGate, pg8::StaticOrder, false, true>(lds, g, S, E);
#endif
            pg8::gemm_phase<pg8::EpiGate, pg8::StaticOrder, false, true>(lds, g, S, E);
            SEAM(base + 5);
        }
        if (IN(base + 6)) {
            pg8::Gemm g{MERGED, DM, (const bf16*)(wb + WO_WOUT), T, DM, DM};
            pg8::StaticOrder S; S.init(T, DM, nb, bid);
#ifdef DUP_P5
            { pg8::EpiRes E0{xl, a.out, DM, !real}; pg8::gemm_phase<pg8::EpiRes, pg8::StaticOrder, false, true>(lds, g, S, E0); }
#endif
            pg8::EpiRes E{xl, a.out, DM, real};
            pg8::gemm_phase<pg8::EpiRes, pg8::StaticOrder, false, true>(lds, g, S, E);
            if (l == 0) SEAM(base + 6);
        }
        if (l == 0 && IN(base + 7)) { norm_rows(a.out, a.in[3] + DM, H, T, bid, nb); SEAM(base + 7); }
    }
#undef IN
#undef SEAM
}

extern "C" void kernel_launch(void* const* d_in, const int* in_sizes, int n_in, void* d_out, int out_size, void* d_ws, size_t ws_size, hipStream_t stream) {
    static int grid = 0;
    if (grid == 0) {
        if (n_in != 24 || out_size != T * DM || ws_size < WS_END) { fprintf(stderr, "kernel_launch: unexpected problem (n_in %d out %d ws %zu)\n", n_in, out_size, ws_size); grid = -1; return; }
        int dev = 0, cus = 0, per_cu = 0;
        hipGetDevice(&dev); hipDeviceGetAttribute(&cus, hipDeviceAttributeMultiprocessorCount, dev);
        if (hipFuncSetAttribute((const void*)mk_fwd, hipFuncAttributeMaxDynamicSharedMemorySize, LDS_BYTES) != hipSuccess) { fprintf(stderr, "kernel_launch: hipFuncSetAttribute failed\n"); grid = -1; return; }
        if (hipOccupancyMaxActiveBlocksPerMultiprocessor(&per_cu, (const void*)mk_fwd, NTHR, LDS_BYTES) != hipSuccess || per_cu < 1) { fprintf(stderr, "kernel_launch: occupancy query says %d\n", per_cu); per_cu = 1; }
        (void)hipGetLastError();
        grid = cus;
    }
    if (grid < 0) return;
    if (hipMemsetAsync(d_ws, 0, 65536, stream) != hipSuccess) { fprintf(stderr, "kernel_launch: memset failed\n"); return; }
    Args a{};
    for (int i = 0; i < 24; ++i) a.in[i] = (const float*)d_in[i];
    a.out = (float*)d_out; a.ws = (unsigned char*)d_ws;
#if MK_PER_PHASE
    for (int p = 0; p < NPH; ++p) { a.ph_lo = p; a.ph_hi = p + 1; void* args[] = {&a};
        hipError_t e = hipLaunchCooperativeKernel((void*)mk_fwd, dim3(grid), dim3(NTHR), args, LDS_BYTES, stream);
        if (e != hipSuccess) { fprintf(stderr, "launch %d failed: %s\n", p, hipGetErrorString(e)); break; } }
#else
    a.ph_lo = 0; a.ph_hi = NPH; void* args[] = {&a};
    hipError_t e = hipLaunchCooperativeKernel((void*)mk_fwd, dim3(grid), dim3(NTHR), args, LDS_BYTES, stream);
    if (e != hipSuccess) fprintf(stderr, "cooperative launch failed: %s (grid %d)\n", hipGetErrorString(e), grid);
#endif
}
```

```cpp
#include <hip/hip_runtime.h>
#include <hip/hip_cooperative_groups.h>
#include <cstdio>
#include <cstdint>
namespace cg = cooperative_groups;
namespace pg8 {
#define PG8_LAS __attribute__((address_space(3)))
typedef unsigned short bf16_t;
typedef short bf16x8 __attribute__((ext_vector_type(8)));
typedef float f32x4 __attribute__((ext_vector_type(4)));
typedef unsigned u32x4 __attribute__((ext_vector_type(4)));
constexpr int BM = 256, BK = 64, HALF = 128, HTB = HALF * BK * 2  , STAGE_BYTES = 8 * HTB, NXCD = 8, WGM = 8;

__host__ __device__ __forceinline__ int lds_byte(int r, int c) { const int st = (r >> 4) * 2 + (c >> 5), rr = r & 15, cc = c & 31, ob = rr * 64 + cc * 2; return st * 1024 + (ob ^ (((ob >> 9) & 1) << 5)); }
__host__ __device__ __forceinline__ void stage_rc(int b, int& R, int& C) { const int st = b / 1024, sb = b % 1024, swz = sb ^ (((sb >> 9) & 1) << 5); R = (st >> 1) * 16 + swz / 64; C = (st & 1) * 32 + (swz % 64) / 2; }
__host__ __device__ __forceinline__ int perm32(int rho) { const int n = rho >> 4, i = rho & 15; return 8 * (i >> 2) + 4 * n + (i & 3); }

struct Unit { int pm, pn; };
struct Gemm { const bf16_t* A; int lda; const bf16_t* Bt; int M, N, K; };

struct StaticOrder {
    int nM, nN, nwg, G, c;
    __host__ __device__ void init(int M, int N, int G_, int c_) { nM = M / BM; nN = N / BM; nwg = nM * nN; G = G_; c = c_; }
    __host__ __device__ bool next(int i, Unit& u) const {
        const long L = (long)i * G + c; if (L >= nwg) return false;
        int wgid = (int)L; { const int q = nwg / NXCD, r = nwg % NXCD, xcd = wgid % NXCD, off = wgid / NXCD; wgid = (xcd < r ? xcd * (q + 1) : r * (q + 1) + (xcd - r) * q) + off; }
        const int nig = WGM * nN, gid = wgid / nig, fm = gid * WGM, gsz = (nM - fm) < WGM ? (nM - fm) : WGM;
        u.pm = fm + ((wgid % nig) % gsz); u.pn = (wgid % nig) / gsz; return true;
    }
    __device__ __forceinline__ void a_ready(const Unit&) const {}
    __device__ __forceinline__ void done(const Unit&) const {}
};

__device__ __forceinline__ unsigned cvt_pk_bf16(float lo, float hi) { unsigned r; asm volatile("v_cvt_pk_bf16_f32 %0, %1, %2" : "=v"(r) : "v"(lo), "v"(hi)); return r; }
__device__ __forceinline__ int opaque_tid() { int t = threadIdx.x; asm volatile("" : "+v"(t)); return t; }
__device__ __forceinline__ float bflo(unsigned u) { return __uint_as_float(u << 16); }
__device__ __forceinline__ float bfhi(unsigned u) { return __uint_as_float(u & 0xffff0000u); }
__device__ __forceinline__ float sigm(float x) { return __builtin_amdgcn_rcpf(1.0f + __expf(-x)); }

template <int ACT> struct EpiAct {
    static constexpr bool PERM = true, AFTER_DRAIN = false, HAS_MID = false;
    bf16_t* O0; int ld0; int npn0; bf16_t* O1; int ld1; const float* bias;
    __device__ __forceinline__ void operator()(const f32x4 (&acc)[2][2][4][2], const Unit& u, int wr, int wc, int fr, int fq) const {
        const int row0 = u.pm * BM + wr * 64 + fr;
        const bool second = (u.pn >= npn0);
        bf16_t* base = second ? O1 : O0; const int ld = second ? ld1 : ld0; const int colt = second ? (u.pn - npn0) * BM : u.pn * BM;
        const int col0 = colt + wc * 32 + 8 * fq;
#pragma unroll
        for (int bj = 0; bj < 2; ++bj) {
            f32x4 b0 = (f32x4){0.f, 0.f, 0.f, 0.f}, b1 = b0;
            if (ACT == 2) { b0 = *(const f32x4*)(bias + col0 + bj * HALF); b1 = *(const f32x4*)(bias + col0 + bj * HALF + 4); }
#pragma unroll
            for (int ai = 0; ai < 2; ++ai)
#pragma unroll
                for (int m = 0; m < 4; ++m) {
                    bf16_t* rowp = base + (size_t)(row0 + ai * HALF + m * 16) * ld + col0 + bj * HALF;
                    f32x4 v0 = acc[ai][bj][m][0], v1 = acc[ai][bj][m][1];
                    if (ACT != 0 && second) {
#pragma unroll
                        for (int e = 0; e < 4; ++e) {
                            if (ACT == 1) { v0[e] = v0[e] * sigm(v0[e]); v1[e] = v1[e] * sigm(v1[e]); }
                            if (ACT == 2) { v0[e] = sigm(v0[e] + b0[e]); v1[e] = sigm(v1[e] + b1[e]); }
                        }
                    }
                    u32x4 w; w.x = cvt_pk_bf16(v0[0], v0[1]); w.y = cvt_pk_bf16(v0[2], v0[3]); w.z = cvt_pk_bf16(v1[0], v1[1]); w.w = cvt_pk_bf16(v1[2], v1[3]);
                    *(u32x4*)rowp = w;
                }
        }
    }
};

struct EpiGate {
    static constexpr bool PERM = true, AFTER_DRAIN = false, HAS_MID = true;
    const bf16_t* GATE; bf16_t* O;
    __device__ __forceinline__ void mid(f32x4 (&acc)[2][2][4][2], const Unit& u, int nb, int wr, int wc, int fr_, int fq_) const {
        int fr = fr_, fq = fq_; asm volatile("" : "+v"(fr), "+v"(fq));
        const int row0 = u.pm * BM + wr * 64 + fr, col0 = u.pn * BM + wc * 32 + 8 * fq;
#pragma unroll
        for (int ai = 0; ai < 2; ++ai)
#pragma unroll
            for (int bj = 0; bj < 2; ++bj) {
                u32x4 ga[4], gb[4];
#pragma unroll
                for (int m = 0; m < 4; ++m) { const bf16_t* gp = GATE + (size_t)(row0 + ai * HALF + m * 16) * 4096 + (nb - 1) * 1024 + col0 + bj * HALF; ga[m] = *(const u32x4*)gp; gb[m] = *(const u32x4*)(gp + 1024); }
                __builtin_amdgcn_sched_barrier(0);
#pragma unroll
                for (int m = 0; m < 4; ++m) { const u32x4 a = ga[m], b = gb[m];
                    f32x4 r0, r1;
                    r0[0] = bflo(a.x) * __builtin_amdgcn_rcpf(bflo(b.x)); r0[1] = bfhi(a.x) * __builtin_amdgcn_rcpf(bfhi(b.x));
                    r0[2] = bflo(a.y) * __builtin_amdgcn_rcpf(bflo(b.y)); r0[3] = bfhi(a.y) * __builtin_amdgcn_rcpf(bfhi(b.y));
                    r1[0] = bflo(a.z) * __builtin_amdgcn_rcpf(bflo(b.z)); r1[1] = bfhi(a.z) * __builtin_amdgcn_rcpf(bfhi(b.z));
                    r1[2] = bflo(a.w) * __builtin_amdgcn_rcpf(bflo(b.w)); r1[3] = bfhi(a.w) * __builtin_amdgcn_rcpf(bfhi(b.w));
                    acc[ai][bj][m][0] = acc[ai][bj][m][0] * r0; acc[ai][bj][m][1] = acc[ai][bj][m][1] * r1; }
                __builtin_amdgcn_sched_barrier(0);
            }
    }
    __device__ __forceinline__ void operator()(const f32x4 (&acc)[2][2][4][2], const Unit& u, int wr, int wc, int fr, int fq) const {
        const int row0 = u.pm * BM + wr * 64 + fr, col0 = u.pn * BM + wc * 32 + 8 * fq;
#pragma unroll
        for (int ai = 0; ai < 2; ++ai)
#pragma unroll
            for (int bj = 0; bj < 2; ++bj) {
                u32x4 ga[4];
#pragma unroll
                for (int m = 0; m < 4; ++m) ga[m] = *(const u32x4*)(GATE + (size_t)(row0 + ai * HALF + m * 16) * 4096 + 3 * 1024 + col0 + bj * HALF);
                __builtin_amdgcn_sched_barrier(0);
#pragma unroll
                for (int m = 0; m < 4; ++m) { const u32x4 a = ga[m]; const f32x4 v0 = acc[ai][bj][m][0], v1 = acc[ai][bj][m][1];
                    u32x4 w; w.x = cvt_pk_bf16(v0[0] * bflo(a.x), v0[1] * bfhi(a.x)); w.y = cvt_pk_bf16(v0[2] * bflo(a.y), v0[3] * bfhi(a.y));
                    w.z = cvt_pk_bf16(v1[0] * bflo(a.z), v1[1] * bfhi(a.z)); w.w = cvt_pk_bf16(v1[2] * bflo(a.w), v1[3] * bfhi(a.w));
                    *(u32x4*)(O + (size_t)(row0 + ai * HALF + m * 16) * 1024 + col0 + bj * HALF) = w; }
                __builtin_amdgcn_sched_barrier(0);
            }
    }
};

struct EpiRes {
    static constexpr bool PERM = false, AFTER_DRAIN = false, HAS_MID = false;
    const float* base; float* out; int ldc; bool st;
    __device__ __forceinline__ void operator()(const f32x4 (&acc)[2][2][4][2], const Unit& u, int wr, int wc, int fr, int fq) const {
        const int row0 = u.pm * BM + wr * 64 + fr, col0 = u.pn * BM + wc * 32 + 4 * fq;
#pragma unroll
        for (int ai = 0; ai < 2; ++ai)
#pragma unroll
            for (int m = 0; m < 4; ++m)
#pragma unroll
                for (int bj = 0; bj < 2; ++bj)
#pragma unroll
                    for (int n = 0; n < 2; ++n) {
                        const size_t o = (size_t)(row0 + ai * HALF + m * 16) * ldc + col0 + bj * HALF + 16 * n;
                        const f32x4 x = *(const f32x4*)(base + o);
                        if (st) *(f32x4*)(out + o) = x + acc[ai][bj][m][n];
                    }
    }
};
template <class Epi, class Sched, bool ALIGN_EPI = false, bool SP2 = false>
__device__ __forceinline__ void gemm_phase(PG8_LAS unsigned char* lds, const Gemm g, const Sched& S, const Epi& E) {
    const int tid = pg8::opaque_tid(), wid = __builtin_amdgcn_readfirstlane(tid >> 6), lane = tid & 63, wr = wid >> 2, wc = wid & 3, fr = lane & 15, fq = lane >> 4;
    const int K = g.K, nt = K / BK;
    unsigned voffA[2], voffB[2];
#pragma unroll
    for (int i = 0; i < 2; ++i) { int R, C; stage_rc(tid * 16 + i * 8192, R, C); const int Rb = Epi::PERM ? ((R & ~31) + perm32(R & 31)) : R;
        voffA[i] = (unsigned)(R * g.lda + C) * 2u; voffB[i] = (unsigned)(Rb * K + C) * 2u; }
    const size_t kstep = (size_t)(BK * 2);
    const size_t hstepA = (size_t)HALF * g.lda * 2, hstepB = (size_t)HALF * K * 2;
    const size_t tstepA = 2 * hstepA, tstepB = 2 * hstepB;
    const unsigned ldsw = (unsigned)wid * 1024u;
    const int aoff = lds_byte(wr * 64 + fr, fq * 8), boff = lds_byte(wc * 32 + fr, fq * 8);
#define PG8_SA(b, h) (((b) * 2 + (h)) * HTB)
#define PG8_SB(b, h) ((4 + (b) * 2 + (h)) * HTB)
#define PG8_STAGE(bufoff, gbase, voff) do { _Pragma("unroll") for (int _i = 0; _i < 2; ++_i) \
        __builtin_amdgcn_global_load_lds((const unsigned*)((const char*)(gbase) + (voff)[_i]), (PG8_LAS unsigned*)(lds + (bufoff) + ldsw + _i * 8192), 16, 0, 0); } while (0)
#define PG8_LDA(dst, b, h) do { _Pragma("unroll") for (int m = 0; m < 4; ++m) _Pragma("unroll") for (int k = 0; k < 2; ++k) dst[m][k] = *(const PG8_LAS bf16x8*)(lds + PG8_SA(b, h) + aoff + m * 2048 + k * 1024); } while (0)
#define PG8_LDB(dst, b, h) do { _Pragma("unroll") for (int n = 0; n < 2; ++n) _Pragma("unroll") for (int k = 0; k < 2; ++k) dst[n][k] = *(const PG8_LAS bf16x8*)(lds + PG8_SB(b, h) + boff + n * 2048 + k * 1024); } while (0)
#define PG8_MMA(ai, bj, At, Bt) do { __builtin_amdgcn_s_setprio(1); _Pragma("unroll") for (int m = 0; m < 4; ++m) _Pragma("unroll") for (int n = 0; n < 2; ++n) _Pragma("unroll") for (int k = 0; k < 2; ++k) \
        acc[ai][bj][m][n] = __builtin_amdgcn_mfma_f32_16x16x32_bf16(Bt[n][k], At[m][k], acc[ai][bj][m][n], 0, 0, 0); __builtin_amdgcn_s_setprio(0); } while (0)
#define PG8_WAIT_V(n) asm volatile("s_waitcnt vmcnt(" #n ")" ::: "memory")
#define PG8_WAIT_L(n) asm volatile("s_waitcnt lgkmcnt(" #n ")" ::: "memory")
#define PG8_BAR __builtin_amdgcn_s_barrier()
#define PG8_SCHED __builtin_amdgcn_sched_barrier(0)
    Unit cur, nxt; int ui = 0;
    if (!S.next(0, cur)) return;
    f32x4 acc[2][2][4][2];
#pragma unroll
    for (int a = 0; a < 2; ++a)
#pragma unroll
        for (int b = 0; b < 2; ++b)
#pragma unroll
            for (int m = 0; m < 4; ++m)
#pragma unroll
                for (int n = 0; n < 2; ++n) acc[a][b][m][n] = (f32x4){0.f, 0.f, 0.f, 0.f};
    bf16x8 At[4][2], B0[2][2], B1[2][2];
    const char* cA = (const char*)g.A + (size_t)cur.pm * tstepA; const char* cB = (const char*)g.Bt + (size_t)cur.pn * tstepB;
    S.a_ready(cur);
    if constexpr (SP2) {
        PG8_STAGE(PG8_SB(0, 0), cB, voffB); PG8_STAGE(PG8_SB(0, 1), cB + hstepB, voffB); PG8_STAGE(PG8_SA(0, 0), cA, voffA); PG8_STAGE(PG8_SA(0, 1), cA + hstepA, voffA);
        if (wr == 1) PG8_BAR;
        PG8_WAIT_V(2); PG8_BAR;
        PG8_STAGE(PG8_SB(1, 0), cB + kstep, voffB); PG8_STAGE(PG8_SA(1, 0), cA + kstep, voffA); PG8_STAGE(PG8_SB(1, 1), cB + hstepB + kstep, voffB);
        PG8_WAIT_V(6); PG8_BAR;
    } else {
        PG8_STAGE(PG8_SB(0, 0), cB, voffB); PG8_STAGE(PG8_SA(0, 0), cA, voffA); PG8_STAGE(PG8_SB(0, 1), cB + hstepB, voffB); PG8_STAGE(PG8_SA(0, 1), cA + hstepA, voffA);
        if (wr == 1) PG8_BAR;
        PG8_WAIT_V(4); PG8_BAR;
        PG8_STAGE(PG8_SB(1, 0), cB + kstep, voffB); PG8_STAGE(PG8_SA(1, 0), cA + kstep, voffA); PG8_STAGE(PG8_SB(1, 1), cB + hstepB + kstep, voffB);
        PG8_WAIT_V(6); PG8_BAR;
    }
    for (;;) {
        const bool has_next = S.next(ui + 1, nxt);
        const char* nA = has_next ? (const char*)g.A + (size_t)nxt.pm * tstepA : cA; const char* nB = has_next ? (const char*)g.Bt + (size_t)nxt.pn * tstepB : cB;
        for (int t = 0; t < nt; t += 2) {
            if constexpr (Epi::HAS_MID) { if (t != 0 && (t & 7) == 0) E.mid(acc, cur, t >> 3, wr, wc, fr, fq); }
            const bool last = (t == nt - 2);
            const char* a1 = cA + (size_t)(t + 1) * kstep;
            const char* a2 = last ? nA : cA + (size_t)(t + 2) * kstep; const char* b2 = last ? nB : cB + (size_t)(t + 2) * kstep;
            const char* a3 = a2 + kstep; const char* b3 = b2 + kstep;
            if (last && has_next) S.a_ready(nxt);
            if constexpr (SP2) {
            PG8_LDB(B0, 0, 0); PG8_LDB(B1, 0, 1); PG8_SCHED; PG8_LDA(At, 0, 0); PG8_STAGE(PG8_SA(1, 1), a1 + hstepA, voffA);
            PG8_WAIT_V(8); PG8_WAIT_L(0); PG8_BAR; PG8_MMA(0, 0, At, B0); PG8_MMA(0, 1, At, B1); PG8_BAR; PG8_SCHED;
            PG8_LDA(At, 0, 1); PG8_STAGE(PG8_SB(0, 0), b2, voffB); PG8_STAGE(PG8_SB(0, 1), b2 + hstepB, voffB); PG8_STAGE(PG8_SA(0, 0), a2, voffA);
            PG8_WAIT_V(8); PG8_WAIT_L(0); PG8_BAR; PG8_MMA(1, 0, At, B0); PG8_MMA(1, 1, At, B1); PG8_BAR; PG8_SCHED;
            PG8_LDB(B0, 1, 0); PG8_LDB(B1, 1, 1); PG8_SCHED; PG8_LDA(At, 1, 0); PG8_STAGE(PG8_SA(0, 1), a2 + hstepA, voffA);
            PG8_WAIT_V(8); PG8_WAIT_L(0); PG8_BAR; PG8_MMA(0, 0, At, B0); PG8_MMA(0, 1, At, B1); PG8_BAR; PG8_SCHED;
            PG8_LDA(At, 1, 1); PG8_STAGE(PG8_SB(1, 0), b3, voffB); PG8_STAGE(PG8_SB(1, 1), b3 + hstepB, voffB); PG8_STAGE(PG8_SA(1, 0), a3, voffA);
            PG8_WAIT_V(8); PG8_WAIT_L(0); PG8_BAR; PG8_MMA(1, 0, At, B0); PG8_MMA(1, 1, At, B1); PG8_BAR; PG8_SCHED;
            } else {
            PG8_LDB(B0, 0, 0); PG8_SCHED; PG8_LDA(At, 0, 0); PG8_STAGE(PG8_SA(1, 1), a1 + hstepA, voffA);
            PG8_WAIT_L(8); PG8_BAR; PG8_WAIT_L(0); PG8_MMA(0, 0, At, B0); PG8_BAR; PG8_SCHED;
            PG8_LDB(B1, 0, 1); PG8_STAGE(PG8_SB(0, 0), b2, voffB);
            PG8_BAR; PG8_WAIT_L(0); PG8_MMA(0, 1, At, B1); PG8_BAR;
            PG8_LDA(At, 0, 1); PG8_STAGE(PG8_SA(0, 0), a2, voffA);
            PG8_BAR; PG8_WAIT_L(0); PG8_MMA(1, 0, At, B0); PG8_BAR; PG8_SCHED;
            PG8_STAGE(PG8_SB(0, 1), b2 + hstepB, voffB);
            PG8_WAIT_V(6); PG8_BAR; PG8_MMA(1, 1, At, B1); PG8_BAR;
            PG8_LDB(B0, 1, 0); PG8_SCHED; PG8_LDA(At, 1, 0); PG8_STAGE(PG8_SA(0, 1), a2 + hstepA, voffA);
            PG8_WAIT_L(8); PG8_BAR; PG8_WAIT_L(0); PG8_MMA(0, 0, At, B0); PG8_BAR; PG8_SCHED;
            PG8_LDB(B1, 1, 1); PG8_STAGE(PG8_SB(1, 0), b3, voffB);
            PG8_BAR; PG8_WAIT_L(0); PG8_MMA(0, 1, At, B1); PG8_BAR;
            PG8_LDA(At, 1, 1); PG8_STAGE(PG8_SA(1, 0), a3, voffA);
            PG8_BAR; PG8_WAIT_L(0); PG8_MMA(1, 0, At, B0); PG8_BAR; PG8_SCHED;
            PG8_STAGE(PG8_SB(1, 1), b3 + hstepB, voffB);
            PG8_WAIT_V(6); PG8_BAR; PG8_MMA(1, 1, At, B1); PG8_BAR;
            }
        }
        if constexpr (ALIGN_EPI) { if (wr == 0) PG8_BAR; }
        if constexpr (!Epi::AFTER_DRAIN) { E(acc, cur, wr, wc, fr, fq); S.done(cur); }
        if (!has_next) break;
#pragma unroll
        for (int a = 0; a < 2; ++a)
#pragma unroll
            for (int b = 0; b < 2; ++b)
#pragma unroll
                for (int m = 0; m < 4; ++m)
#pragma unroll
                    for (int n = 0; n < 2; ++n) acc[a][b][m][n] = (f32x4){0.f, 0.f, 0.f, 0.f};
        cur = nxt; cA = nA; cB = nB; ++ui;
        if constexpr (ALIGN_EPI) { if (wr == 1) PG8_BAR; }
    }
    PG8_WAIT_V(0);
    if constexpr (!ALIGN_EPI) { if (wr == 0) PG8_BAR; }
    PG8_BAR;
    if constexpr (Epi::AFTER_DRAIN) { E.fused(acc, cur, wr, wc, fr, fq, lds, wid, lane); S.done(cur); }
#undef PG8_SA
#undef PG8_SB
#undef PG8_STAGE
#undef PG8_LDA
#undef PG8_LDB
#undef PG8_MMA
#undef PG8_WAIT_V
#undef PG8_WAIT_L
#undef PG8_BAR
#undef PG8_SCHED
}
}
constexpr int NWAVES = 8, NTHR = 512;
constexpr int BATCH = 8, SEQ = 2048, DM = 1024, T = BATCH * SEQ, DEPTH = 2, MEML = 256, MEMT = BATCH * MEML;
constexpr int INW = 9632, INWP = 9728, NA = 5632  , MIXW = 3584, GW = 2048, GATEW = 4096;
constexpr float EPS = 1e-6f;
constexpr int MC_CQ = 0, MC_CKV = 256, MC_KR = 384, MC_BG = 512, MC_CG = 1024, MC_XIN = 1536, MC_U = 2048, MC_V = 2560, MC_MQ = 3072;
constexpr size_t MiB = 1u << 20;
constexpr size_t WS_W0 = 1 * MiB, WS_W1 = 275 * MiB;
constexpr size_t WO_WIN = 0, WO_WUQ = 19 * MiB, WO_WUKV = WO_WUQ + 768 * 256 * 2, WO_WBR = WO_WUKV + 1024 * 128 * 2, WO_WOUT = WO_WBR + 4 * MiB, WO_END = WO_WOUT + 2 * MiB;
static_assert(WO_END <= 26 * MiB, "weights");
constexpr size_t WS_SLAB = 35 * MiB, SLAB = 30 * MiB;
constexpr size_t SO_MIX = 0, SO_GATE = 0, SO_Q = 14 * MiB, SO_K = 17 * MiB, SO_VT = 20 * MiB, SO_H = 18 * MiB, SO_MERGED = 18 * MiB, SO_G = 22 * MiB;
constexpr size_t WS_WMEMT = 147 * MiB, WS_MEMN = 151 * MiB, WS_KVRAW = 27 * MiB;
constexpr size_t WS_END = 301 * MiB;
constexpr int LDS_BYTES = 147456;

#define LAS __attribute__((address_space(3)))
typedef unsigned short bf16;
typedef unsigned v4u __attribute__((ext_vector_type(4)));
typedef unsigned v2u __attribute__((ext_vector_type(2)));
typedef float f32x4 __attribute__((ext_vector_type(4)));
typedef short bf16x8 __attribute__((ext_vector_type(8)));
using pg8::cvt_pk_bf16; using pg8::bflo; using pg8::bfhi; using pg8::sigm;

__device__ __forceinline__ float wave_sum(float v) {
#pragma unroll
    for (int o = 1; o < 64; o <<= 1) v += __shfl_xor(v, o);
    return v;
}
__device__ __forceinline__ f32x4 mfma16(bf16x8 a, bf16x8 b, f32x4 c) { return __builtin_amdgcn_mfma_f32_16x16x32_bf16(a, b, c, 0, 0, 0); }
__device__ __forceinline__ bf16x8 as_bf8(v4u v) { return __builtin_bit_cast(bf16x8, v); }

struct Args { const float* in[24]; float* out; unsigned char* ws; int ph_lo, ph_hi; };
struct BV { bf16* MIX; bf16* G; bf16* Q; bf16* K; bf16* Vt; const bf16* kvraw0; const bf16* kvraw1; const int* pos; };

__device__ __forceinline__ void tr_item(const float* W, int K, int N, bf16* WT, int ldt, int coff, int win, LAS float* scr, int item, int lane) {
    const int nblk = N / 32, kb = item / nblk, nb = item % nblk, k0 = 64 * kb, n0 = 32 * nb;
    const int radd = (win && n0 >= 416) ? 96 : 0;
#pragma unroll 8
    for (int i = 0; i < 32; ++i) { const int kk = 2 * i + (lane >> 5); scr[kk * 33 + (lane & 31)] = W[(size_t)(k0 + kk) * N + n0 + (lane & 31)]; }
    asm volatile("s_waitcnt lgkmcnt(0)" ::: "memory");
    const int c = lane & 7;
#pragma unroll
    for (int j = 0; j < 4; ++j) { const int n = (lane >> 3) + 8 * j; const LAS float* s = scr + (8 * c) * 33 + n;
        v4u o; o.x = cvt_pk_bf16(s[0 * 33], s[1 * 33]); o.y = cvt_pk_bf16(s[2 * 33], s[3 * 33]); o.z = cvt_pk_bf16(s[4 * 33], s[5 * 33]); o.w = cvt_pk_bf16(s[6 * 33], s[7 * 33]);
        *(v4u*)(WT + (size_t)(radd + n0 + n) * ldt + coff + k0 + 8 * c) = o; }
    asm volatile("s_waitcnt lgkmcnt(0)" ::: "memory");
}
__device__ __forceinline__ void rms_row(const float* xrow, const float* g, bf16* orow, int lane) {
    const f32x4* xr = (const f32x4*)xrow + lane; const f32x4* gr = (const f32x4*)g + lane;
    f32x4 v[4]; float s = 0.f;
#pragma unroll
    for (int j = 0; j < 4; ++j) { v[j] = xr[64 * j]; s += (v[j].x * v[j].x + v[j].y * v[j].y) + (v[j].z * v[j].z + v[j].w * v[j].w); }
    const float rstd = 1.0f / sqrtf(wave_sum(s) * (1.f / 1024.f) + EPS);
    v2u* o8 = (v2u*)orow + lane;
#pragma unroll
    for (int j = 0; j < 4; ++j) { const f32x4 gg = gr[64 * j]; v2u o; o.x = cvt_pk_bf16(v[j].x * rstd * gg.x, v[j].y * rstd * gg.y); o.y = cvt_pk_bf16(v[j].z * rstd * gg.z, v[j].w * rstd * gg.w); o8[64 * j] = o; }
}
__device__ __forceinline__ void norm_rows(const float* x, const float* g, bf16* H, int rows, int bid, int nb) {
    const int tid = pg8::opaque_tid(), lane = tid & 63, gw = bid * NWAVES + (tid >> 6), ngw = nb * NWAVES;
    const f32x4* gr = (const f32x4*)g + lane;
    for (int m = gw; m < rows; m += 2 * ngw) {
        const int m2 = m + ngw; const bool has2 = m2 < rows;
        const f32x4* xa = (const f32x4*)(x + (size_t)m * DM) + lane; const f32x4* xb = (const f32x4*)(x + (size_t)(has2 ? m2 : m) * DM) + lane;
        f32x4 va[4], vb[4]; float sa = 0.f, sb = 0.f;
#pragma unroll
        for (int j = 0; j < 4; ++j) { va[j] = xa[64 * j]; vb[j] = xb[64 * j]; }
#pragma unroll
        for (int j = 0; j < 4; ++j) { sa += (va[j].x * va[j].x + va[j].y * va[j].y) + (va[j].z * va[j].z + va[j].w * va[j].w); sb += (vb[j].x * vb[j].x + vb[j].y * vb[j].y) + (vb[j].z * vb[j].z + vb[j].w * vb[j].w); }
        const float ra = 1.0f / sqrtf(wave_sum(sa) * (1.f / 1024.f) + EPS), rb = 1.0f / sqrtf(wave_sum(sb) * (1.f / 1024.f) + EPS);
        v2u* oa = (v2u*)(H + (size_t)m * DM) + lane; v2u* ob = (v2u*)(H + (size_t)m2 * DM) + lane;
#pragma unroll
        for (int j = 0; j < 4; ++j) { const f32x4 gg = gr[64 * j]; v2u o;
            o.x = cvt_pk_bf16(va[j].x * ra * gg.x, va[j].y * ra * gg.y); o.y = cvt_pk_bf16(va[j].z * ra * gg.z, va[j].w * ra * gg.w); oa[64 * j] = o;
            if (has2) { o.x = cvt_pk_bf16(vb[j].x * rb * gg.x, vb[j].y * rb * gg.y); o.y = cvt_pk_bf16(vb[j].z * rb * gg.z, vb[j].w * rb * gg.w); ob[64 * j] = o; } }
    }
}

__device__ __forceinline__ void ph_prologue(const Args& a, LAS unsigned char* lds, int bid, int nb) {
    const int tid = pg8::opaque_tid(), lane = tid & 63, wave = tid >> 6;
    LAS float* scr = (LAS float*)(lds + wave * 16384);
    const int gw = bid * NWAVES + wave, ngw = nb * NWAVES;
    constexpr int I_IN = 16 * 301, I_UQ = 4 * 24, I_UKV = 2 * 32, I_MEM = 16 * 32, I_BR = 8 * 32, I_OUT = 16 * 32;
    constexpr int PER_L = I_IN + I_UQ + I_UKV + I_MEM + 4 * I_BR + I_OUT;
    for (int it0 = gw; it0 < 2 * PER_L; it0 += ngw) {
        const int l = it0 / PER_L; int r = it0 % PER_L;
        unsigned char* wb = a.ws + (l ? WS_W1 : WS_W0);
        if (r < I_IN) { tr_item(a.in[4] + (size_t)l * DM * INW, DM, INW, (bf16*)(wb + WO_WIN), DM, 0, 1, scr, r, lane); continue; } r -= I_IN;
        if (r < I_UQ) { tr_item(a.in[7] + (size_t)l * 256 * 768, 256, 768, (bf16*)(wb + WO_WUQ), 256, 0, 0, scr, r, lane); continue; } r -= I_UQ;
        if (r < I_UKV) { tr_item(a.in[8] + (size_t)l * 128 * 1024, 128, 1024, (bf16*)(wb + WO_WUKV), 128, 0, 0, scr, r, lane); continue; } r -= I_UKV;
        if (r < I_MEM) { tr_item(a.in[18] + (size_t)l * DM * 1024, DM, 1024, (bf16*)(a.ws + WS_WMEMT + l * 2 * MiB), DM, 0, 0, scr, r, lane); continue; } r -= I_MEM;
        if (r < 4 * I_BR) { const int n = r / I_BR; tr_item(a.in[22] + ((size_t)l * 4 + n) * 512 * DM, 512, DM, (bf16*)(wb + WO_WBR), 2048, n * 512, 0, scr, r % I_BR, lane); continue; } r -= 4 * I_BR;
        tr_item(a.in[23] + (size_t)l * DM * DM, DM, DM, (bf16*)(wb + WO_WOUT), DM, 0, 0, scr, r, lane);
    }
    for (int i = bid * NTHR + tid; i < 2 * 96 * 128; i += nb * NTHR) { const int l = i / (96 * 128), r = i % (96 * 128);
        *(v4u*)(a.ws + (l ? WS_W1 : WS_W0) + WO_WIN + (size_t)(416 * 1024) * 2 + (size_t)r * 16) = (v4u){0u, 0u, 0u, 0u}; }
    for (int l = 0; l < 2; ++l) norm_rows(a.in[1], a.in[17] + l * DM, (bf16*)(a.ws + WS_MEMN + l * 4 * MiB), MEMT, bid, nb);
    for (int g = 0; g < BATCH; ++g) norm_rows(a.in[0] + (size_t)g * SEQ * DM, a.in[3], (bf16*)(a.out + (size_t)g * SEQ * DM), SEQ, bid, nb);
}

__device__ __forceinline__ void ph_p2(const Args& a, const BV& v, int l, LAS unsigned char* lds, int bid, int nb) {
    const int tid = pg8::opaque_tid(), lane = tid & 63, w = tid >> 6;
    const bf16* MIX = v.MIX;
    const unsigned char* wb = a.ws + (l ? WS_W1 : WS_W0);
    const bf16* WuqT = (const bf16*)(wb + WO_WUQ); const bf16* WukvT = (const bf16*)(wb + WO_WUKV);
    const float* cqg = a.in[5] + l * 256; const float* ckvg = a.in[6] + l * 128; const float* qg = a.in[9] + l * 96; const float* kg = a.in[10] + l * 96;
    const int* pos = v.pos;
    bf16* Qb = v.Q; bf16* Kb = v.K; bf16* Vtb = v.Vt;
    constexpr int AQ_LD = 264, AKV_LD = 136;
    LAS bf16* Aq = (LAS bf16*)lds; LAS bf16* Akv = (LAS bf16*)(lds + 33792);
    LAS float* kr = (LAS float*)(lds + 51200); LAS float* cs = (LAS float*)(lds + 59392); LAS float* sn = (LAS float*)(lds + 63488);
    const float* cqg0 = cqg; const float* ckvg0 = ckvg; const float* qg0 = qg; const float* kg0 = kg;
    for (int u = bid; u < SEQ / 64; u += nb) {
        const int t0 = u * 64;
        int c16 = lane & 15, q4 = lane >> 4; asm volatile("" : "+v"(c16), "+v"(q4));
        int zo = 0; asm volatile("" : "+s"(zo));
        const float* cqg = cqg0 + zo; const float* ckvg = ckvg0 + zo; const float* qg = qg0 + zo; const float* kg = kg0 + zo;
        __syncthreads();
        {
            const int row = tid >> 3, part = tid & 7;
            const bf16* src = MIX + (size_t)(t0 + row) * MIXW;
            v4u x[4]; float ss = 0.f;
#pragma unroll
            for (int i = 0; i < 4; ++i) { x[i] = *(const v4u*)(src + MC_CQ + part * 32 + i * 8);
                ss += bflo(x[i].x) * bflo(x[i].x) + bfhi(x[i].x) * bfhi(x[i].x) + bflo(x[i].y) * bflo(x[i].y) + bfhi(x[i].y) * bfhi(x[i].y)
                    + bflo(x[i].z) * bflo(x[i].z) + bfhi(x[i].z) * bfhi(x[i].z) + bflo(x[i].w) * bflo(x[i].w) + bfhi(x[i].w) * bfhi(x[i].w); }
            ss += __shfl_xor(ss, 1); ss += __shfl_xor(ss, 2); ss += __shfl_xor(ss, 4);
            float rstd = 1.0f / sqrtf(ss * (1.f / 256.f) + EPS);
#pragma unroll
            for (int i = 0; i < 4; ++i) { const float* gp = cqg + part * 32 + i * 8; v4u o;
                o.x = cvt_pk_bf16(bflo(x[i].x) * rstd * gp[0], bfhi(x[i].x) * rstd * gp[1]); o.y = cvt_pk_bf16(bflo(x[i].y) * rstd * gp[2], bfhi(x[i].y) * rstd * gp[3]);
                o.z = cvt_pk_bf16(bflo(x[i].z) * rstd * gp[4], bfhi(x[i].z) * rstd * gp[5]); o.w = cvt_pk_bf16(bflo(x[i].w) * rstd * gp[6], bfhi(x[i].w) * rstd * gp[7]);
                *(LAS v4u*)(Aq + row * AQ_LD + part * 32 + i * 8) = o; }
            v4u y[2]; ss = 0.f;
#pragma unroll
            for (int i = 0; i < 2; ++i) { y[i] = *(const v4u*)(src + MC_CKV + part * 16 + i * 8);
                ss += bflo(y[i].x) * bflo(y[i].x) + bfhi(y[i].x) * bfhi(y[i].x) + bflo(y[i].y) * bflo(y[i].y) + bfhi(y[i].y) * bfhi(y[i].y)
                    + bflo(y[i].z) * bflo(y[i].z) + bfhi(y[i].z) * bfhi(y[i].z) + bflo(y[i].w) * bflo(y[i].w) + bfhi(y[i].w) * bfhi(y[i].w); }
            ss += __shfl_xor(ss, 1); ss += __shfl_xor(ss, 2); ss += __shfl_xor(ss, 4);
            rstd = 1.0f / sqrtf(ss * (1.f / 128.f) + EPS);
#pragma unroll
            for (int i = 0; i < 2; ++i) { const float* gp = ckvg + part * 16 + i * 8; v4u o;
                o.x = cvt_pk_bf16(bflo(y[i].x) * rstd * gp[0], bfhi(y[i].x) * rstd * gp[1]); o.y = cvt_pk_bf16(bflo(y[i].y) * rstd * gp[2], bfhi(y[i].y) * rstd * gp[3]);
                o.z = cvt_pk_bf16(bflo(y[i].z) * rstd * gp[4], bfhi(y[i].z) * rstd * gp[5]); o.w = cvt_pk_bf16(bflo(y[i].w) * rstd * gp[6], bfhi(y[i].w) * rstd * gp[7]);
                *(LAS v4u*)(Akv + row * AKV_LD + part * 16 + i * 8) = o; }
            const v2u z = *(const v2u*)(src + MC_KR + part * 4);
            kr[row * 32 + part * 4 + 0] = bflo(z.x); kr[row * 32 + part * 4 + 1] = bfhi(z.x); kr[row * 32 + part * 4 + 2] = bflo(z.y); kr[row * 32 + part * 4 + 3] = bfhi(z.y);
#pragma unroll
            for (int i = 0; i < 2; ++i) { const int e = tid * 2 + i, r = e >> 4, f = e & 15;
                const float invf = exp2f(-(float)f * (13.287712379549449f / 16.0f));
                const float ang = (float)pos[t0 + r] * invf; float sv, cv; sincosf(ang, &sv, &cv); cs[e] = cv; sn[e] = sv; }
        }
        __syncthreads();
        const int h = w;
        {
            f32x4 acc[4][6];
#pragma unroll
            for (int mt = 0; mt < 4; ++mt)
#pragma unroll
                for (int nt = 0; nt < 6; ++nt) acc[mt][nt] = (f32x4){0.f, 0.f, 0.f, 0.f};
            const bf16* wq0 = WuqT + (size_t)(h * 96 + c16) * 256 + 8 * q4;
            v4u wf[6], wn[6];
#pragma unroll
            for (int nt = 0; nt < 6; ++nt) wf[nt] = *(const v4u*)(wq0 + nt * 16 * 256);
#pragma unroll 1
            for (int ks = 0; ks < 8; ++ks) {
                if (ks + 1 < 8) {
#pragma unroll
                    for (int nt = 0; nt < 6; ++nt) wn[nt] = *(const v4u*)(wq0 + nt * 16 * 256 + (ks + 1) * 32); }
                bf16x8 tf[4];
#pragma unroll
                for (int mt = 0; mt < 4; ++mt) tf[mt] = as_bf8(*(const LAS v4u*)(Aq + (mt * 16 + c16) * AQ_LD + ks * 32 + 8 * q4));
#pragma unroll
                for (int nt = 0; nt < 6; ++nt)
#pragma unroll
                    for (int mt = 0; mt < 4; ++mt) acc[mt][nt] = mfma16(as_bf8(wf[nt]), tf[mt], acc[mt][nt]);
#pragma unroll
                for (int nt = 0; nt < 6; ++nt) wf[nt] = wn[nt];
            }
#pragma unroll
            for (int mt = 0; mt < 4; ++mt) {
                float ss = 0.f;
#pragma unroll
                for (int nt = 0; nt < 6; ++nt) ss += acc[mt][nt][0] * acc[mt][nt][0] + acc[mt][nt][1] * acc[mt][nt][1] + acc[mt][nt][2] * acc[mt][nt][2] + acc[mt][nt][3] * acc[mt][nt][3];
                ss += __shfl_xor(ss, 16); ss += __shfl_xor(ss, 32);
                const float rstd = 1.0f / sqrtf(ss * (1.f / 96.f) + EPS);
                const int r = mt * 16 + c16, t = t0 + r, b = t >> 11, s = t & 2047;
                bf16* qrow = Qb + ((size_t)(b * 8 + h) * SEQ + s) * 96;
#pragma unroll
                for (int nt = 0; nt < 4; ++nt) { const float* gp = qg + nt * 16 + 4 * q4; v2u o;
                    o.x = cvt_pk_bf16(acc[mt][nt][0] * rstd * gp[0], acc[mt][nt][1] * rstd * gp[1]); o.y = cvt_pk_bf16(acc[mt][nt][2] * rstd * gp[2], acc[mt][nt][3] * rstd * gp[3]);
                    *(v2u*)(qrow + nt * 16 + 4 * q4) = o; }
                float o1[4], o2[4];
#pragma unroll
                for (int j = 0; j < 4; ++j) { const int f = 4 * q4 + j; const float x1 = acc[mt][4][j] * rstd * qg[64 + f], x2 = acc[mt][5][j] * rstd * qg[80 + f];
                    const float cv = cs[r * 16 + f], sv = sn[r * 16 + f]; o1[j] = x1 * cv - x2 * sv; o2[j] = x1 * sv + x2 * cv; }
                v2u p1, p2; p1.x = cvt_pk_bf16(o1[0], o1[1]); p1.y = cvt_pk_bf16(o1[2], o1[3]); p2.x = cvt_pk_bf16(o2[0], o2[1]); p2.y = cvt_pk_bf16(o2[2], o2[3]);
                *(v2u*)(qrow + 64 + 4 * q4) = p1; *(v2u*)(qrow + 80 + 4 * q4) = p2;
            }
        }
        __builtin_amdgcn_sched_barrier(0);
        {
            f32x4 acc[4][4];
#pragma unroll
            for (int mt = 0; mt < 4; ++mt)
#pragma unroll
                for (int nt = 0; nt < 4; ++nt) acc[mt][nt] = (f32x4){0.f, 0.f, 0.f, 0.f};
            const bf16* wk0 = WukvT + (size_t)(h * 128 + c16) * 128 + 8 * q4;
            v4u wf[4], wn[4];
#pragma unroll
            for (int nt = 0; nt < 4; ++nt) wf[nt] = *(const v4u*)(wk0 + nt * 16 * 128);
#pragma unroll 1
            for (int ks = 0; ks < 4; ++ks) {
                if (ks + 1 < 4) {
#pragma unroll
                    for (int nt = 0; nt < 4; ++nt) wn[nt] = *(const v4u*)(wk0 + nt * 16 * 128 + (ks + 1) * 32); }
                bf16x8 tf[4];
#pragma unroll
                for (int mt = 0; mt < 4; ++mt) tf[mt] = as_bf8(*(const LAS v4u*)(Akv + (mt * 16 + c16) * AKV_LD + ks * 32 + 8 * q4));
#pragma unroll
                for (int nt = 0; nt < 4; ++nt)
#pragma unroll
                    for (int mt = 0; mt < 4; ++mt) acc[mt][nt] = mfma16(as_bf8(wf[nt]), tf[mt], acc[mt][nt]);
#pragma unroll
                for (int nt = 0; nt < 4; ++nt) wf[nt] = wn[nt];
            }
#pragma unroll
            for (int mt = 0; mt < 4; ++mt) {
                const int r = mt * 16 + c16, t = t0 + r, b = t >> 11, s = t & 2047;
                float kr1[4], kr2[4]; float ss = 0.f;
#pragma unroll
                for (int j = 0; j < 4; ++j) { kr1[j] = kr[r * 32 + 4 * q4 + j]; kr2[j] = kr[r * 32 + 16 + 4 * q4 + j]; ss += kr1[j] * kr1[j] + kr2[j] * kr2[j]; }
#pragma unroll
                for (int nt = 0; nt < 4; ++nt) ss += acc[mt][nt][0] * acc[mt][nt][0] + acc[mt][nt][1] * acc[mt][nt][1] + acc[mt][nt][2] * acc[mt][nt][2] + acc[mt][nt][3] * acc[mt][nt][3];
                ss += __shfl_xor(ss, 16); ss += __shfl_xor(ss, 32);
                const float rstd = 1.0f / sqrtf(ss * (1.f / 96.f) + EPS);
                bf16* krow = Kb + ((size_t)(b * 8 + h) * SEQ + s) * 96;
#pragma unroll
                for (int nt = 0; nt < 4; ++nt) { const float* gp = kg + nt * 16 + 4 * q4; v2u o;
                    o.x = cvt_pk_bf16(acc[mt][nt][0] * rstd * gp[0], acc[mt][nt][1] * rstd * gp[1]); o.y = cvt_pk_bf16(acc[mt][nt][2] * rstd * gp[2], acc[mt][nt][3] * rstd * gp[3]);
                    *(v2u*)(krow + nt * 16 + 4 * q4) = o; }
                float o1[4], o2[4];
#pragma unroll
                for (int j = 0; j < 4; ++j) { const int f = 4 * q4 + j; const float x1 = kr1[j] * rstd * kg[64 + f], x2 = kr2[j] * rstd * kg[80 + f];
                    const float cv = cs[r * 16 + f], sv = sn[r * 16 + f]; o1[j] = x1 * cv - x2 * sv; o2[j] = x1 * sv + x2 * cv; }
                v2u p1, p2; p1.x = cvt_pk_bf16(o1[0], o1[1]); p1.y = cvt_pk_bf16(o1[2], o1[3]); p2.x = cvt_pk_bf16(o2[0], o2[1]); p2.y = cvt_pk_bf16(o2[2], o2[3]);
                *(v2u*)(krow + 64 + 4 * q4) = p1; *(v2u*)(krow + 80 + 4 * q4) = p2;
            }
        }
        __builtin_amdgcn_sched_barrier(0);
        {
            f32x4 acc[4][4];
#pragma unroll
            for (int mt = 0; mt < 4; ++mt)
#pragma unroll
                for (int nt = 0; nt < 4; ++nt) acc[mt][nt] = (f32x4){0.f, 0.f, 0.f, 0.f};
            const bf16* wk0 = WukvT + (size_t)(h * 128 + 64 + c16) * 128 + 8 * q4;
            v4u wf[4], wn[4];
#pragma unroll
            for (int nt = 0; nt < 4; ++nt) wf[nt] = *(const v4u*)(wk0 + nt * 16 * 128);
#pragma unroll 1
            for (int ks = 0; ks < 4; ++ks) {
                if (ks + 1 < 4) {
#pragma unroll
                    for (int nt = 0; nt < 4; ++nt) wn[nt] = *(const v4u*)(wk0 + nt * 16 * 128 + (ks + 1) * 32); }
                bf16x8 tf[4];
#pragma unroll
                for (int mt = 0; mt < 4; ++mt) tf[mt] = as_bf8(*(const LAS v4u*)(Akv + (mt * 16 + c16) * AKV_LD + ks * 32 + 8 * q4));
#pragma unroll
                for (int nt = 0; nt < 4; ++nt)
#pragma unroll
                    for (int mt = 0; mt < 4; ++mt) acc[mt][nt] = mfma16(as_bf8(wf[nt]), tf[mt], acc[mt][nt]);
#pragma unroll
                for (int nt = 0; nt < 4; ++nt) wf[nt] = wn[nt];
            }
#pragma unroll
            for (int mt = 0; mt < 4; ++mt) {
                const int r = mt * 16 + c16, t = t0 + r, b = t >> 11, s = t & 2047;
                bf16* vcol = Vtb + (size_t)(b * 8 + h) * 64 * SEQ + s;
#pragma unroll
                for (int nt = 0; nt < 4; ++nt)
#pragma unroll
                    for (int j = 0; j < 4; ++j) { const int d = nt * 16 + 4 * q4 + j; vcol[(size_t)d * SEQ] = (bf16)(cvt_pk_bf16(acc[mt][nt][j], 0.f) & 0xffffu); }
            }
        }
    }
}
template <int DQK, int DV, bool CAUSAL, bool QNORM>
__device__ __forceinline__ void attn_block(LAS unsigned char* lds, const bf16* Qp, int qpitch, const float* qg, const bf16* Kp, const bf16* Vtp, int vpitch,
                                           int nkt, int row0seq, float scale_log2, bf16* Gp, int gpitch, bool st, const float* kg) {
    constexpr int KS = DQK / 32, DT = DV / 16, KROW = DQK + 8, VROW = 72, KBUF = 64 * KROW * 2, VBUF = DV * VROW * 2;
    constexpr int NKC = 8 * DQK, NVC = 8 * DV, KPT = (NKC + NTHR - 1) / NTHR, VPT = (NVC + NTHR - 1) / NTHR;
    static_assert(2 * KBUF + 2 * VBUF <= 131072, "attention LDS");
    const int tid = pg8::opaque_tid(), lane = tid & 63, w = tid >> 6, c16 = lane & 15, q4 = lane >> 4;
    __syncthreads();
    bf16x8 qf[2][KS];
    {
        v4u raw[2][KS];
#pragma unroll
        for (int qt = 0; qt < 2; ++qt)
#pragma unroll
            for (int ks = 0; ks < KS; ++ks) raw[qt][ks] = *(const v4u*)(Qp + (size_t)(32 * w + 16 * qt + c16) * qpitch + ks * 32 + 8 * q4);
        if (QNORM) {
#pragma unroll
            for (int qt = 0; qt < 2; ++qt) {
                float ss = 0.f;
#pragma unroll
                for (int ks = 0; ks < KS; ++ks) { const v4u x = raw[qt][ks];
                    ss += bflo(x.x) * bflo(x.x) + bfhi(x.x) * bfhi(x.x) + bflo(x.y) * bflo(x.y) + bfhi(x.y) * bfhi(x.y) + bflo(x.z) * bflo(x.z) + bfhi(x.z) * bfhi(x.z) + bflo(x.w) * bflo(x.w) + bfhi(x.w) * bfhi(x.w); }
                ss += __shfl_xor(ss, 16); ss += __shfl_xor(ss, 32);
                const float rstd = 1.0f / sqrtf(ss * (1.f / DQK) + EPS);
#pragma unroll
                for (int ks = 0; ks < KS; ++ks) { const v4u x = raw[qt][ks]; const float* gp = qg + ks * 32 + 8 * q4; v4u o;
                    o.x = cvt_pk_bf16(bflo(x.x) * rstd * gp[0], bfhi(x.x) * rstd * gp[1]); o.y = cvt_pk_bf16(bflo(x.y) * rstd * gp[2], bfhi(x.y) * rstd * gp[3]);
                    o.z = cvt_pk_bf16(bflo(x.z) * rstd * gp[4], bfhi(x.z) * rstd * gp[5]); o.w = cvt_pk_bf16(bflo(x.w) * rstd * gp[6], bfhi(x.w) * rstd * gp[7]);
                    raw[qt][ks] = o; }
            }
        }
#pragma unroll
        for (int qt = 0; qt < 2; ++qt)
#pragma unroll
            for (int ks = 0; ks < KS; ++ks) qf[qt][ks] = as_bf8(raw[qt][ks]);
    }
    v4u kreg[KPT], vreg[VPT];
#define ATT_GLOAD(kt) do { if constexpr (!QNORM) { \
    _Pragma("unroll") for (int i = 0; i < KPT; ++i) { const int ch = tid + i * NTHR; if (ch < NKC) kreg[i] = *(const v4u*)(Kp + (size_t)(kt) * 64 * DQK + (size_t)ch * 8); } \
    _Pragma("unroll") for (int i = 0; i < VPT; ++i) { const int ch = tid + i * NTHR; if (ch < NVC) vreg[i] = *(const v4u*)(Vtp + (size_t)(ch >> 3) * vpitch + (kt) * 64 + (ch & 7) * 8); } \
  } else { \
    _Pragma("unroll") for (int i = 0; i < KPT; ++i) { const int ch = tid + i * NTHR; kreg[i] = *(const v4u*)(Kp + (size_t)((kt) * 64 + (ch >> 4)) * 1024 + (ch & 15) * 8); } \
    _Pragma("unroll") for (int i = 0; i < VPT; ++i) { const int ch = tid + i * NTHR; vreg[i] = *(const v4u*)(Vtp + (size_t)((kt) * 64 + (ch & 63)) * 1024 + (ch >> 6) * 8); } \
  } } while (0)
#define ATT_LSTORE(buf) do { if constexpr (!QNORM) { \
    _Pragma("unroll") for (int i = 0; i < KPT; ++i) { const int ch = tid + i * NTHR; if (ch < NKC) *(LAS v4u*)(lds + (buf) * KBUF + (ch / (DQK / 8)) * (KROW * 2) + (ch % (DQK / 8)) * 16) = kreg[i]; } \
    _Pragma("unroll") for (int i = 0; i < VPT; ++i) { const int ch = tid + i * NTHR; if (ch < NVC) *(LAS v4u*)(lds + 2 * KBUF + (buf) * VBUF + (ch >> 3) * (VROW * 2) + (ch & 7) * 16) = vreg[i]; } \
  } else { \
    _Pragma("unroll") for (int i = 0; i < KPT; ++i) { const int ch = tid + i * NTHR; const v4u x = kreg[i]; \
        float ss = bflo(x.x) * bflo(x.x) + bfhi(x.x) * bfhi(x.x) + bflo(x.y) * bflo(x.y) + bfhi(x.y) * bfhi(x.y) + bflo(x.z) * bflo(x.z) + bfhi(x.z) * bfhi(x.z) + bflo(x.w) * bflo(x.w) + bfhi(x.w) * bfhi(x.w); \
        ss += __shfl_xor(ss, 1); ss += __shfl_xor(ss, 2); ss += __shfl_xor(ss, 4); ss += __shfl_xor(ss, 8); \
        const float rs = 1.0f / sqrtf(ss * (1.f / 128.f) + EPS); const float* gp = kg + (ch & 15) * 8; v4u o; \
        o.x = cvt_pk_bf16(bflo(x.x) * rs * gp[0], bfhi(x.x) * rs * gp[1]); o.y = cvt_pk_bf16(bflo(x.y) * rs * gp[2], bfhi(x.y) * rs * gp[3]); \
        o.z = cvt_pk_bf16(bflo(x.z) * rs * gp[4], bfhi(x.z) * rs * gp[5]); o.w = cvt_pk_bf16(bflo(x.w) * rs * gp[6], bfhi(x.w) * rs * gp[7]); \
        *(LAS v4u*)(lds + (buf) * KBUF + (ch >> 4) * (KROW * 2) + (ch & 15) * 16) = o; } \
    _Pragma("unroll") for (int i = 0; i < VPT; ++i) { const int ch = tid + i * NTHR; const v4u x = vreg[i]; \
        LAS bf16* vd = (LAS bf16*)(lds + 2 * KBUF + (buf) * VBUF) + ((ch >> 6) * 8) * VROW + (ch & 63); \
        vd[0 * VROW] = (bf16)(x.x & 0xffffu); vd[1 * VROW] = (bf16)(x.x >> 16); vd[2 * VROW] = (bf16)(x.y & 0xffffu); vd[3 * VROW] = (bf16)(x.y >> 16); \
        vd[4 * VROW] = (bf16)(x.z & 0xffffu); vd[5 * VROW] = (bf16)(x.z >> 16); vd[6 * VROW] = (bf16)(x.w & 0xffffu); vd[7 * VROW] = (bf16)(x.w >> 16); } \
  } } while (0)
    ATT_GLOAD(0); ATT_LSTORE(0);
    __syncthreads();
    float m_run[2] = {-1e30f, -1e30f}, l_run[2] = {0.f, 0.f};
    f32x4 o[DT][2];
#pragma unroll
    for (int dt = 0; dt < DT; ++dt) { o[dt][0] = (f32x4){0.f, 0.f, 0.f, 0.f}; o[dt][1] = (f32x4){0.f, 0.f, 0.f, 0.f}; }
    const int rw0 = row0seq + 32 * w;
    for (int kt = 0; kt < nkt; ++kt) {
        if (kt + 1 < nkt) ATT_GLOAD(kt + 1);
        const int k0 = kt * 64;
        const bool active = !CAUSAL || (k0 <= rw0 + 31);
        if (active) {
            const LAS unsigned char* kb = lds + (kt & 1) * KBUF; const LAS unsigned char* vb = lds + 2 * KBUF + (kt & 1) * VBUF;
            f32x4 s[4][2];
#pragma unroll
            for (int kk = 0; kk < 4; ++kk) { s[kk][0] = (f32x4){0.f, 0.f, 0.f, 0.f}; s[kk][1] = (f32x4){0.f, 0.f, 0.f, 0.f}; }
#pragma unroll
            for (int kk = 0; kk < 4; ++kk)
#pragma unroll
                for (int ks = 0; ks < KS; ++ks) { const bf16x8 kf = as_bf8(*(const LAS v4u*)(kb + (kk * 16 + c16) * (KROW * 2) + (ks * 32 + 8 * q4) * 2));
                    s[kk][0] = mfma16(kf, qf[0][ks], s[kk][0]); s[kk][1] = mfma16(kf, qf[1][ks], s[kk][1]); }
            const bool needmask = CAUSAL && (k0 + 63 > rw0);
            bf16x8 pf[2][2];
#pragma unroll
            for (int qt = 0; qt < 2; ++qt) {
                const int rowi = rw0 + 16 * qt + c16;
                float tmax = -INFINITY;
#pragma unroll
                for (int kk = 0; kk < 4; ++kk)
#pragma unroll
                    for (int j = 0; j < 4; ++j) { float v = s[kk][qt][j];
                        if (needmask) { const int key = k0 + kk * 16 + 4 * q4 + j; v = (key > rowi) ? -INFINITY : v; }
                        s[kk][qt][j] = v; tmax = fmaxf(tmax, v); }
                tmax = fmaxf(tmax, __shfl_xor(tmax, 16)); tmax = fmaxf(tmax, __shfl_xor(tmax, 32));
                const float mnew = fmaxf(m_run[qt], tmax * scale_log2), alpha = __builtin_amdgcn_exp2f(m_run[qt] - mnew);
                m_run[qt] = mnew;
                float psum = 0.f;
#pragma unroll
                for (int kk = 0; kk < 4; ++kk)
#pragma unroll
                    for (int j = 0; j < 4; ++j) { const float p = __builtin_amdgcn_exp2f(__builtin_fmaf(s[kk][qt][j], scale_log2, -mnew)); s[kk][qt][j] = p; psum += p; }
                l_run[qt] = l_run[qt] * alpha + psum;
#pragma unroll
                for (int dt = 0; dt < DT; ++dt) o[dt][qt] = o[dt][qt] * alpha;
#pragma unroll
                for (int kp = 0; kp < 2; ++kp) { v4u pp;
                    pp.x = cvt_pk_bf16(s[2 * kp][qt][0], s[2 * kp][qt][1]); pp.y = cvt_pk_bf16(s[2 * kp][qt][2], s[2 * kp][qt][3]);
                    pp.z = cvt_pk_bf16(s[2 * kp + 1][qt][0], s[2 * kp + 1][qt][1]); pp.w = cvt_pk_bf16(s[2 * kp + 1][qt][2], s[2 * kp + 1][qt][3]);
                    pf[qt][kp] = as_bf8(pp); }
            }
#pragma unroll
            for (int dt = 0; dt < DT; ++dt)
#pragma unroll
                for (int kp = 0; kp < 2; ++kp) {
                    const LAS unsigned char* vp = vb + (dt * 16 + c16) * (VROW * 2) + (32 * kp + 4 * q4) * 2;
                    const v2u a0 = *(const LAS v2u*)vp, a1 = *(const LAS v2u*)(vp + 32);
                    const bf16x8 vf = as_bf8((v4u){a0.x, a0.y, a1.x, a1.y});
                    o[dt][0] = mfma16(vf, pf[0][kp], o[dt][0]); o[dt][1] = mfma16(vf, pf[1][kp], o[dt][1]);
                }
        }
        if (kt + 1 < nkt) ATT_LSTORE((kt + 1) & 1);
        __syncthreads();
    }
#undef ATT_GLOAD
#undef ATT_LSTORE
#pragma unroll
    for (int qt = 0; qt < 2; ++qt) {
        float lt = l_run[qt]; lt += __shfl_xor(lt, 16); lt += __shfl_xor(lt, 32);
        const float inv = 1.0f / lt;
        bf16* gr = Gp + (size_t)(32 * w + 16 * qt + c16) * gpitch + 4 * q4;
#pragma unroll
        for (int dt = 0; dt < DT; ++dt) { const v2u g = *(const v2u*)(gr + dt * 16); v2u r;
            r.x = cvt_pk_bf16(o[dt][qt][0] * inv * bflo(g.x), o[dt][qt][1] * inv * bfhi(g.x)); r.y = cvt_pk_bf16(o[dt][qt][2] * inv * bflo(g.y), o[dt][qt][3] * inv * bfhi(g.y));
            if (st) *(v2u*)(gr + dt * 16) = r; }
    }
}

__device__ __forceinline__ void ph_mla(const BV& v, LAS unsigned char* lds, int bid, int nb, bool st) {
    const bf16* Qb = v.Q; const bf16* Kb = v.K; const bf16* Vtb = v.Vt; bf16* G = v.G;
    const float sc = 0.10206207261596577f * 1.4426950408889634f;
    for (int u = bid; u < 32; u += nb) {
        const int b = 0, h = (u >> 2) & 7, p = u & 3;
        for (int half = 0; half < 2; ++half) {
            const int jb = half ? p : 7 - p;
            const size_t bh = (size_t)(b * 8 + h);
            attn_block<96, 64, true, false>(lds, Qb + (bh * SEQ + 256 * jb) * 96, 96, nullptr, Kb + bh * SEQ * 96, Vtb + bh * 64 * SEQ, SEQ, 4 * (jb + 1), 256 * jb, sc,
                                            G + (size_t)(b * SEQ + 256 * jb) * GW + h * 64, GW, st, nullptr);
        }
    }
}
__device__ __forceinline__ void ph_memattn(const Args& a, const BV& v, int l, LAS unsigned char* lds, int bid, int nb, bool st) {
    const bf16* MIX = v.MIX; bf16* G = v.G;
    const bf16* kvraw = l ? v.kvraw1 : v.kvraw0;
    const float sc = 0.08838834764831845f * 1.4426950408889634f;
    for (int u = bid; u < 32; u += nb) {
        const int tb = u >> 2, h = u & 3, t0 = tb * 256, b = 0;
        attn_block<128, 128, false, true>(lds, MIX + (size_t)t0 * MIXW + MC_MQ + h * 128, MIXW, a.in[19] + l * 128, kvraw + (size_t)(b * 256) * 1024 + h * 128, kvraw + (size_t)(b * 256) * 1024 + 512 + h * 128, 256,
                                          4, 0, sc, G + (size_t)t0 * GW + 3 * 512 + h * 128, GW, st, a.in[20] + l * 128);
    }
}

__device__ __forceinline__ void ph_sg(const Args& a, const BV& v, int l, LAS unsigned char* lds, int bid, int nb, bool st) {
    const int tid = pg8::opaque_tid(), lane = tid & 63, w = tid >> 6, c16 = lane & 15, q4 = lane >> 4;
    const bf16* MIX = v.MIX; bf16* G = v.G;
    const float* lng = a.in[13] + l * 512; const float* lnb = a.in[14] + l * 512; const float* ws_ = a.in[15] + (size_t)l * 4 * 128 * 128; const float* bs = a.in[16] + l * 4 * 128;
    LAS float* stat = (LAS float*)lds; LAS bf16* vT = (LAS bf16*)(lds + 1024); constexpr int VLD = 136;
    for (int u = bid; u < 64; u += nb) {
        const int c = u >> 2, g = u & 3, t0 = c * 128;
        __syncthreads();
        {   const int row = tid >> 2, part = tid & 3; const bf16* src = MIX + (size_t)(t0 + row) * MIXW + MC_V + part * 128;
            float s1 = 0.f, s2 = 0.f;
#pragma unroll 4
            for (int i = 0; i < 16; ++i) { const v4u x = *(const v4u*)(src + i * 8);
                const float f0 = bflo(x.x), f1 = bfhi(x.x), f2 = bflo(x.y), f3 = bfhi(x.y), f4 = bflo(x.z), f5 = bfhi(x.z), f6 = bflo(x.w), f7 = bfhi(x.w);
                s1 += ((f0 + f1) + (f2 + f3)) + ((f4 + f5) + (f6 + f7)); s2 += ((f0 * f0 + f1 * f1) + (f2 * f2 + f3 * f3)) + ((f4 * f4 + f5 * f5) + (f6 * f6 + f7 * f7)); }
            s1 += __shfl_xor(s1, 1); s1 += __shfl_xor(s1, 2); s2 += __shfl_xor(s2, 1); s2 += __shfl_xor(s2, 2);
            const float mean = s1 * (1.f / 512.f), var = fmaxf(s2 * (1.f / 512.f) - mean * mean, 0.f);
            if (part == 0) { stat[row * 2] = mean; stat[row * 2 + 1] = 1.0f / sqrtf(var + EPS); }
        }
        __syncthreads();
        {   const int s = tid & 127, dq = tid >> 7; const bf16* src = MIX + (size_t)(t0 + s) * MIXW + MC_V + g * 128 + dq * 32;
            const float mean = stat[s * 2], rstd = stat[s * 2 + 1];
#pragma unroll
            for (int i = 0; i < 4; ++i) { const v4u x = *(const v4u*)(src + i * 8); const int d0 = dq * 32 + i * 8; const float* gp = lng + g * 128 + d0; const float* bp = lnb + g * 128 + d0;
                float f[8] = {bflo(x.x), bfhi(x.x), bflo(x.y), bfhi(x.y), bflo(x.z), bfhi(x.z), bflo(x.w), bfhi(x.w)};
#pragma unroll
                for (int e = 0; e < 8; ++e) { const float y = (f[e] - mean) * rstd * gp[e] + bp[e]; vT[(d0 + e) * VLD + s] = (bf16)(cvt_pk_bf16(y, 0.f) & 0xffffu); } }
        }
        __syncthreads();
        {   f32x4 acc[8];
#pragma unroll
            for (int nt = 0; nt < 8; ++nt) acc[nt] = (f32x4){0.f, 0.f, 0.f, 0.f};
            const int tt = 16 * w + c16, nks = (w >> 1) + 1;
            const float* wrow = ws_ + ((size_t)g * 128 + tt) * 128;
            for (int ks = 0; ks < nks; ++ks) {
                const int s0 = ks * 32 + 8 * q4;
                const f32x4 w0 = *(const f32x4*)(wrow + s0), w1 = *(const f32x4*)(wrow + s0 + 4);
                float wv[8] = {w0[0], w0[1], w0[2], w0[3], w1[0], w1[1], w1[2], w1[3]};
#pragma unroll
                for (int e = 0; e < 8; ++e) wv[e] = (s0 + e <= tt) ? wv[e] : 0.f;
                v4u wp; wp.x = cvt_pk_bf16(wv[0], wv[1]); wp.y = cvt_pk_bf16(wv[2], wv[3]); wp.z = cvt_pk_bf16(wv[4], wv[5]); wp.w = cvt_pk_bf16(wv[6], wv[7]);
                const bf16x8 bfrag = as_bf8(wp);
#pragma unroll
                for (int nt = 0; nt < 8; ++nt) { const bf16x8 af = as_bf8(*(const LAS v4u*)(vT + (nt * 16 + c16) * VLD + s0)); acc[nt] = mfma16(af, bfrag, acc[nt]); }
            }
            const int t = t0 + tt; const float bias = bs[g * 128 + tt];
            const bf16* up = MIX + (size_t)t * MIXW + MC_U + g * 128 + 4 * q4; bf16* gp = G + (size_t)t * GW + 2 * 512 + g * 128 + 4 * q4;
#pragma unroll
            for (int nt = 0; nt < 8; ++nt) { const v2u uu = *(const v2u*)(up + nt * 16), gg = *(const v2u*)(gp + nt * 16); v2u r;
                r.x = cvt_pk_bf16(bflo(uu.x) * (acc[nt][0] + bias) * bflo(gg.x), bfhi(uu.x) * (acc[nt][1] + bias) * bfhi(gg.x));
                r.y = cvt_pk_bf16(bflo(uu.y) * (acc[nt][2] + bias) * bflo(gg.y), bfhi(uu.y) * (acc[nt][3] + bias) * bfhi(gg.y));
                if (st) *(v2u*)(gp + nt * 16) = r; }
        }
    }
}

__device__ __forceinline__ void ph_conv(const Args& a, const BV& v, int l, int bid, int nb, bool st) {
    const bf16* MIX = v.MIX; bf16* G = v.G;
    const float* cw = a.in[11] + l * 3 * 512; const float* cb = a.in[12] + l * 512;
    for (int idx = bid * NTHR + pg8::opaque_tid(); idx < (SEQ / 4) * 64; idx += nb * NTHR) {
        const int t4 = (idx >> 6) * 4, c = (idx & 63) * 8;
        float w0[8], w1[8], w2[8], bb[8];
#pragma unroll
        for (int e = 0; e < 8; ++e) { w0[e] = cw[c + e]; w1[e] = cw[512 + c + e]; w2[e] = cw[1024 + c + e]; bb[e] = cb[c + e]; }
        v4u cgv[6], xv[6], bgv[4], ggv[4];
#pragma unroll
        for (int r = 0; r < 6; ++r) { const int t = t4 - 2 + r; const bf16* row = MIX + (size_t)(t < 0 ? 0 : t) * MIXW; cgv[r] = *(const v4u*)(row + MC_CG + c); xv[r] = *(const v4u*)(row + MC_XIN + c); }
#pragma unroll
        for (int r = 0; r < 4; ++r) { bgv[r] = *(const v4u*)(MIX + (size_t)(t4 + r) * MIXW + MC_BG + c); ggv[r] = *(const v4u*)(G + (size_t)(t4 + r) * GW + 512 + c); }
        float z[6][8];
#pragma unroll
        for (int r = 0; r < 6; ++r) { const float m = (t4 - 2 + r < 0) ? 0.f : 1.f;
            z[r][0] = m * bflo(cgv[r].x) * bflo(xv[r].x); z[r][1] = m * bfhi(cgv[r].x) * bfhi(xv[r].x); z[r][2] = m * bflo(cgv[r].y) * bflo(xv[r].y); z[r][3] = m * bfhi(cgv[r].y) * bfhi(xv[r].y);
            z[r][4] = m * bflo(cgv[r].z) * bflo(xv[r].z); z[r][5] = m * bfhi(cgv[r].z) * bfhi(xv[r].z); z[r][6] = m * bflo(cgv[r].w) * bflo(xv[r].w); z[r][7] = m * bfhi(cgv[r].w) * bfhi(xv[r].w); }
#pragma unroll
        for (int r = 0; r < 4; ++r) {
            const v4u bg = bgv[r], gg = ggv[r];
            const float bgf[8] = {bflo(bg.x), bfhi(bg.x), bflo(bg.y), bfhi(bg.y), bflo(bg.z), bfhi(bg.z), bflo(bg.w), bfhi(bg.w)};
            const float ggf[8] = {bflo(gg.x), bfhi(gg.x), bflo(gg.y), bfhi(gg.y), bflo(gg.z), bfhi(gg.z), bflo(gg.w), bfhi(gg.w)};
            float y[8];
#pragma unroll
            for (int e = 0; e < 8; ++e) y[e] = bgf[e] * (bb[e] + w0[e] * z[r][e] + w1[e] * z[r + 1][e] + w2[e] * z[r + 2][e]) * ggf[e];
            v4u o; o.x = cvt_pk_bf16(y[0], y[1]); o.y = cvt_pk_bf16(y[2], y[3]); o.z = cvt_pk_bf16(y[4], y[5]); o.w = cvt_pk_bf16(y[6], y[7]);
            if (st) *(v4u*)(G + (size_t)(t4 + r) * GW + 512 + c) = o;
        }
    }
}
#define XB_TMO      128
#define XB_XCNT(j)  (256  + 64 * (j))
#define XB_XSUB(j)  (1280 + 64 * (j))
#define XB_XGEN(j)  (2304 + 64 * (j))
#define XB_TOP      3328
#define XB_TOPGEN   3392
#define XCD_BAR_WORDS 3456
#define XB_SPIN_CAP (1u << 18)

__device__ __forceinline__ unsigned xb_ld(unsigned* p)              { return __hip_atomic_load(p, __ATOMIC_RELAXED, __HIP_MEMORY_SCOPE_AGENT); }
__device__ __forceinline__ unsigned xb_add(unsigned* p, unsigned v) { return __hip_atomic_fetch_add(p, v, __ATOMIC_RELAXED, __HIP_MEMORY_SCOPE_AGENT); }
__device__ __forceinline__ unsigned xb_xcc_id() { return (unsigned)__builtin_amdgcn_s_getreg((3 << 11) | 20) & 0xFu; }
#define XB_SPIN(cond, bar) do { unsigned _sp = 0; while (cond) { __builtin_amdgcn_s_sleep(1); \
    if ((++_sp & 255u) == 0u) { if (xb_ld(&(bar)[XB_TMO])) break; if (_sp > XB_SPIN_CAP) { atomicAdd(&(bar)[XB_TMO], 1u); break; } } } } while (0)

struct XcdBarrier {
    unsigned* bar; unsigned x;
    volatile LAS unsigned* st;
};

__device__ __forceinline__ XcdBarrier xcd_barrier_post(unsigned* bar, volatile LAS unsigned* st) {
    XcdBarrier b; b.bar = bar; b.x = xb_xcc_id(); b.st = st;
    if (threadIdx.x == 0) (void)xb_add(&bar[XB_XCNT(b.x)], 1u);
    return b;
}
__device__ __forceinline__ void xcd_barrier_complete(unsigned* bar, unsigned x, unsigned& nloc, unsigned& nx) {
    const unsigned G = gridDim.x * gridDim.y * gridDim.z;
    unsigned sum, cnt, mine, sp = 0u;
    for (;;) {
        sum = 0u; cnt = 0u; mine = 0u;
#pragma unroll
        for (unsigned j = 0; j < 16; ++j) { const unsigned c = xb_ld(&bar[XB_XCNT(j)]); sum += c; cnt += (c > 0u) ? 1u : 0u; mine = (j == x) ? c : mine; }
        if (sum == G) break;
        __builtin_amdgcn_s_sleep(1);
        if ((++sp & 255u) == 0u) { if (xb_ld(&bar[XB_TMO])) break; if (sp > XB_SPIN_CAP) { atomicAdd(&bar[XB_TMO], 1u); break; } }
    }
    nloc = mine > 0u ? mine : 1u; nx = cnt > 0u ? cnt : 1u;
}

__device__ __forceinline__ void xcd_barrier(const XcdBarrier& b) {
    asm volatile("s_waitcnt vmcnt(0)" ::: "memory");
    __syncthreads();
    if (threadIdx.x == 0) {
        unsigned* bar = b.bar;
        __builtin_amdgcn_s_waitcnt(0);
        unsigned nloc = b.st[0], nx = b.st[1];
        if (nloc == 0u) { xcd_barrier_complete(bar, b.x, nloc, nx); b.st[0] = nloc; b.st[1] = nx; }
        const unsigned old = xb_add(&bar[XB_XSUB(b.x)], 1u);
        const unsigned gen = old / nloc;
        if (old + 1u == (gen + 1u) * nloc) {
            __builtin_amdgcn_fence(__ATOMIC_RELEASE, "agent");
            asm volatile("s_waitcnt vmcnt(0)" ::: "memory");
            const unsigned og = xb_add(&bar[XB_TOP], 1u);
            const unsigned tg = og / nx;
            if (og + 1u == (tg + 1u) * nx) xb_add(&bar[XB_TOPGEN], 1u);
            else XB_SPIN(xb_ld(&bar[XB_TOPGEN]) == tg, bar);
            __builtin_amdgcn_fence(__ATOMIC_ACQUIRE, "agent");
            xb_add(&bar[XB_XGEN(b.x)], 1u);
            asm volatile("s_waitcnt vmcnt(0)" ::: "memory");
        } else {
            XB_SPIN(xb_ld(&bar[XB_XGEN(b.x)]) == gen, bar);
            __builtin_amdgcn_fence(__ATOMIC_ACQUIRE, "agent");
            asm volatile("s_waitcnt vmcnt(0)" ::: "memory");
        }
    }
    __syncthreads();
}

#ifndef MK_PER_PHASE
#define MK_PER_PHASE 0
#endif
constexpr int NPH = 1 + 8 + 7;
__device__ __forceinline__ void group_barrier(unsigned* cnt, unsigned& round) {
    asm volatile("s_waitcnt vmcnt(0)" ::: "memory");
    __syncthreads();
    if (threadIdx.x == 0) {
        __builtin_amdgcn_fence(__ATOMIC_RELEASE, "agent");
        asm volatile("s_waitcnt vmcnt(0)" ::: "memory");
        (void)__hip_atomic_fetch_add(cnt, 1u, __ATOMIC_RELAXED, __HIP_MEMORY_SCOPE_AGENT);
        const unsigned target = (round + 1u) * 32u; unsigned sp = 0u;
        while (__hip_atomic_load(cnt, __ATOMIC_RELAXED, __HIP_MEMORY_SCOPE_AGENT) < target) { __builtin_amdgcn_s_sleep(1); if (++sp > (1u << 24)) break; }
        __builtin_amdgcn_fence(__ATOMIC_ACQUIRE, "agent");
        asm volatile("s_waitcnt vmcnt(0)" ::: "memory");
    }
    __syncthreads();
    ++round;
}

__global__ void __launch_bounds__(NTHR, 2) mk_fwd(Args a) {
    extern __shared__ __attribute__((aligned(16))) unsigned char lds_raw[];
    LAS unsigned char* lds = (LAS unsigned char*)lds_raw;
    cg::grid_group grid = cg::this_grid();
    const int bid = blockIdx.x, nb = gridDim.x;
    const bool real = (a.ph_hi > 0);
    volatile LAS unsigned* MISC = (volatile LAS unsigned*)(lds + 131072);
    if (threadIdx.x < 32) MISC[threadIdx.x] = 0u;
    __syncthreads();
    const XcdBarrier bar = xcd_barrier_post((unsigned*)a.ws + 1024, MISC + 8);
#ifdef DUP_PRO
    ph_prologue(a, lds, bid, nb); __syncthreads();
#endif
    ph_prologue(a, lds, bid, nb);
    if (a.ph_hi < 0) grid.sync();
    xcd_barrier(bar);
    for (int ll = 0; ll < 2; ++ll) {
        pg8::Gemm g2{(const bf16*)(a.ws + WS_MEMN + ll * 4 * MiB), DM, (const bf16*)(a.ws + WS_WMEMT + ll * 2 * MiB), MEMT, 1024, DM};
        pg8::StaticOrder S2; S2.init(MEMT, 1024, nb, (bid + 128 * ll) % nb);
        pg8::EpiAct<0> E2{(bf16*)(a.ws + WS_KVRAW + ll * 4 * MiB), 1024, 1 << 20, nullptr, 0, nullptr};
        pg8::gemm_phase<pg8::EpiAct<0>, pg8::StaticOrder, true, true>(lds, g2, S2, E2);
    }
    xcd_barrier(bar);
    const int g = bid & 7, lb = bid >> 3; constexpr int NLB = 32;
    unsigned* gcnt = (unsigned*)a.ws + 8192 + 64 * g; unsigned round = 0u;
    unsigned char* slab = a.ws + WS_SLAB + (size_t)g * SLAB;
    BV v; v.MIX = (bf16*)(slab + SO_MIX); v.G = (bf16*)(slab + SO_G); v.Q = (bf16*)(slab + SO_Q); v.K = (bf16*)(slab + SO_K); v.Vt = (bf16*)(slab + SO_VT);
    v.kvraw0 = (const bf16*)(a.ws + WS_KVRAW) + (size_t)g * MEML * 1024; v.kvraw1 = (const bf16*)(a.ws + WS_KVRAW + 4 * MiB) + (size_t)g * MEML * 1024; v.pos = (const int*)a.in[2] + g * SEQ;
    bf16* H = (bf16*)(slab + SO_H); bf16* GATE = (bf16*)(slab + SO_GATE); bf16* MERGED = (bf16*)(slab + SO_MERGED);
    float* outg = a.out + (size_t)g * SEQ * DM;
#define GB() group_barrier(gcnt, round)
    for (int l = 0; l < 2; ++l) {
        const unsigned char* wb = a.ws + (l ? WS_W1 : WS_W0);
        const bf16* WinT = (const bf16*)(wb + WO_WIN);
        const float* xl = l ? outg : a.in[0] + (size_t)g * SEQ * DM;
        const bf16* Hl = l ? H : (const bf16*)outg;
        {
            pg8::Gemm gm{Hl, DM, WinT, SEQ, NA, DM};
            pg8::StaticOrder S; S.init(SEQ, NA, NLB, lb);
            pg8::EpiAct<1> E{v.MIX, MIXW, 14, v.G, GW, nullptr};
#ifdef DUP_P1A
            pg8::gemm_phase<pg8::EpiAct<1>, pg8::StaticOrder, true, true>(lds, gm, S, E);
#endif
            pg8::gemm_phase<pg8::EpiAct<1>, pg8::StaticOrder, true, true>(lds, gm, S, E);
        }
        GB();
#ifdef DUP_P2
        ph_p2(a, v, l, lds, lb, NLB);
#endif
        ph_p2(a, v, l, lds, lb, NLB);
        GB();
#ifdef DUP_MLA
        ph_mla(v, lds, lb, NLB, !real);
#endif
#ifdef DUP_MIX3
        ph_memattn(a, v, l, lds, lb, NLB, !real); ph_sg(a, v, l, lds, lb, NLB, !real); ph_conv(a, v, l, lb, NLB, !real);
#endif
        ph_mla(v, lds, lb, NLB, real); ph_memattn(a, v, l, lds, lb, NLB, real); ph_sg(a, v, l, lds, lb, NLB, real); ph_conv(a, v, l, lb, NLB, real);
        GB();
        if (l == 1) { norm_rows(xl, a.in[3] + l * DM, H, SEQ, lb, NLB); GB(); }
        {
            pg8::Gemm gm{Hl, DM, WinT + (size_t)NA * DM, SEQ, GATEW, DM};
            pg8::StaticOrder S; S.init(SEQ, GATEW, NLB, lb);
            pg8::EpiAct<2> E{nullptr, 0, 0, GATE, GATEW, a.in[21] + l * 4096};
#ifdef DUP_P1B
            pg8::gemm_phase<pg8::EpiAct<2>, pg8::StaticOrder, true, true>(lds, gm, S, E);
#endif
            pg8::gemm_phase<pg8::EpiAct<2>, pg8::StaticOrder, true, true>(lds, gm, S, E);
        }
        GB();
        {
            pg8::Gemm gm{v.G, GW, (const bf16*)(wb + WO_WBR), SEQ, DM, 2048};
            pg8::StaticOrder S; S.init(SEQ, DM, NLB, lb);
            pg8::EpiGate E{GATE, MERGED};
#ifdef DUP_P4
            pg8::gemm_phase<pg8::EpiGate, pg8::StaticOrder, false, true>(lds, gm, S, E);
#endif
            pg8::gemm_phase<pg8::EpiGate, pg8::StaticOrder, false, true>(lds, gm, S, E);
        }
        GB();
        {
            pg8::Gemm gm{MERGED, DM, (const bf16*)(wb + WO_WOUT), SEQ, DM, DM};
            pg8::StaticOrder S; S.init(SEQ, DM, NLB, lb);
#ifdef DUP_P5
            { pg8::EpiRes E0{xl, outg, DM, !real}; pg8::gemm_phase<pg8::EpiRes, pg8::StaticOrder, false, true>(lds, gm, S, E0); }
#endif
            pg8::EpiRes E{xl, outg, DM, real};
            pg8::gemm_phase<pg8::EpiRes, pg8::StaticOrder, false, true>(lds, gm, S, E);
        }
        if (l == 0) { GB(); norm_rows(outg, a.in[3] + DM, H, SEQ, lb, NLB); GB(); }
    }
#undef GB
}

extern "C" void kernel_launch(void* const* d_in, const int* in_sizes, int n_in, void* d_out, int out_size, void* d_ws, size_t ws_size, hipStream_t stream) {
    static int grid = 0;
    if (grid == 0) {
        if (n_in != 24 || out_size != T * DM || ws_size < WS_END) { fprintf(stderr, "kernel_launch: unexpected problem (n_in %d out %d ws %zu)\n", n_in, out_size, ws_size); grid = -1; return; }
        int dev = 0, cus = 0, per_cu = 0;
        hipGetDevice(&dev); hipDeviceGetAttribute(&cus, hipDeviceAttributeMultiprocessorCount, dev);
        if (hipFuncSetAttribute((const void*)mk_fwd, hipFuncAttributeMaxDynamicSharedMemorySize, LDS_BYTES) != hipSuccess) { fprintf(stderr, "kernel_launch: hipFuncSetAttribute failed\n"); grid = -1; return; }
        if (hipOccupancyMaxActiveBlocksPerMultiprocessor(&per_cu, (const void*)mk_fwd, NTHR, LDS_BYTES) != hipSuccess || per_cu < 1) { fprintf(stderr, "kernel_launch: occupancy query says %d\n", per_cu); per_cu = 1; }
        (void)hipGetLastError();
        if (cus < 256) { fprintf(stderr, "kernel_launch: needs 256 CUs, device has %d\n", cus); grid = -1; return; }
        grid = 256;
    }
    if (grid < 0) return;
    if (hipMemsetAsync(d_ws, 0, 65536, stream) != hipSuccess) { fprintf(stderr, "kernel_launch: memset failed\n"); return; }
    Args a{};
    for (int i = 0; i < 24; ++i) a.in[i] = (const float*)d_in[i];
    a.out = (float*)d_out; a.ws = (unsigned char*)d_ws;
    a.ph_lo = 0; a.ph_hi = NPH; void* args[] = {&a};
    hipError_t e = hipLaunchCooperativeKernel((void*)mk_fwd, dim3(grid), dim3(NTHR), args, LDS_BYTES, stream);
    if (e != hipSuccess) fprintf(stderr, "cooperative launch failed: %s (grid %d)\n", hipGetErrorString(e), grid);
}
```

```cpp
#include <hip/hip_runtime.h>
#include <hip/hip_cooperative_groups.h>
#include <cstdio>
#include <cstdint>
namespace cg = cooperative_groups;
namespace pg8 {
#define PG8_LAS __attribute__((address_space(3)))
typedef unsigned short bf16_t;
typedef short bf16x8 __attribute__((ext_vector_type(8)));
typedef float f32x4 __attribute__((ext_vector_type(4)));
typedef unsigned u32x4 __attribute__((ext_vector_type(4)));
constexpr int BM = 256, BK = 64, HALF = 128, HTB = HALF * BK * 2  , STAGE_BYTES = 8 * HTB, NXCD = 8, WGM = 8;

__host__ __device__ __forceinline__ int lds_byte(int r, int c) { const int st = (r >> 4) * 2 + (c >> 5), rr = r & 15, cc = c & 31, ob = rr * 64 + cc * 2; return st * 1024 + (ob ^ (((ob >> 9) & 1) << 5)); }
__host__ __device__ __forceinline__ void stage_rc(int b, int& R, int& C) { const int st = b / 1024, sb = b % 1024, swz = sb ^ (((sb >> 9) & 1) << 5); R = (st >> 1) * 16 + swz / 64; C = (st & 1) * 32 + (swz % 64) / 2; }
__host__ __device__ __forceinline__ int perm32(int rho) { const int n = rho >> 4, i = rho & 15; return 8 * (i >> 2) + 4 * n + (i & 3); }

struct Unit { int pm, pn; };
struct Gemm { const bf16_t* A; int lda; const bf16_t* Bt; int M, N, K; };

struct StaticOrder {
    int nM, nN, nwg, G, c;
    __host__ __device__ void init(int M, int N, int G_, int c_) { nM = M / BM; nN = N / BM; nwg = nM * nN; G = G_; c = c_; }
    __host__ __device__ bool next(int i, Unit& u) const {
        const long L = (long)i * G + c; if (L >= nwg) return false;
        int wgid = (int)L; { const int q = nwg / NXCD, r = nwg % NXCD, xcd = wgid % NXCD, off = wgid / NXCD; wgid = (xcd < r ? xcd * (q + 1) : r * (q + 1) + (xcd - r) * q) + off; }
        const int nig = WGM * nN, gid = wgid / nig, fm = gid * WGM, gsz = (nM - fm) < WGM ? (nM - fm) : WGM;
        u.pm = fm + ((wgid % nig) % gsz); u.pn = (wgid % nig) / gsz; return true;
    }
    __device__ __forceinline__ void a_ready(const Unit&) const {}
    __device__ __forceinline__ void done(const Unit&) const {}
};

__device__ __forceinline__ unsigned cvt_pk_bf16(float lo, float hi) { unsigned r; asm volatile("v_cvt_pk_bf16_f32 %0, %1, %2" : "=v"(r) : "v"(lo), "v"(hi)); return r; }
__device__ __forceinline__ int opaque_tid() { int t = threadIdx.x; asm volatile("" : "+v"(t)); return t; }
__device__ __forceinline__ float bflo(unsigned u) { return __uint_as_float(u << 16); }
__device__ __forceinline__ float bfhi(unsigned u) { return __uint_as_float(u & 0xffff0000u); }
__device__ __forceinline__ float sigm(float x) { return __builtin_amdgcn_rcpf(1.0f + __expf(-x)); }

template <int ACT> struct EpiAct {
    static constexpr bool PERM = true, AFTER_DRAIN = false, HAS_MID = false;
    bf16_t* O0; int ld0; int npn0; bf16_t* O1; int ld1; const float* bias;
    __device__ __forceinline__ void operator()(const f32x4 (&acc)[2][2][4][2], const Unit& u, int wr, int wc, int fr, int fq) const {
        const int row0 = u.pm * BM + wr * 64 + fr;
        const bool second = (u.pn >= npn0);
        bf16_t* base = second ? O1 : O0; const int ld = second ? ld1 : ld0; const int colt = second ? (u.pn - npn0) * BM : u.pn * BM;
        const int col0 = colt + wc * 32 + 8 * fq;
#pragma unroll
        for (int bj = 0; bj < 2; ++bj) {
            f32x4 b0 = (f32x4){0.f, 0.f, 0.f, 0.f}, b1 = b0;
            if (ACT == 2) { b0 = *(const f32x4*)(bias + col0 + bj * HALF); b1 = *(const f32x4*)(bias + col0 + bj * HALF + 4); }
#pragma unroll
            for (int ai = 0; ai < 2; ++ai)
#pragma unroll
                for (int m = 0; m < 4; ++m) {
                    bf16_t* rowp = base + (size_t)(row0 + ai * HALF + m * 16) * ld + col0 + bj * HALF;
                    f32x4 v0 = acc[ai][bj][m][0], v1 = acc[ai][bj][m][1];
                    if (ACT != 0 && second) {
#pragma unroll
                        for (int e = 0; e < 4; ++e) {
                            if (ACT == 1) { v0[e] = v0[e] * sigm(v0[e]); v1[e] = v1[e] * sigm(v1[e]); }
                            if (ACT == 2) { v0[e] = sigm(v0[e] + b0[e]); v1[e] = sigm(v1[e] + b1[e]); }
                        }
                    }
                    u32x4 w; w.x = cvt_pk_bf16(v0[0], v0[1]); w.y = cvt_pk_bf16(v0[2], v0[3]); w.z = cvt_pk_bf16(v1[0], v1[1]); w.w = cvt_pk_bf16(v1[2], v1[3]);
                    *(u32x4*)rowp = w;
                }
        }
    }
};

struct EpiGateQ {
    static constexpr bool PERM = true, AFTER_DRAIN = false, HAS_MID = false;
    unsigned char* O; const float* bias;
    __device__ __forceinline__ void operator()(const f32x4 (&acc)[2][2][4][2], const Unit& u, int wr, int wc, int fr, int fq) const {
        const int row0 = u.pm * BM + wr * 64 + fr, col0 = u.pn * BM + wc * 32 + 8 * fq;
#pragma unroll
        for (int bj = 0; bj < 2; ++bj) {
            const f32x4 b0 = *(const f32x4*)(bias + col0 + bj * HALF), b1 = *(const f32x4*)(bias + col0 + bj * HALF + 4);
#pragma unroll
            for (int ai = 0; ai < 2; ++ai)
#pragma unroll
                for (int m = 0; m < 4; ++m) {
                    const f32x4 v0 = acc[ai][bj][m][0] + b0, v1 = acc[ai][bj][m][1] + b1;
                    unsigned lo = 0u, hi = 0u;
#pragma unroll
                    for (int e = 0; e < 4; ++e) {
                        lo = __builtin_amdgcn_cvt_pk_u8_f32(fmaxf(__builtin_rintf(sigm(v0[e]) * 255.0f), 1.0f), e, lo);
                        hi = __builtin_amdgcn_cvt_pk_u8_f32(fmaxf(__builtin_rintf(sigm(v1[e]) * 255.0f), 1.0f), e, hi);
                    }
                    typedef unsigned u32x2 __attribute__((ext_vector_type(2)));
                    *(u32x2*)(O + (size_t)(row0 + ai * HALF + m * 16) * 4096 + col0 + bj * HALF) = (u32x2){lo, hi};
                }
        }
    }
};

__device__ __forceinline__ float ub0(unsigned u) { return (float)(u & 0xffu); }
__device__ __forceinline__ float ub1(unsigned u) { return (float)((u >> 8) & 0xffu); }
__device__ __forceinline__ float ub2(unsigned u) { return (float)((u >> 16) & 0xffu); }
__device__ __forceinline__ float ub3(unsigned u) { return (float)(u >> 24); }
struct EpiGate {
    static constexpr bool PERM = true, AFTER_DRAIN = false, HAS_MID = true;
    const unsigned char* GATE; bf16_t* O;
    typedef unsigned u32x2 __attribute__((ext_vector_type(2)));
    __device__ __forceinline__ void mid(f32x4 (&acc)[2][2][4][2], const Unit& u, int nb, int wr, int wc, int fr_, int fq_) const {
        int fr = fr_, fq = fq_; asm volatile("" : "+v"(fr), "+v"(fq));
        const int row0 = u.pm * BM + wr * 64 + fr, col0 = u.pn * BM + wc * 32 + 8 * fq;
#pragma unroll
        for (int ai = 0; ai < 2; ++ai) {
            u32x2 ga[2][4], gb[2][4];
#pragma unroll
            for (int bj = 0; bj < 2; ++bj)
#pragma unroll
                for (int m = 0; m < 4; ++m) { const unsigned char* gp = GATE + (size_t)(row0 + ai * HALF + m * 16) * 4096 + (nb - 1) * 1024 + col0 + bj * HALF; ga[bj][m] = *(const u32x2*)gp; gb[bj][m] = *(const u32x2*)(gp + 1024); }
            __builtin_amdgcn_sched_barrier(0);
#pragma unroll
            for (int bj = 0; bj < 2; ++bj)
#pragma unroll
                for (int m = 0; m < 4; ++m) { const u32x2 a = ga[bj][m], b = gb[bj][m];
                    f32x4 r0, r1;
                    r0[0] = ub0(a.x) * __builtin_amdgcn_rcpf(ub0(b.x)); r0[1] = ub1(a.x) * __builtin_amdgcn_rcpf(ub1(b.x));
                    r0[2] = ub2(a.x) * __builtin_amdgcn_rcpf(ub2(b.x)); r0[3] = ub3(a.x) * __builtin_amdgcn_rcpf(ub3(b.x));
                    r1[0] = ub0(a.y) * __builtin_amdgcn_rcpf(ub0(b.y)); r1[1] = ub1(a.y) * __builtin_amdgcn_rcpf(ub1(b.y));
                    r1[2] = ub2(a.y) * __builtin_amdgcn_rcpf(ub2(b.y)); r1[3] = ub3(a.y) * __builtin_amdgcn_rcpf(ub3(b.y));
                    acc[ai][bj][m][0] = acc[ai][bj][m][0] * r0; acc[ai][bj][m][1] = acc[ai][bj][m][1] * r1; }
            __builtin_amdgcn_sched_barrier(0);
        }
    }
    __device__ __forceinline__ void operator()(const f32x4 (&acc)[2][2][4][2], const Unit& u, int wr, int wc, int fr, int fq) const {
        const int row0 = u.pm * BM + wr * 64 + fr, col0 = u.pn * BM + wc * 32 + 8 * fq;
        const float k = 1.0f / 255.0f;
#pragma unroll
        for (int ai = 0; ai < 2; ++ai)
#pragma unroll
            for (int bj = 0; bj < 2; ++bj) {
                u32x2 ga[4];
#pragma unroll
                for (int m = 0; m < 4; ++m) ga[m] = *(const u32x2*)(GATE + (size_t)(row0 + ai * HALF + m * 16) * 4096 + 3 * 1024 + col0 + bj * HALF);
                __builtin_amdgcn_sched_barrier(0);
#pragma unroll
                for (int m = 0; m < 4; ++m) { const u32x2 a = ga[m]; const f32x4 v0 = acc[ai][bj][m][0] * k, v1 = acc[ai][bj][m][1] * k;
                    u32x4 w; w.x = cvt_pk_bf16(v0[0] * ub0(a.x), v0[1] * ub1(a.x)); w.y = cvt_pk_bf16(v0[2] * ub2(a.x), v0[3] * ub3(a.x));
                    w.z = cvt_pk_bf16(v1[0] * ub0(a.y), v1[1] * ub1(a.y)); w.w = cvt_pk_bf16(v1[2] * ub2(a.y), v1[3] * ub3(a.y));
                    *(u32x4*)(O + (size_t)(row0 + ai * HALF + m * 16) * 1024 + col0 + bj * HALF) = w; }
                __builtin_amdgcn_sched_barrier(0);
            }
    }
};

struct EpiRes {
    static constexpr bool PERM = false, AFTER_DRAIN = false, HAS_MID = false;
    const float* base; float* out; int ldc; bool st;
    __device__ __forceinline__ void operator()(const f32x4 (&acc)[2][2][4][2], const Unit& u, int wr, int wc, int fr, int fq) const {
        const int row0 = u.pm * BM + wr * 64 + fr, col0 = u.pn * BM + wc * 32 + 4 * fq;
#pragma unroll
        for (int ai = 0; ai < 2; ++ai)
#pragma unroll
            for (int m = 0; m < 4; ++m)
#pragma unroll
                for (int bj = 0; bj < 2; ++bj)
#pragma unroll
                    for (int n = 0; n < 2; ++n) {
                        const size_t o = (size_t)(row0 + ai * HALF + m * 16) * ldc + col0 + bj * HALF + 16 * n;
                        const f32x4 x = *(const f32x4*)(base + o);
                        if (st) *(f32x4*)(out + o) = x + acc[ai][bj][m][n];
                    }
    }
};
template <class Epi, class Sched, bool ALIGN_EPI = false, bool SP2 = false>
__device__ __forceinline__ void gemm_phase(PG8_LAS unsigned char* lds, const Gemm g, const Sched& S, const Epi& E) {
    const int tid = pg8::opaque_tid(), wid = __builtin_amdgcn_readfirstlane(tid >> 6), lane = tid & 63, wr = wid >> 2, wc = wid & 3, fr = lane & 15, fq = lane >> 4;
    const int K = g.K, nt = K / BK;
    unsigned voffA[2], voffB[2];
#pragma unroll
    for (int i = 0; i < 2; ++i) { int R, C; stage_rc(tid * 16 + i * 8192, R, C); const int Rb = Epi::PERM ? ((R & ~31) + perm32(R & 31)) : R;
        voffA[i] = (unsigned)(R * g.lda + C) * 2u; voffB[i] = (unsigned)(Rb * K + C) * 2u; }
    const size_t kstep = (size_t)(BK * 2);
    const size_t hstepA = (size_t)HALF * g.lda * 2, hstepB = (size_t)HALF * K * 2;
    const size_t tstepA = 2 * hstepA, tstepB = 2 * hstepB;
    const unsigned ldsw = (unsigned)wid * 1024u;
    const int aoff = lds_byte(wr * 64 + fr, fq * 8), boff = lds_byte(wc * 32 + fr, fq * 8);
#define PG8_SA(b, h) (((b) * 2 + (h)) * HTB)
#define PG8_SB(b, h) ((4 + (b) * 2 + (h)) * HTB)
#define PG8_STAGE(bufoff, gbase, voff) do { _Pragma("unroll") for (int _i = 0; _i < 2; ++_i) \
        __builtin_amdgcn_global_load_lds((const unsigned*)((const char*)(gbase) + (voff)[_i]), (PG8_LAS unsigned*)(lds + (bufoff) + ldsw + _i * 8192), 16, 0, 0); } while (0)
#define PG8_LDA(dst, b, h) do { _Pragma("unroll") for (int m = 0; m < 4; ++m) _Pragma("unroll") for (int k = 0; k < 2; ++k) dst[m][k] = *(const PG8_LAS bf16x8*)(lds + PG8_SA(b, h) + aoff + m * 2048 + k * 1024); } while (0)
#define PG8_LDB(dst, b, h) do { _Pragma("unroll") for (int n = 0; n < 2; ++n) _Pragma("unroll") for (int k = 0; k < 2; ++k) dst[n][k] = *(const PG8_LAS bf16x8*)(lds + PG8_SB(b, h) + boff + n * 2048 + k * 1024); } while (0)
#define PG8_MMA(ai, bj, At, Bt) do { __builtin_amdgcn_s_setprio(1); _Pragma("unroll") for (int m = 0; m < 4; ++m) _Pragma("unroll") for (int n = 0; n < 2; ++n) _Pragma("unroll") for (int k = 0; k < 2; ++k) \
        acc[ai][bj][m][n] = __builtin_amdgcn_mfma_f32_16x16x32_bf16(Bt[n][k], At[m][k], acc[ai][bj][m][n], 0, 0, 0); __builtin_amdgcn_s_setprio(0); } while (0)
#define PG8_WAIT_V(n) asm volatile("s_waitcnt vmcnt(" #n ")" ::: "memory")
#define PG8_WAIT_L(n) asm volatile("s_waitcnt lgkmcnt(" #n ")" ::: "memory")
#define PG8_BAR __builtin_amdgcn_s_barrier()
#define PG8_SCHED __builtin_amdgcn_sched_barrier(0)
    Unit cur, nxt; int ui = 0;
    if (!S.next(0, cur)) return;
    f32x4 acc[2][2][4][2];
#pragma unroll
    for (int a = 0; a < 2; ++a)
#pragma unroll
        for (int b = 0; b < 2; ++b)
#pragma unroll
            for (int m = 0; m < 4; ++m)
#pragma unroll
                for (int n = 0; n < 2; ++n) acc[a][b][m][n] = (f32x4){0.f, 0.f, 0.f, 0.f};
    bf16x8 At[4][2], B0[2][2], B1[2][2];
    const char* cA = (const char*)g.A + (size_t)cur.pm * tstepA; const char* cB = (const char*)g.Bt + (size_t)cur.pn * tstepB;
    S.a_ready(cur);
    if constexpr (SP2) {
        PG8_STAGE(PG8_SB(0, 0), cB, voffB); PG8_STAGE(PG8_SB(0, 1), cB + hstepB, voffB); PG8_STAGE(PG8_SA(0, 0), cA, voffA); PG8_STAGE(PG8_SA(0, 1), cA + hstepA, voffA);
        if (wr == 1) PG8_BAR;
        PG8_WAIT_V(2); PG8_BAR;
        PG8_STAGE(PG8_SB(1, 0), cB + kstep, voffB); PG8_STAGE(PG8_SA(1, 0), cA + kstep, voffA); PG8_STAGE(PG8_SB(1, 1), cB + hstepB + kstep, voffB);
        PG8_WAIT_V(6); PG8_BAR;
    } else {
        PG8_STAGE(PG8_SB(0, 0), cB, voffB); PG8_STAGE(PG8_SA(0, 0), cA, voffA); PG8_STAGE(PG8_SB(0, 1), cB + hstepB, voffB); PG8_STAGE(PG8_SA(0, 1), cA + hstepA, voffA);
        if (wr == 1) PG8_BAR;
        PG8_WAIT_V(4); PG8_BAR;
        PG8_STAGE(PG8_SB(1, 0), cB + kstep, voffB); PG8_STAGE(PG8_SA(1, 0), cA + kstep, voffA); PG8_STAGE(PG8_SB(1, 1), cB + hstepB + kstep, voffB);
        PG8_WAIT_V(6); PG8_BAR;
    }
    for (;;) {
        const bool has_next = S.next(ui + 1, nxt);
        const char* nA = has_next ? (const char*)g.A + (size_t)nxt.pm * tstepA : cA; const char* nB = has_next ? (const char*)g.Bt + (size_t)nxt.pn * tstepB : cB;
        for (int t = 0; t < nt; t += 2) {
            if constexpr (Epi::HAS_MID) { if (t != 0 && (t & 7) == 0) E.mid(acc, cur, t >> 3, wr, wc, fr, fq); }
            const bool last = (t == nt - 2);
            const char* a1 = cA + (size_t)(t + 1) * kstep;
            const char* a2 = last ? nA : cA + (size_t)(t + 2) * kstep; const char* b2 = last ? nB : cB + (size_t)(t + 2) * kstep;
            const char* a3 = a2 + kstep; const char* b3 = b2 + kstep;
            if (last && has_next) S.a_ready(nxt);
            if constexpr (SP2) {
            PG8_LDB(B0, 0, 0); PG8_LDB(B1, 0, 1); PG8_SCHED; PG8_LDA(At, 0, 0); PG8_STAGE(PG8_SA(1, 1), a1 + hstepA, voffA);
            PG8_WAIT_V(8); PG8_WAIT_L(0); PG8_BAR; PG8_MMA(0, 0, At, B0); PG8_MMA(0, 1, At, B1); PG8_BAR; PG8_SCHED;
            PG8_LDA(At, 0, 1); PG8_STAGE(PG8_SB(0, 0), b2, voffB); PG8_STAGE(PG8_SB(0, 1), b2 + hstepB, voffB); PG8_STAGE(PG8_SA(0, 0), a2, voffA);
            PG8_WAIT_V(8); PG8_WAIT_L(0); PG8_BAR; PG8_MMA(1, 0, At, B0); PG8_MMA(1, 1, At, B1); PG8_BAR; PG8_SCHED;
            PG8_LDB(B0, 1, 0); PG8_LDB(B1, 1, 1); PG8_SCHED; PG8_LDA(At, 1, 0); PG8_STAGE(PG8_SA(0, 1), a2 + hstepA, voffA);
            PG8_WAIT_V(8); PG8_WAIT_L(0); PG8_BAR; PG8_MMA(0, 0, At, B0); PG8_MMA(0, 1, At, B1); PG8_BAR; PG8_SCHED;
            PG8_LDA(At, 1, 1); PG8_STAGE(PG8_SB(1, 0), b3, voffB); PG8_STAGE(PG8_SB(1, 1), b3 + hstepB, voffB); PG8_STAGE(PG8_SA(1, 0), a3, voffA);
            PG8_WAIT_V(8); PG8_WAIT_L(0); PG8_BAR; PG8_MMA(1, 0, At, B0); PG8_MMA(1, 1, At, B1); PG8_BAR; PG8_SCHED;
            } else {
            PG8_LDB(B0, 0, 0); PG8_SCHED; PG8_LDA(At, 0, 0); PG8_STAGE(PG8_SA(1, 1), a1 + hstepA, voffA);
            PG8_WAIT_L(8); PG8_BAR; PG8_WAIT_L(0); PG8_MMA(0, 0, At, B0); PG8_BAR; PG8_SCHED;
            PG8_LDB(B1, 0, 1); PG8_STAGE(PG8_SB(0, 0), b2, voffB);
            PG8_BAR; PG8_WAIT_L(0); PG8_MMA(0, 1, At, B1); PG8_BAR;
            PG8_LDA(At, 0, 1); PG8_STAGE(PG8_SA(0, 0), a2, voffA);
            PG8_BAR; PG8_WAIT_L(0); PG8_MMA(1, 0, At, B0); PG8_BAR; PG8_SCHED;
            PG8_STAGE(PG8_SB(0, 1), b2 + hstepB, voffB);
            PG8_WAIT_V(6); PG8_BAR; PG8_MMA(1, 1, At, B1); PG8_BAR;
            PG8_LDB(B0, 1, 0); PG8_SCHED; PG8_LDA(At, 1, 0); PG8_STAGE(PG8_SA(0, 1), a2 + hstepA, voffA);
            PG8_WAIT_L(8); PG8_BAR; PG8_WAIT_L(0); PG8_MMA(0, 0, At, B0); PG8_BAR; PG8_SCHED;
            PG8_LDB(B1, 1, 1); PG8_STAGE(PG8_SB(1, 0), b3, voffB);
            PG8_BAR; PG8_WAIT_L(0); PG8_MMA(0, 1, At, B1); PG8_BAR;
            PG8_LDA(At, 1, 1); PG8_STAGE(PG8_SA(1, 0), a3, voffA);
            PG8_BAR; PG8_WAIT_L(0); PG8_MMA(1, 0, At, B0); PG8_BAR; PG8_SCHED;
            PG8_STAGE(PG8_SB(1, 1), b3 + hstepB, voffB);
            PG8_WAIT_V(6); PG8_BAR; PG8_MMA(1, 1, At, B1); PG8_BAR;
            }
        }
        if constexpr (ALIGN_EPI) { if (wr == 0) PG8_BAR; }
        if constexpr (!Epi::AFTER_DRAIN) { E(acc, cur, wr, wc, fr, fq); S.done(cur); }
        if (!has_next) break;
#pragma unroll
        for (int a = 0; a < 2; ++a)
#pragma unroll
            for (int b = 0; b < 2; ++b)
#pragma unroll
                for (int m = 0; m < 4; ++m)
#pragma unroll
                    for (int n = 0; n < 2; ++n) acc[a][b][m][n] = (f32x4){0.f, 0.f, 0.f, 0.f};
        cur = nxt; cA = nA; cB = nB; ++ui;
        if constexpr (ALIGN_EPI) { if (wr == 1) PG8_BAR; }
    }
    PG8_WAIT_V(0);
    if constexpr (!ALIGN_EPI) { if (wr == 0) PG8_BAR; }
    PG8_BAR;
    if constexpr (Epi::AFTER_DRAIN) { E.fused(acc, cur, wr, wc, fr, fq, lds, wid, lane); S.done(cur); }
#undef PG8_SA
#undef PG8_SB
#undef PG8_STAGE
#undef PG8_LDA
#undef PG8_LDB
#undef PG8_MMA
#undef PG8_WAIT_V
#undef PG8_WAIT_L
#undef PG8_BAR
#undef PG8_SCHED
}
}
constexpr int NWAVES = 8, NTHR = 512;
constexpr int BATCH = 8, SEQ = 2048, DM = 1024, T = BATCH * SEQ, DEPTH = 2, MEML = 256, MEMT = BATCH * MEML;
constexpr int INW = 9632, INWP = 9728, NA = 5632  , MIXW = 3584, GW = 2048, GATEW = 4096;
constexpr float EPS = 1e-6f;
constexpr int MC_CQ = 0, MC_CKV = 256, MC_KR = 384, MC_BG = 512, MC_CG = 1024, MC_XIN = 1536, MC_U = 2048, MC_V = 2560, MC_MQ = 3072;
constexpr size_t MiB = 1u << 20;
constexpr size_t WS_W0 = 1 * MiB, WS_W1 = 275 * MiB;
constexpr size_t WO_WIN = 0, WO_WUQ = 19 * MiB, WO_WUKV = WO_WUQ + 768 * 256 * 2, WO_WBR = WO_WUKV + 1024 * 128 * 2, WO_WOUT = WO_WBR + 4 * MiB, WO_END = WO_WOUT + 2 * MiB;
static_assert(WO_END <= 26 * MiB, "weights");
constexpr size_t WS_SLAB = 35 * MiB, SLAB = 30 * MiB;
constexpr size_t SO_MIX = 0, SO_GATE = 0, SO_Q = 14 * MiB, SO_K = 17 * MiB, SO_VT = 20 * MiB, SO_H = 18 * MiB, SO_MERGED = 18 * MiB, SO_G = 22 * MiB;
constexpr size_t WS_WMEMT = 147 * MiB, WS_MEMN = 151 * MiB, WS_KVRAW = 27 * MiB;
constexpr size_t WS_END = 301 * MiB;
constexpr int LDS_BYTES = 147456;

#define LAS __attribute__((address_space(3)))
typedef unsigned short bf16;
typedef unsigned v4u __attribute__((ext_vector_type(4)));
typedef unsigned v2u __attribute__((ext_vector_type(2)));
typedef float f32x4 __attribute__((ext_vector_type(4)));
typedef short bf16x8 __attribute__((ext_vector_type(8)));
using pg8::cvt_pk_bf16; using pg8::bflo; using pg8::bfhi; using pg8::sigm;

__device__ __forceinline__ float wave_sum(float v) {
#pragma unroll
    for (int o = 1; o < 64; o <<= 1) v += __shfl_xor(v, o);
    return v;
}
__device__ __forceinline__ f32x4 mfma16(bf16x8 a, bf16x8 b, f32x4 c) { return __builtin_amdgcn_mfma_f32_16x16x32_bf16(a, b, c, 0, 0, 0); }
__device__ __forceinline__ bf16x8 as_bf8(v4u v) { return __builtin_bit_cast(bf16x8, v); }

struct Args { const float* in[24]; float* out; unsigned char* ws; int ph_lo, ph_hi; };
struct BV { bf16* MIX; bf16* G; bf16* Q; bf16* K; bf16* Vt; const bf16* kvraw0; const bf16* kvraw1; const int* pos; };

__device__ __forceinline__ void tr_item(const float* W, int K, int N, bf16* WT, int ldt, int coff, int win, LAS float* scr, int item, int lane) {
    const int nblk = N / 32, kb = item / nblk, nb = item % nblk, k0 = 64 * kb, n0 = 32 * nb;
    const int radd = (win && n0 >= 416) ? 96 : 0;
#pragma unroll 8
    for (int i = 0; i < 32; ++i) { const int kk = 2 * i + (lane >> 5); scr[kk * 33 + (lane & 31)] = W[(size_t)(k0 + kk) * N + n0 + (lane & 31)]; }
    asm volatile("s_waitcnt lgkmcnt(0)" ::: "memory");
    const int c = lane & 7;
#pragma unroll
    for (int j = 0; j < 4; ++j) { const int n = (lane >> 3) + 8 * j; const LAS float* s = scr + (8 * c) * 33 + n;
        v4u o; o.x = cvt_pk_bf16(s[0 * 33], s[1 * 33]); o.y = cvt_pk_bf16(s[2 * 33], s[3 * 33]); o.z = cvt_pk_bf16(s[4 * 33], s[5 * 33]); o.w = cvt_pk_bf16(s[6 * 33], s[7 * 33]);
        *(v4u*)(WT + (size_t)(radd + n0 + n) * ldt + coff + k0 + 8 * c) = o; }
    asm volatile("s_waitcnt lgkmcnt(0)" ::: "memory");
}
__device__ __forceinline__ void rms_row(const float* xrow, const float* g, bf16* orow, int lane) {
    const f32x4* xr = (const f32x4*)xrow + lane; const f32x4* gr = (const f32x4*)g + lane;
    f32x4 v[4]; float s = 0.f;
#pragma unroll
    for (int j = 0; j < 4; ++j) { v[j] = xr[64 * j]; s += (v[j].x * v[j].x + v[j].y * v[j].y) + (v[j].z * v[j].z + v[j].w * v[j].w); }
    const float rstd = 1.0f / sqrtf(wave_sum(s) * (1.f / 1024.f) + EPS);
    v2u* o8 = (v2u*)orow + lane;
#pragma unroll
    for (int j = 0; j < 4; ++j) { const f32x4 gg = gr[64 * j]; v2u o; o.x = cvt_pk_bf16(v[j].x * rstd * gg.x, v[j].y * rstd * gg.y); o.y = cvt_pk_bf16(v[j].z * rstd * gg.z, v[j].w * rstd * gg.w); o8[64 * j] = o; }
}
__device__ __forceinline__ void norm_rows(const float* x, const float* g, bf16* H, int rows, int bid, int nb) {
    const int tid = pg8::opaque_tid(), lane = tid & 63, gw = bid * NWAVES + (tid >> 6), ngw = nb * NWAVES;
    const f32x4* gr = (const f32x4*)g + lane;
    for (int m = gw; m < rows; m += 2 * ngw) {
        const int m2 = m + ngw; const bool has2 = m2 < rows;
        const f32x4* xa = (const f32x4*)(x + (size_t)m * DM) + lane; const f32x4* xb = (const f32x4*)(x + (size_t)(has2 ? m2 : m) * DM) + lane;
        f32x4 va[4], vb[4]; float sa = 0.f, sb = 0.f;
#pragma unroll
        for (int j = 0; j < 4; ++j) { va[j] = xa[64 * j]; vb[j] = xb[64 * j]; }
#pragma unroll
        for (int j = 0; j < 4; ++j) { sa += (va[j].x * va[j].x + va[j].y * va[j].y) + (va[j].z * va[j].z + va[j].w * va[j].w); sb += (vb[j].x * vb[j].x + vb[j].y * vb[j].y) + (vb[j].z * vb[j].z + vb[j].w * vb[j].w); }
        const float ra = 1.0f / sqrtf(wave_sum(sa) * (1.f / 1024.f) + EPS), rb = 1.0f / sqrtf(wave_sum(sb) * (1.f / 1024.f) + EPS);
        v2u* oa = (v2u*)(H + (size_t)m * DM) + lane; v2u* ob = (v2u*)(H + (size_t)m2 * DM) + lane;
#pragma unroll
        for (int j = 0; j < 4; ++j) { const f32x4 gg = gr[64 * j]; v2u o;
            o.x = cvt_pk_bf16(va[j].x * ra * gg.x, va[j].y * ra * gg.y); o.y = cvt_pk_bf16(va[j].z * ra * gg.z, va[j].w * ra * gg.w); oa[64 * j] = o;
            if (has2) { o.x = cvt_pk_bf16(vb[j].x * rb * gg.x, vb[j].y * rb * gg.y); o.y = cvt_pk_bf16(vb[j].z * rb * gg.z, vb[j].w * rb * gg.w); ob[64 * j] = o; } }
    }
}

__device__ __forceinline__ void ph_prologue(const Args& a, LAS unsigned char* lds, int bid, int nb) {
    const int tid = pg8::opaque_tid(), lane = tid & 63, wave = tid >> 6;
    LAS float* scr = (LAS float*)(lds + wave * 16384);
    const int gw = bid * NWAVES + wave, ngw = nb * NWAVES;
    constexpr int I_IN = 16 * 301, I_UQ = 4 * 24, I_UKV = 2 * 32, I_MEM = 16 * 32, I_BR = 8 * 32, I_OUT = 16 * 32;
    constexpr int PER_L = I_IN + I_UQ + I_UKV + I_MEM + 4 * I_BR + I_OUT;
    for (int it0 = gw; it0 < 2 * PER_L; it0 += ngw) {
        const int l = it0 / PER_L; int r = it0 % PER_L;
        unsigned char* wb = a.ws + (l ? WS_W1 : WS_W0);
        if (r < I_IN) { tr_item(a.in[4] + (size_t)l * DM * INW, DM, INW, (bf16*)(wb + WO_WIN), DM, 0, 1, scr, r, lane); continue; } r -= I_IN;
        if (r < I_UQ) { tr_item(a.in[7] + (size_t)l * 256 * 768, 256, 768, (bf16*)(wb + WO_WUQ), 256, 0, 0, scr, r, lane); continue; } r -= I_UQ;
        if (r < I_UKV) { tr_item(a.in[8] + (size_t)l * 128 * 1024, 128, 1024, (bf16*)(wb + WO_WUKV), 128, 0, 0, scr, r, lane); continue; } r -= I_UKV;
        if (r < I_MEM) { tr_item(a.in[18] + (size_t)l * DM * 1024, DM, 1024, (bf16*)(a.ws + WS_WMEMT + l * 2 * MiB), DM, 0, 0, scr, r, lane); continue; } r -= I_MEM;
        if (r < 4 * I_BR) { const int n = r / I_BR; tr_item(a.in[22] + ((size_t)l * 4 + n) * 512 * DM, 512, DM, (bf16*)(wb + WO_WBR), 2048, n * 512, 0, scr, r % I_BR, lane); continue; } r -= 4 * I_BR;
        tr_item(a.in[23] + (size_t)l * DM * DM, DM, DM, (bf16*)(wb + WO_WOUT), DM, 0, 0, scr, r, lane);
    }
    for (int i = bid * NTHR + tid; i < 2 * 96 * 128; i += nb * NTHR) { const int l = i / (96 * 128), r = i % (96 * 128);
        *(v4u*)(a.ws + (l ? WS_W1 : WS_W0) + WO_WIN + (size_t)(416 * 1024) * 2 + (size_t)r * 16) = (v4u){0u, 0u, 0u, 0u}; }
    for (int l = 0; l < 2; ++l) norm_rows(a.in[1], a.in[17] + l * DM, (bf16*)(a.ws + WS_MEMN + l * 4 * MiB), MEMT, bid, nb);
    for (int g = 0; g < BATCH; ++g) norm_rows(a.in[0] + (size_t)g * SEQ * DM, a.in[3], (bf16*)(a.out + (size_t)g * SEQ * DM), SEQ, bid, nb);
}

__device__ __forceinline__ void ph_p2(const Args& a, const BV& v, int l, LAS unsigned char* lds, int bid, int nb) {
    const int tid = pg8::opaque_tid(), lane = tid & 63, w = tid >> 6;
    const bf16* MIX = v.MIX;
    const unsigned char* wb = a.ws + (l ? WS_W1 : WS_W0);
    const bf16* WuqT = (const bf16*)(wb + WO_WUQ); const bf16* WukvT = (const bf16*)(wb + WO_WUKV);
    const float* cqg = a.in[5] + l * 256; const float* ckvg = a.in[6] + l * 128; const float* qg = a.in[9] + l * 96; const float* kg = a.in[10] + l * 96;
    const int* pos = v.pos;
    bf16* Qb = v.Q; bf16* Kb = v.K; bf16* Vtb = v.Vt;
    constexpr int AQ_LD = 264, AKV_LD = 136;
    LAS bf16* Aq = (LAS bf16*)lds; LAS bf16* Akv = (LAS bf16*)(lds + 33792);
    LAS float* kr = (LAS float*)(lds + 51200); LAS float* cs = (LAS float*)(lds + 59392); LAS float* sn = (LAS float*)(lds + 63488);
    const float* cqg0 = cqg; const float* ckvg0 = ckvg; const float* qg0 = qg; const float* kg0 = kg;
    for (int u = bid; u < SEQ / 64; u += nb) {
        const int t0 = u * 64;
        int c16 = lane & 15, q4 = lane >> 4; asm volatile("" : "+v"(c16), "+v"(q4));
        int zo = 0; asm volatile("" : "+s"(zo));
        const float* cqg = cqg0 + zo; const float* ckvg = ckvg0 + zo; const float* qg = qg0 + zo; const float* kg = kg0 + zo;
        __syncthreads();
        {
            const int row = tid >> 3, part = tid & 7;
            const bf16* src = MIX + (size_t)(t0 + row) * MIXW;
            v4u x[4]; float ss = 0.f;
#pragma unroll
            for (int i = 0; i < 4; ++i) { x[i] = *(const v4u*)(src + MC_CQ + part * 32 + i * 8);
                ss += bflo(x[i].x) * bflo(x[i].x) + bfhi(x[i].x) * bfhi(x[i].x) + bflo(x[i].y) * bflo(x[i].y) + bfhi(x[i].y) * bfhi(x[i].y)
                    + bflo(x[i].z) * bflo(x[i].z) + bfhi(x[i].z) * bfhi(x[i].z) + bflo(x[i].w) * bflo(x[i].w) + bfhi(x[i].w) * bfhi(x[i].w); }
            ss += __shfl_xor(ss, 1); ss += __shfl_xor(ss, 2); ss += __shfl_xor(ss, 4);
            float rstd = 1.0f / sqrtf(ss * (1.f / 256.f) + EPS);
#pragma unroll
            for (int i = 0; i < 4; ++i) { const float* gp = cqg + part * 32 + i * 8; v4u o;
                o.x = cvt_pk_bf16(bflo(x[i].x) * rstd * gp[0], bfhi(x[i].x) * rstd * gp[1]); o.y = cvt_pk_bf16(bflo(x[i].y) * rstd * gp[2], bfhi(x[i].y) * rstd * gp[3]);
                o.z = cvt_pk_bf16(bflo(x[i].z) * rstd * gp[4], bfhi(x[i].z) * rstd * gp[5]); o.w = cvt_pk_bf16(bflo(x[i].w) * rstd * gp[6], bfhi(x[i].w) * rstd * gp[7]);
                *(LAS v4u*)(Aq + row * AQ_LD + part * 32 + i * 8) = o; }
            v4u y[2]; ss = 0.f;
#pragma unroll
            for (int i = 0; i < 2; ++i) { y[i] = *(const v4u*)(src + MC_CKV + part * 16 + i * 8);
                ss += bflo(y[i].x) * bflo(y[i].x) + bfhi(y[i].x) * bfhi(y[i].x) + bflo(y[i].y) * bflo(y[i].y) + bfhi(y[i].y) * bfhi(y[i].y)
                    + bflo(y[i].z) * bflo(y[i].z) + bfhi(y[i].z) * bfhi(y[i].z) + bflo(y[i].w) * bflo(y[i].w) + bfhi(y[i].w) * bfhi(y[i].w); }
            ss += __shfl_xor(ss, 1); ss += __shfl_xor(ss, 2); ss += __shfl_xor(ss, 4);
            rstd = 1.0f / sqrtf(ss * (1.f / 128.f) + EPS);
#pragma unroll
            for (int i = 0; i < 2; ++i) { const float* gp = ckvg + part * 16 + i * 8; v4u o;
                o.x = cvt_pk_bf16(bflo(y[i].x) * rstd * gp[0], bfhi(y[i].x) * rstd * gp[1]); o.y = cvt_pk_bf16(bflo(y[i].y) * rstd * gp[2], bfhi(y[i].y) * rstd * gp[3]);
                o.z = cvt_pk_bf16(bflo(y[i].z) * rstd * gp[4], bfhi(y[i].z) * rstd * gp[5]); o.w = cvt_pk_bf16(bflo(y[i].w) * rstd * gp[6], bfhi(y[i].w) * rstd * gp[7]);
                *(LAS v4u*)(Akv + row * AKV_LD + part * 16 + i * 8) = o; }
            const v2u z = *(const v2u*)(src + MC_KR + part * 4);
            kr[row * 32 + part * 4 + 0] = bflo(z.x); kr[row * 32 + part * 4 + 1] = bfhi(z.x); kr[row * 32 + part * 4 + 2] = bflo(z.y); kr[row * 32 + part * 4 + 3] = bfhi(z.y);
#pragma unroll
            for (int i = 0; i < 2; ++i) { const int e = tid * 2 + i, r = e >> 4, f = e & 15;
                const float invf = exp2f(-(float)f * (13.287712379549449f / 16.0f));
                const float ang = (float)pos[t0 + r] * invf; float sv, cv; sincosf(ang, &sv, &cv); cs[e] = cv; sn[e] = sv; }
        }
        __syncthreads();
        const int h = w;
        {
            f32x4 acc[4][6];
#pragma unroll
            for (int mt = 0; mt < 4; ++mt)
#pragma unroll
                for (int nt = 0; nt < 6; ++nt) acc[mt][nt] = (f32x4){0.f, 0.f, 0.f, 0.f};
            const bf16* wq0 = WuqT + (size_t)(h * 96 + c16) * 256 + 8 * q4;
            v4u wf[6], wn[6];
#pragma unroll
            for (int nt = 0; nt < 6; ++nt) wf[nt] = *(const v4u*)(wq0 + nt * 16 * 256);
#pragma unroll 1
            for (int ks = 0; ks < 8; ++ks) {
                if (ks + 1 < 8) {
#pragma unroll
                    for (int nt = 0; nt < 6; ++nt) wn[nt] = *(const v4u*)(wq0 + nt * 16 * 256 + (ks + 1) * 32); }
                bf16x8 tf[4];
#pragma unroll
                for (int mt = 0; mt < 4; ++mt) tf[mt] = as_bf8(*(const LAS v4u*)(Aq + (mt * 16 + c16) * AQ_LD + ks * 32 + 8 * q4));
#pragma unroll
                for (int nt = 0; nt < 6; ++nt)
#pragma unroll
                    for (int mt = 0; mt < 4; ++mt) acc[mt][nt] = mfma16(as_bf8(wf[nt]), tf[mt], acc[mt][nt]);
#pragma unroll
                for (int nt = 0; nt < 6; ++nt) wf[nt] = wn[nt];
            }
#pragma unroll
            for (int mt = 0; mt < 4; ++mt) {
                float ss = 0.f;
#pragma unroll
                for (int nt = 0; nt < 6; ++nt) ss += acc[mt][nt][0] * acc[mt][nt][0] + acc[mt][nt][1] * acc[mt][nt][1] + acc[mt][nt][2] * acc[mt][nt][2] + acc[mt][nt][3] * acc[mt][nt][3];
                ss += __shfl_xor(ss, 16); ss += __shfl_xor(ss, 32);
                const float rstd = 1.0f / sqrtf(ss * (1.f / 96.f) + EPS);
                const int r = mt * 16 + c16, t = t0 + r, b = t >> 11, s = t & 2047;
                bf16* qrow = Qb + ((size_t)(b * 8 + h) * SEQ + s) * 96;
#pragma unroll
                for (int nt = 0; nt < 4; ++nt) { const float* gp = qg + nt * 16 + 4 * q4; v2u o;
                    o.x = cvt_pk_bf16(acc[mt][nt][0] * rstd * gp[0], acc[mt][nt][1] * rstd * gp[1]); o.y = cvt_pk_bf16(acc[mt][nt][2] * rstd * gp[2], acc[mt][nt][3] * rstd * gp[3]);
                    *(v2u*)(qrow + nt * 16 + 4 * q4) = o; }
                float o1[4], o2[4];
#pragma unroll
                for (int j = 0; j < 4; ++j) { const int f = 4 * q4 + j; const float x1 = acc[mt][4][j] * rstd * qg[64 + f], x2 = acc[mt][5][j] * rstd * qg[80 + f];
                    const float cv = cs[r * 16 + f], sv = sn[r * 16 + f]; o1[j] = x1 * cv - x2 * sv; o2[j] = x1 * sv + x2 * cv; }
                v2u p1, p2; p1.x = cvt_pk_bf16(o1[0], o1[1]); p1.y = cvt_pk_bf16(o1[2], o1[3]); p2.x = cvt_pk_bf16(o2[0], o2[1]); p2.y = cvt_pk_bf16(o2[2], o2[3]);
                *(v2u*)(qrow + 64 + 4 * q4) = p1; *(v2u*)(qrow + 80 + 4 * q4) = p2;
            }
        }
        __builtin_amdgcn_sched_barrier(0);
        {
            f32x4 acc[4][4];
#pragma unroll
            for (int mt = 0; mt < 4; ++mt)
#pragma unroll
                for (int nt = 0; nt < 4; ++nt) acc[mt][nt] = (f32x4){0.f, 0.f, 0.f, 0.f};
            const bf16* wk0 = WukvT + (size_t)(h * 128 + c16) * 128 + 8 * q4;
            v4u wf[4], wn[4];
#pragma unroll
            for (int nt = 0; nt < 4; ++nt) wf[nt] = *(const v4u*)(wk0 + nt * 16 * 128);
#pragma unroll 1
            for (int ks = 0; ks < 4; ++ks) {
                if (ks + 1 < 4) {
#pragma unroll
                    for (int nt = 0; nt < 4; ++nt) wn[nt] = *(const v4u*)(wk0 + nt * 16 * 128 + (ks + 1) * 32); }
                bf16x8 tf[4];
#pragma unroll
                for (int mt = 0; mt < 4; ++mt) tf[mt] = as_bf8(*(const LAS v4u*)(Akv + (mt * 16 + c16) * AKV_LD + ks * 32 + 8 * q4));
#pragma unroll
                for (int nt = 0; nt < 4; ++nt)
#pragma unroll
                    for (int mt = 0; mt < 4; ++mt) acc[mt][nt] = mfma16(as_bf8(wf[nt]), tf[mt], acc[mt][nt]);
#pragma unroll
                for (int nt = 0; nt < 4; ++nt) wf[nt] = wn[nt];
            }
#pragma unroll
            for (int mt = 0; mt < 4; ++mt) {
                const int r = mt * 16 + c16, t = t0 + r, b = t >> 11, s = t & 2047;
                float kr1[4], kr2[4]; float ss = 0.f;
#pragma unroll
                for (int j = 0; j < 4; ++j) { kr1[j] = kr[r * 32 + 4 * q4 + j]; kr2[j] = kr[r * 32 + 16 + 4 * q4 + j]; ss += kr1[j] * kr1[j] + kr2[j] * kr2[j]; }
#pragma unroll
                for (int nt = 0; nt < 4; ++nt) ss += acc[mt][nt][0] * acc[mt][nt][0] + acc[mt][nt][1] * acc[mt][nt][1] + acc[mt][nt][2] * acc[mt][nt][2] + acc[mt][nt][3] * acc[mt][nt][3];
                ss += __shfl_xor(ss, 16); ss += __shfl_xor(ss, 32);
                const float rstd = 1.0f / sqrtf(ss * (1.f / 96.f) + EPS);
                bf16* krow = Kb + ((size_t)(b * 8 + h) * SEQ + s) * 96;
#pragma unroll
                for (int nt = 0; nt < 4; ++nt) { const float* gp = kg + nt * 16 + 4 * q4; v2u o;
                    o.x = cvt_pk_bf16(acc[mt][nt][0] * rstd * gp[0], acc[mt][nt][1] * rstd * gp[1]); o.y = cvt_pk_bf16(acc[mt][nt][2] * rstd * gp[2], acc[mt][nt][3] * rstd * gp[3]);
                    *(v2u*)(krow + nt * 16 + 4 * q4) = o; }
                float o1[4], o2[4];
#pragma unroll
                for (int j = 0; j < 4; ++j) { const int f = 4 * q4 + j; const float x1 = kr1[j] * rstd * kg[64 + f], x2 = kr2[j] * rstd * kg[80 + f];
                    const float cv = cs[r * 16 + f], sv = sn[r * 16 + f]; o1[j] = x1 * cv - x2 * sv; o2[j] = x1 * sv + x2 * cv; }
                v2u p1, p2; p1.x = cvt_pk_bf16(o1[0], o1[1]); p1.y = cvt_pk_bf16(o1[2], o1[3]); p2.x = cvt_pk_bf16(o2[0], o2[1]); p2.y = cvt_pk_bf16(o2[2], o2[3]);
                *(v2u*)(krow + 64 + 4 * q4) = p1; *(v2u*)(krow + 80 + 4 * q4) = p2;
            }
        }
        __builtin_amdgcn_sched_barrier(0);
        {
            f32x4 acc[4][4];
#pragma unroll
            for (int mt = 0; mt < 4; ++mt)
#pragma unroll
                for (int nt = 0; nt < 4; ++nt) acc[mt][nt] = (f32x4){0.f, 0.f, 0.f, 0.f};
            const bf16* wk0 = WukvT + (size_t)(h * 128 + 64 + c16) * 128 + 8 * q4;
            v4u wf[4], wn[4];
#pragma unroll
            for (int nt = 0; nt < 4; ++nt) wf[nt] = *(const v4u*)(wk0 + nt * 16 * 128);
#pragma unroll 1
            for (int ks = 0; ks < 4; ++ks) {
                if (ks + 1 < 4) {
#pragma unroll
                    for (int nt = 0; nt < 4; ++nt) wn[nt] = *(const v4u*)(wk0 + nt * 16 * 128 + (ks + 1) * 32); }
                bf16x8 tf[4];
#pragma unroll
                for (int mt = 0; mt < 4; ++mt) tf[mt] = as_bf8(*(const LAS v4u*)(Akv + (mt * 16 + c16) * AKV_LD + ks * 32 + 8 * q4));
#pragma unroll
                for (int nt = 0; nt < 4; ++nt)
#pragma unroll
                    for (int mt = 0; mt < 4; ++mt) acc[mt][nt] = mfma16(as_bf8(wf[nt]), tf[mt], acc[mt][nt]);
#pragma unroll
                for (int nt = 0; nt < 4; ++nt) wf[nt] = wn[nt];
            }
#pragma unroll
            for (int mt = 0; mt < 4; ++mt) {
                const int r = mt * 16 + c16, t = t0 + r, b = t >> 11, s = t & 2047;
                bf16* vcol = Vtb + (size_t)(b * 8 + h) * 64 * SEQ + s;
#pragma unroll
                for (int nt = 0; nt < 4; ++nt)
#pragma unroll
                    for (int j = 0; j < 4; ++j) { const int d = nt * 16 + 4 * q4 + j; vcol[(size_t)d * SEQ] = (bf16)(cvt_pk_bf16(acc[mt][nt][j], 0.f) & 0xffffu); }
            }
        }
    }
}
template <int DQK, int DV, bool CAUSAL, bool QNORM>
__device__ __forceinline__ void attn_block(LAS unsigned char* lds, const bf16* Qp, int qpitch, const float* qg, const bf16* Kp, const bf16* Vtp, int vpitch,
                                           int nkt, int row0seq, float scale_log2, bf16* Gp, int gpitch, bool st, const float* kg) {
    constexpr int KS = DQK / 32, DT = DV / 16, KROW = DQK + 8, VROW = 72, KBUF = 64 * KROW * 2, VBUF = DV * VROW * 2;
    constexpr int NKC = 8 * DQK, NVC = 8 * DV, KPT = (NKC + NTHR - 1) / NTHR, VPT = (NVC + NTHR - 1) / NTHR;
    static_assert(2 * KBUF + 2 * VBUF <= 131072, "attention LDS");
    const int tid = pg8::opaque_tid(), lane = tid & 63, w = tid >> 6, c16 = lane & 15, q4 = lane >> 4;
    __syncthreads();
    bf16x8 qf[2][KS];
    {
        v4u raw[2][KS];
#pragma unroll
        for (int qt = 0; qt < 2; ++qt)
#pragma unroll
            for (int ks = 0; ks < KS; ++ks) raw[qt][ks] = *(const v4u*)(Qp + (size_t)(32 * w + 16 * qt + c16) * qpitch + ks * 32 + 8 * q4);
        if (QNORM) {
#pragma unroll
            for (int qt = 0; qt < 2; ++qt) {
                float ss = 0.f;
#pragma unroll
                for (int ks = 0; ks < KS; ++ks) { const v4u x = raw[qt][ks];
                    ss += bflo(x.x) * bflo(x.x) + bfhi(x.x) * bfhi(x.x) + bflo(x.y) * bflo(x.y) + bfhi(x.y) * bfhi(x.y) + bflo(x.z) * bflo(x.z) + bfhi(x.z) * bfhi(x.z) + bflo(x.w) * bflo(x.w) + bfhi(x.w) * bfhi(x.w); }
                ss += __shfl_xor(ss, 16); ss += __shfl_xor(ss, 32);
                const float rstd = 1.0f / sqrtf(ss * (1.f / DQK) + EPS);
#pragma unroll
                for (int ks = 0; ks < KS; ++ks) { const v4u x = raw[qt][ks]; const float* gp = qg + ks * 32 + 8 * q4; v4u o;
                    o.x = cvt_pk_bf16(bflo(x.x) * rstd * gp[0], bfhi(x.x) * rstd * gp[1]); o.y = cvt_pk_bf16(bflo(x.y) * rstd * gp[2], bfhi(x.y) * rstd * gp[3]);
                    o.z = cvt_pk_bf16(bflo(x.z) * rstd * gp[4], bfhi(x.z) * rstd * gp[5]); o.w = cvt_pk_bf16(bflo(x.w) * rstd * gp[6], bfhi(x.w) * rstd * gp[7]);
                    raw[qt][ks] = o; }
            }
        }
#pragma unroll
        for (int qt = 0; qt < 2; ++qt)
#pragma unroll
            for (int ks = 0; ks < KS; ++ks) qf[qt][ks] = as_bf8(raw[qt][ks]);
    }
    v4u kreg[KPT], vreg[VPT];
#define ATT_GLOAD(kt) do { if constexpr (!QNORM) { \
    _Pragma("unroll") for (int i = 0; i < KPT; ++i) { const int ch = tid + i * NTHR; if (ch < NKC) kreg[i] = *(const v4u*)(Kp + (size_t)(kt) * 64 * DQK + (size_t)ch * 8); } \
    _Pragma("unroll") for (int i = 0; i < VPT; ++i) { const int ch = tid + i * NTHR; if (ch < NVC) vreg[i] = *(const v4u*)(Vtp + (size_t)(ch >> 3) * vpitch + (kt) * 64 + (ch & 7) * 8); } \
  } else { \
    _Pragma("unroll") for (int i = 0; i < KPT; ++i) { const int ch = tid + i * NTHR; kreg[i] = *(const v4u*)(Kp + (size_t)((kt) * 64 + (ch >> 4)) * 1024 + (ch & 15) * 8); } \
    _Pragma("unroll") for (int i = 0; i < VPT; ++i) { const int ch = tid + i * NTHR; vreg[i] = *(const v4u*)(Vtp + (size_t)((kt) * 64 + (ch & 63)) * 1024 + (ch >> 6) * 8); } \
  } } while (0)
#define ATT_LSTORE(buf) do { if constexpr (!QNORM) { \
    _Pragma("unroll") for (int i = 0; i < KPT; ++i) { const int ch = tid + i * NTHR; if (ch < NKC) *(LAS v4u*)(lds + (buf) * KBUF + (ch / (DQK / 8)) * (KROW * 2) + (ch % (DQK / 8)) * 16) = kreg[i]; } \
    _Pragma("unroll") for (int i = 0; i < VPT; ++i) { const int ch = tid + i * NTHR; if (ch < NVC) *(LAS v4u*)(lds + 2 * KBUF + (buf) * VBUF + (ch >> 3) * (VROW * 2) + (ch & 7) * 16) = vreg[i]; } \
  } else { \
    _Pragma("unroll") for (int i = 0; i < KPT; ++i) { const int ch = tid + i * NTHR; const v4u x = kreg[i]; \
        float ss = bflo(x.x) * bflo(x.x) + bfhi(x.x) * bfhi(x.x) + bflo(x.y) * bflo(x.y) + bfhi(x.y) * bfhi(x.y) + bflo(x.z) * bflo(x.z) + bfhi(x.z) * bfhi(x.z) + bflo(x.w) * bflo(x.w) + bfhi(x.w) * bfhi(x.w); \
        ss += __shfl_xor(ss, 1); ss += __shfl_xor(ss, 2); ss += __shfl_xor(ss, 4); ss += __shfl_xor(ss, 8); \
        const float rs = 1.0f / sqrtf(ss * (1.f / 128.f) + EPS); const float* gp = kg + (ch & 15) * 8; v4u o; \
        o.x = cvt_pk_bf16(bflo(x.x) * rs * gp[0], bfhi(x.x) * rs * gp[1]); o.y = cvt_pk_bf16(bflo(x.y) * rs * gp[2], bfhi(x.y) * rs * gp[3]); \
        o.z = cvt_pk_bf16(bflo(x.z) * rs * gp[4], bfhi(x.z) * rs * gp[5]); o.w = cvt_pk_bf16(bflo(x.w) * rs * gp[6], bfhi(x.w) * rs * gp[7]); \
        *(LAS v4u*)(lds + (buf) * KBUF + (ch >> 4) * (KROW * 2) + (ch & 15) * 16) = o; } \
    _Pragma("unroll") for (int i = 0; i < VPT; ++i) { const int ch = tid + i * NTHR; const v4u x = vreg[i]; \
        LAS bf16* vd = (LAS bf16*)(lds + 2 * KBUF + (buf) * VBUF) + ((ch >> 6) * 8) * VROW + (ch & 63); \
        vd[0 * VROW] = (bf16)(x.x & 0xffffu); vd[1 * VROW] = (bf16)(x.x >> 16); vd[2 * VROW] = (bf16)(x.y & 0xffffu); vd[3 * VROW] = (bf16)(x.y >> 16); \
        vd[4 * VROW] = (bf16)(x.z & 0xffffu); vd[5 * VROW] = (bf16)(x.z >> 16); vd[6 * VROW] = (bf16)(x.w & 0xffffu); vd[7 * VROW] = (bf16)(x.w >> 16); } \
  } } while (0)
    ATT_GLOAD(0); ATT_LSTORE(0);
    __syncthreads();
    float m_run[2] = {-1e30f, -1e30f}, l_run[2] = {0.f, 0.f};
    f32x4 o[DT][2];
#pragma unroll
    for (int dt = 0; dt < DT; ++dt) { o[dt][0] = (f32x4){0.f, 0.f, 0.f, 0.f}; o[dt][1] = (f32x4){0.f, 0.f, 0.f, 0.f}; }
    const int rw0 = row0seq + 32 * w;
    for (int kt = 0; kt < nkt; ++kt) {
        if (kt + 1 < nkt) ATT_GLOAD(kt + 1);
        const int k0 = kt * 64;
        const bool active = !CAUSAL || (k0 <= rw0 + 31);
        if (active) {
            const LAS unsigned char* kb = lds + (kt & 1) * KBUF; const LAS unsigned char* vb = lds + 2 * KBUF + (kt & 1) * VBUF;
            f32x4 s[4][2];
#pragma unroll
            for (int kk = 0; kk < 4; ++kk) { s[kk][0] = (f32x4){0.f, 0.f, 0.f, 0.f}; s[kk][1] = (f32x4){0.f, 0.f, 0.f, 0.f}; }
#pragma unroll
            for (int kk = 0; kk < 4; ++kk)
#pragma unroll
                for (int ks = 0; ks < KS; ++ks) { const bf16x8 kf = as_bf8(*(const LAS v4u*)(kb + (kk * 16 + c16) * (KROW * 2) + (ks * 32 + 8 * q4) * 2));
                    s[kk][0] = mfma16(kf, qf[0][ks], s[kk][0]); s[kk][1] = mfma16(kf, qf[1][ks], s[kk][1]); }
            const bool needmask = CAUSAL && (k0 + 63 > rw0);
            bf16x8 pf[2][2];
#pragma unroll
            for (int qt = 0; qt < 2; ++qt) {
                const int rowi = rw0 + 16 * qt + c16;
                float tmax = -INFINITY;
#pragma unroll
                for (int kk = 0; kk < 4; ++kk)
#pragma unroll
                    for (int j = 0; j < 4; ++j) { float v = s[kk][qt][j];
                        if (needmask) { const int key = k0 + kk * 16 + 4 * q4 + j; v = (key > rowi) ? -INFINITY : v; }
                        s[kk][qt][j] = v; tmax = fmaxf(tmax, v); }
                tmax = fmaxf(tmax, __shfl_xor(tmax, 16)); tmax = fmaxf(tmax, __shfl_xor(tmax, 32));
                const float mnew = fmaxf(m_run[qt], tmax * scale_log2), alpha = __builtin_amdgcn_exp2f(m_run[qt] - mnew);
                m_run[qt] = mnew;
                float psum = 0.f;
#pragma unroll
                for (int kk = 0; kk < 4; ++kk)
#pragma unroll
                    for (int j = 0; j < 4; ++j) { const float p = __builtin_amdgcn_exp2f(__builtin_fmaf(s[kk][qt][j], scale_log2, -mnew)); s[kk][qt][j] = p; psum += p; }
                l_run[qt] = l_run[qt] * alpha + psum;
#pragma unroll
                for (int dt = 0; dt < DT; ++dt) o[dt][qt] = o[dt][qt] * alpha;
#pragma unroll
                for (int kp = 0; kp < 2; ++kp) { v4u pp;
                    pp.x = cvt_pk_bf16(s[2 * kp][qt][0], s[2 * kp][qt][1]); pp.y = cvt_pk_bf16(s[2 * kp][qt][2], s[2 * kp][qt][3]);
                    pp.z = cvt_pk_bf16(s[2 * kp + 1][qt][0], s[2 * kp + 1][qt][1]); pp.w = cvt_pk_bf16(s[2 * kp + 1][qt][2], s[2 * kp + 1][qt][3]);
                    pf[qt][kp] = as_bf8(pp); }
            }
#pragma unroll
            for (int dt = 0; dt < DT; ++dt)
#pragma unroll
                for (int kp = 0; kp < 2; ++kp) {
                    const LAS unsigned char* vp = vb + (dt * 16 + c16) * (VROW * 2) + (32 * kp + 4 * q4) * 2;
                    const v2u a0 = *(const LAS v2u*)vp, a1 = *(const LAS v2u*)(vp + 32);
                    const bf16x8 vf = as_bf8((v4u){a0.x, a0.y, a1.x, a1.y});
                    o[dt][0] = mfma16(vf, pf[0][kp], o[dt][0]); o[dt][1] = mfma16(vf, pf[1][kp], o[dt][1]);
                }
        }
        if (kt + 1 < nkt) ATT_LSTORE((kt + 1) & 1);
        __syncthreads();
    }
#undef ATT_GLOAD
#undef ATT_LSTORE
#pragma unroll
    for (int qt = 0; qt < 2; ++qt) {
        float lt = l_run[qt]; lt += __shfl_xor(lt, 16); lt += __shfl_xor(lt, 32);
        const float inv = 1.0f / lt;
        bf16* gr = Gp + (size_t)(32 * w + 16 * qt + c16) * gpitch + 4 * q4;
#pragma unroll
        for (int dt = 0; dt < DT; ++dt) { const v2u g = *(const v2u*)(gr + dt * 16); v2u r;
            r.x = cvt_pk_bf16(o[dt][qt][0] * inv * bflo(g.x), o[dt][qt][1] * inv * bfhi(g.x)); r.y = cvt_pk_bf16(o[dt][qt][2] * inv * bflo(g.y), o[dt][qt][3] * inv * bfhi(g.y));
            if (st) *(v2u*)(gr + dt * 16) = r; }
    }
}

__device__ __forceinline__ void ph_mla(const BV& v, LAS unsigned char* lds, int bid, int nb, bool st) {
    const bf16* Qb = v.Q; const bf16* Kb = v.K; const bf16* Vtb = v.Vt; bf16* G = v.G;
    const float sc = 0.10206207261596577f * 1.4426950408889634f;
    for (int u = bid; u < 32; u += nb) {
        const int b = 0, h = (u >> 2) & 7, p = u & 3;
        for (int half = 0; half < 2; ++half) {
            const int jb = half ? p : 7 - p;
            const size_t bh = (size_t)(b * 8 + h);
            attn_block<96, 64, true, false>(lds, Qb + (bh * SEQ + 256 * jb) * 96, 96, nullptr, Kb + bh * SEQ * 96, Vtb + bh * 64 * SEQ, SEQ, 4 * (jb + 1), 256 * jb, sc,
                                            G + (size_t)(b * SEQ + 256 * jb) * GW + h * 64, GW, st, nullptr);
        }
    }
}
__device__ __forceinline__ void ph_memattn(const Args& a, const BV& v, int l, LAS unsigned char* lds, int bid, int nb, bool st) {
    const bf16* MIX = v.MIX; bf16* G = v.G;
    const bf16* kvraw = l ? v.kvraw1 : v.kvraw0;
    const float sc = 0.08838834764831845f * 1.4426950408889634f;
    for (int u = bid; u < 32; u += nb) {
        const int tb = u >> 2, h = u & 3, t0 = tb * 256, b = 0;
        attn_block<128, 128, false, true>(lds, MIX + (size_t)t0 * MIXW + MC_MQ + h * 128, MIXW, a.in[19] + l * 128, kvraw + (size_t)(b * 256) * 1024 + h * 128, kvraw + (size_t)(b * 256) * 1024 + 512 + h * 128, 256,
                                          4, 0, sc, G + (size_t)t0 * GW + 3 * 512 + h * 128, GW, st, a.in[20] + l * 128);
    }
}

__device__ __forceinline__ void ph_sg(const Args& a, const BV& v, int l, LAS unsigned char* lds, int bid, int nb, bool st) {
    const int tid = pg8::opaque_tid(), lane = tid & 63, w = tid >> 6, c16 = lane & 15, q4 = lane >> 4;
    const bf16* MIX = v.MIX; bf16* G = v.G;
    const float* lng = a.in[13] + l * 512; const float* lnb = a.in[14] + l * 512; const float* ws_ = a.in[15] + (size_t)l * 4 * 128 * 128; const float* bs = a.in[16] + l * 4 * 128;
    LAS float* stat = (LAS float*)lds; LAS bf16* vT = (LAS bf16*)(lds + 1024); constexpr int VLD = 136;
    for (int u = bid; u < 64; u += nb) {
        const int c = u >> 2, g = u & 3, t0 = c * 128;
        __syncthreads();
        {   const int row = tid >> 2, part = tid & 3; const bf16* src = MIX + (size_t)(t0 + row) * MIXW + MC_V + part * 128;
            float s1 = 0.f, s2 = 0.f;
#pragma unroll 4
            for (int i = 0; i < 16; ++i) { const v4u x = *(const v4u*)(src + i * 8);
                const float f0 = bflo(x.x), f1 = bfhi(x.x), f2 = bflo(x.y), f3 = bfhi(x.y), f4 = bflo(x.z), f5 = bfhi(x.z), f6 = bflo(x.w), f7 = bfhi(x.w);
                s1 += ((f0 + f1) + (f2 + f3)) + ((f4 + f5) + (f6 + f7)); s2 += ((f0 * f0 + f1 * f1) + (f2 * f2 + f3 * f3)) + ((f4 * f4 + f5 * f5) + (f6 * f6 + f7 * f7)); }
            s1 += __shfl_xor(s1, 1); s1 += __shfl_xor(s1, 2); s2 += __shfl_xor(s2, 1); s2 += __shfl_xor(s2, 2);
            const float mean = s1 * (1.f / 512.f), var = fmaxf(s2 * (1.f / 512.f) - mean * mean, 0.f);
            if (part == 0) { stat[row * 2] = mean; stat[row * 2 + 1] = 1.0f / sqrtf(var + EPS); }
        }
        __syncthreads();
        {   const int s = tid & 127, dq = tid >> 7; const bf16* src = MIX + (size_t)(t0 + s) * MIXW + MC_V + g * 128 + dq * 32;
            const float mean = stat[s * 2], rstd = stat[s * 2 + 1];
#pragma unroll
            for (int i = 0; i < 4; ++i) { const v4u x = *(const v4u*)(src + i * 8); const int d0 = dq * 32 + i * 8; const float* gp = lng + g * 128 + d0; const float* bp = lnb + g * 128 + d0;
                float f[8] = {bflo(x.x), bfhi(x.x), bflo(x.y), bfhi(x.y), bflo(x.z), bfhi(x.z), bflo(x.w), bfhi(x.w)};
#pragma unroll
                for (int e = 0; e < 8; ++e) { const float y = (f[e] - mean) * rstd * gp[e] + bp[e]; vT[(d0 + e) * VLD + s] = (bf16)(cvt_pk_bf16(y, 0.f) & 0xffffu); } }
        }
        __syncthreads();
        {   f32x4 acc[8];
#pragma unroll
            for (int nt = 0; nt < 8; ++nt) acc[nt] = (f32x4){0.f, 0.f, 0.f, 0.f};
            const int tt = 16 * w + c16, nks = (w >> 1) + 1;
            const float* wrow = ws_ + ((size_t)g * 128 + tt) * 128;
            for (int ks = 0; ks < nks; ++ks) {
                const int s0 = ks * 32 + 8 * q4;
                const f32x4 w0 = *(const f32x4*)(wrow + s0), w1 = *(const f32x4*)(wrow + s0 + 4);
                float wv[8] = {w0[0], w0[1], w0[2], w0[3], w1[0], w1[1], w1[2], w1[3]};
#pragma unroll
                for (int e = 0; e < 8; ++e) wv[e] = (s0 + e <= tt) ? wv[e] : 0.f;
                v4u wp; wp.x = cvt_pk_bf16(wv[0], wv[1]); wp.y = cvt_pk_bf16(wv[2], wv[3]); wp.z = cvt_pk_bf16(wv[4], wv[5]); wp.w = cvt_pk_bf16(wv[6], wv[7]);
                const bf16x8 bfrag = as_bf8(wp);
#pragma unroll
                for (int nt = 0; nt < 8; ++nt) { const bf16x8 af = as_bf8(*(const LAS v4u*)(vT + (nt * 16 + c16) * VLD + s0)); acc[nt] = mfma16(af, bfrag, acc[nt]); }
            }
            const int t = t0 + tt; const float bias = bs[g * 128 + tt];
            const bf16* up = MIX + (size_t)t * MIXW + MC_U + g * 128 + 4 * q4; bf16* gp = G + (size_t)t * GW + 2 * 512 + g * 128 + 4 * q4;
#pragma unroll
            for (int nt = 0; nt < 8; ++nt) { const v2u uu = *(const v2u*)(up + nt * 16), gg = *(const v2u*)(gp + nt * 16); v2u r;
                r.x = cvt_pk_bf16(bflo(uu.x) * (acc[nt][0] + bias) * bflo(gg.x), bfhi(uu.x) * (acc[nt][1] + bias) * bfhi(gg.x));
                r.y = cvt_pk_bf16(bflo(uu.y) * (acc[nt][2] + bias) * bflo(gg.y), bfhi(uu.y) * (acc[nt][3] + bias) * bfhi(gg.y));
                if (st) *(v2u*)(gp + nt * 16) = r; }
        }
    }
}

__device__ __forceinline__ void ph_conv(const Args& a, const BV& v, int l, int bid, int nb, bool st) {
    const bf16* MIX = v.MIX; bf16* G = v.G;
    const float* cw = a.in[11] + l * 3 * 512; const float* cb = a.in[12] + l * 512;
    for (int idx = bid * NTHR + pg8::opaque_tid(); idx < (SEQ / 4) * 64; idx += nb * NTHR) {
        const int t4 = (idx >> 6) * 4, c = (idx & 63) * 8;
        float w0[8], w1[8], w2[8], bb[8];
#pragma unroll
        for (int e = 0; e < 8; ++e) { w0[e] = cw[c + e]; w1[e] = cw[512 + c + e]; w2[e] = cw[1024 + c + e]; bb[e] = cb[c + e]; }
        v4u cgv[6], xv[6], bgv[4], ggv[4];
#pragma unroll
        for (int r = 0; r < 6; ++r) { const int t = t4 - 2 + r; const bf16* row = MIX + (size_t)(t < 0 ? 0 : t) * MIXW; cgv[r] = *(const v4u*)(row + MC_CG + c); xv[r] = *(const v4u*)(row + MC_XIN + c); }
#pragma unroll
        for (int r = 0; r < 4; ++r) { bgv[r] = *(const v4u*)(MIX + (size_t)(t4 + r) * MIXW + MC_BG + c); ggv[r] = *(const v4u*)(G + (size_t)(t4 + r) * GW + 512 + c); }
        float z[6][8];
#pragma unroll
        for (int r = 0; r < 6; ++r) { const float m = (t4 - 2 + r < 0) ? 0.f : 1.f;
            z[r][0] = m * bflo(cgv[r].x) * bflo(xv[r].x); z[r][1] = m * bfhi(cgv[r].x) * bfhi(xv[r].x); z[r][2] = m * bflo(cgv[r].y) * bflo(xv[r].y); z[r][3] = m * bfhi(cgv[r].y) * bfhi(xv[r].y);
            z[r][4] = m * bflo(cgv[r].z) * bflo(xv[r].z); z[r][5] = m * bfhi(cgv[r].z) * bfhi(xv[r].z); z[r][6] = m * bflo(cgv[r].w) * bflo(xv[r].w); z[r][7] = m * bfhi(cgv[r].w) * bfhi(xv[r].w); }
#pragma unroll
        for (int r = 0; r < 4; ++r) {
            const v4u bg = bgv[r], gg = ggv[r];
            const float bgf[8] = {bflo(bg.x), bfhi(bg.x), bflo(bg.y), bfhi(bg.y), bflo(bg.z), bfhi(bg.z), bflo(bg.w), bfhi(bg.w)};
            const float ggf[8] = {bflo(gg.x), bfhi(gg.x), bflo(gg.y), bfhi(gg.y), bflo(gg.z), bfhi(gg.z), bflo(gg.w), bfhi(gg.w)};
            float y[8];
#pragma unroll
            for (int e = 0; e < 8; ++e) y[e] = bgf[e] * (bb[e] + w0[e] * z[r][e] + w1[e] * z[r + 1][e] + w2[e] * z[r + 2][e]) * ggf[e];
            v4u o; o.x = cvt_pk_bf16(y[0], y[1]); o.y = cvt_pk_bf16(y[2], y[3]); o.z = cvt_pk_bf16(y[4], y[5]); o.w = cvt_pk_bf16(y[6], y[7]);
            if (st) *(v4u*)(G + (size_t)(t4 + r) * GW + 512 + c) = o;
        }
    }
}
#define XB_TMO      128
#define XB_XCNT(j)  (256  + 64 * (j))
#define XB_XSUB(j)  (1280 + 64 * (j))
#define XB_XGEN(j)  (2304 + 64 * (j))
#define XB_TOP      3328
#define XB_TOPGEN   3392
#define XCD_BAR_WORDS 3456
#define XB_SPIN_CAP (1u << 18)

__device__ __forceinline__ unsigned xb_ld(unsigned* p)              { return __hip_atomic_load(p, __ATOMIC_RELAXED, __HIP_MEMORY_SCOPE_AGENT); }
__device__ __forceinline__ unsigned xb_add(unsigned* p, unsigned v) { return __hip_atomic_fetch_add(p, v, __ATOMIC_RELAXED, __HIP_MEMORY_SCOPE_AGENT); }
__device__ __forceinline__ unsigned xb_xcc_id() { return (unsigned)__builtin_amdgcn_s_getreg((3 << 11) | 20) & 0xFu; }
#define XB_SPIN(cond, bar) do { unsigned _sp = 0; while (cond) { __builtin_amdgcn_s_sleep(1); \
    if ((++_sp & 255u) == 0u) { if (xb_ld(&(bar)[XB_TMO])) break; if (_sp > XB_SPIN_CAP) { atomicAdd(&(bar)[XB_TMO], 1u); break; } } } } while (0)

struct XcdBarrier {
    unsigned* bar; unsigned x;
    volatile LAS unsigned* st;
};

__device__ __forceinline__ XcdBarrier xcd_barrier_post(unsigned* bar, volatile LAS unsigned* st) {
    XcdBarrier b; b.bar = bar; b.x = xb_xcc_id(); b.st = st;
    if (threadIdx.x == 0) (void)xb_add(&bar[XB_XCNT(b.x)], 1u);
    return b;
}
__device__ __forceinline__ void xcd_barrier_complete(unsigned* bar, unsigned x, unsigned& nloc, unsigned& nx) {
    const unsigned G = gridDim.x * gridDim.y * gridDim.z;
    unsigned sum, cnt, mine, sp = 0u;
    for (;;) {
        sum = 0u; cnt = 0u; mine = 0u;
#pragma unroll
        for (unsigned j = 0; j < 16; ++j) { const unsigned c = xb_ld(&bar[XB_XCNT(j)]); sum += c; cnt += (c > 0u) ? 1u : 0u; mine = (j == x) ? c : mine; }
        if (sum == G) break;
        __builtin_amdgcn_s_sleep(1);
        if ((++sp & 255u) == 0u) { if (xb_ld(&bar[XB_TMO])) break; if (sp > XB_SPIN_CAP) { atomicAdd(&bar[XB_TMO], 1u); break; } }
    }
    nloc = mine > 0u ? mine : 1u; nx = cnt > 0u ? cnt : 1u;
}

__device__ __forceinline__ void xcd_barrier(const XcdBarrier& b) {
    asm volatile("s_waitcnt vmcnt(0)" ::: "memory");
    __syncthreads();
    if (threadIdx.x == 0) {
        unsigned* bar = b.bar;
        __builtin_amdgcn_s_waitcnt(0);
        unsigned nloc = b.st[0], nx = b.st[1];
        if (nloc == 0u) { xcd_barrier_complete(bar, b.x, nloc, nx); b.st[0] = nloc; b.st[1] = nx; }
        const unsigned old = xb_add(&bar[XB_XSUB(b.x)], 1u);
        const unsigned gen = old / nloc;
        if (old + 1u == (gen + 1u) * nloc) {
            __builtin_amdgcn_fence(__ATOMIC_RELEASE, "agent");
            asm volatile("s_waitcnt vmcnt(0)" ::: "memory");
            const unsigned og = xb_add(&bar[XB_TOP], 1u);
            const unsigned tg = og / nx;
            if (og + 1u == (tg + 1u) * nx) xb_add(&bar[XB_TOPGEN], 1u);
            else XB_SPIN(xb_ld(&bar[XB_TOPGEN]) == tg, bar);
            __builtin_amdgcn_fence(__ATOMIC_ACQUIRE, "agent");
            xb_add(&bar[XB_XGEN(b.x)], 1u);
            asm volatile("s_waitcnt vmcnt(0)" ::: "memory");
        } else {
            XB_SPIN(xb_ld(&bar[XB_XGEN(b.x)]) == gen, bar);
            __builtin_amdgcn_fence(__ATOMIC_ACQUIRE, "agent");
            asm volatile("s_waitcnt vmcnt(0)" ::: "memory");
        }
    }
    __syncthreads();
}

#ifndef MK_PER_PHASE
#define MK_PER_PHASE 0
#endif
constexpr int NPH = 1 + 8 + 7;
__device__ __forceinline__ void group_barrier(unsigned* cnt, unsigned& round) {
    asm volatile("s_waitcnt vmcnt(0)" ::: "memory");
    __syncthreads();
    if (threadIdx.x == 0) {
        __builtin_amdgcn_fence(__ATOMIC_RELEASE, "agent");
        asm volatile("s_waitcnt vmcnt(0)" ::: "memory");
        (void)__hip_atomic_fetch_add(cnt, 1u, __ATOMIC_RELAXED, __HIP_MEMORY_SCOPE_AGENT);
        const unsigned target = (round + 1u) * 32u; unsigned sp = 0u;
        while (__hip_atomic_load(cnt, __ATOMIC_RELAXED, __HIP_MEMORY_SCOPE_AGENT) < target) { __builtin_amdgcn_s_sleep(1); if (++sp > (1u << 24)) break; }
        __builtin_amdgcn_fence(__ATOMIC_ACQUIRE, "agent");
        asm volatile("s_waitcnt vmcnt(0)" ::: "memory");
    }
    __syncthreads();
    ++round;
}

__global__ void __launch_bounds__(NTHR, 2) mk_fwd(Args a) {
    extern __shared__ __attribute__((aligned(16))) unsigned char lds_raw[];
    LAS unsigned char* lds = (LAS unsigned char*)lds_raw;
    cg::grid_group grid = cg::this_grid();
    const int bid = blockIdx.x, nb = gridDim.x;
    const bool real = (a.ph_hi > 0);
    volatile LAS unsigned* MISC = (volatile LAS unsigned*)(lds + 131072);
    if (threadIdx.x < 32) MISC[threadIdx.x] = 0u;
    __syncthreads();
    const XcdBarrier bar = xcd_barrier_post((unsigned*)a.ws + 1024, MISC + 8);
#ifdef DUP_PRO
    ph_prologue(a, lds, bid, nb); __syncthreads();
#endif
    ph_prologue(a, lds, bid, nb);
    if (a.ph_hi < 0) grid.sync();
    xcd_barrier(bar);
    for (int ll = 0; ll < 2; ++ll) {
        pg8::Gemm g2{(const bf16*)(a.ws + WS_MEMN + ll * 4 * MiB), DM, (const bf16*)(a.ws + WS_WMEMT + ll * 2 * MiB), MEMT, 1024, DM};
        pg8::StaticOrder S2; S2.init(MEMT, 1024, nb, (bid + 128 * ll) % nb);
        pg8::EpiAct<0> E2{(bf16*)(a.ws + WS_KVRAW + ll * 4 * MiB), 1024, 1 << 20, nullptr, 0, nullptr};
        pg8::gemm_phase<pg8::EpiAct<0>, pg8::StaticOrder, true, true>(lds, g2, S2, E2);
    }
    xcd_barrier(bar);
    const int g = bid & 7, lb = bid >> 3; constexpr int NLB = 32;
    unsigned* gcnt = (unsigned*)a.ws + 8192 + 64 * g; unsigned round = 0u;
    unsigned char* slab = a.ws + WS_SLAB + (size_t)g * SLAB;
    BV v; v.MIX = (bf16*)(slab + SO_MIX); v.G = (bf16*)(slab + SO_G); v.Q = (bf16*)(slab + SO_Q); v.K = (bf16*)(slab + SO_K); v.Vt = (bf16*)(slab + SO_VT);
    v.kvraw0 = (const bf16*)(a.ws + WS_KVRAW) + (size_t)g * MEML * 1024; v.kvraw1 = (const bf16*)(a.ws + WS_KVRAW + 4 * MiB) + (size_t)g * MEML * 1024; v.pos = (const int*)a.in[2] + g * SEQ;
    bf16* H = (bf16*)(slab + SO_H); bf16* GATE = (bf16*)(slab + SO_GATE); bf16* MERGED = (bf16*)(slab + SO_MERGED);
    float* outg = a.out + (size_t)g * SEQ * DM;
#define GB() group_barrier(gcnt, round)
    for (int l = 0; l < 2; ++l) {
        const unsigned char* wb = a.ws + (l ? WS_W1 : WS_W0);
        const bf16* WinT = (const bf16*)(wb + WO_WIN);
        const float* xl = l ? outg : a.in[0] + (size_t)g * SEQ * DM;
        const bf16* Hl = l ? H : (const bf16*)outg;
        {
            pg8::Gemm gm{Hl, DM, WinT, SEQ, NA, DM};
            pg8::StaticOrder S; S.init(SEQ, NA, NLB, lb);
            pg8::EpiAct<1> E{v.MIX, MIXW, 14, v.G, GW, nullptr};
#ifdef DUP_P1A
            pg8::gemm_phase<pg8::EpiAct<1>, pg8::StaticOrder, true, true>(lds, gm, S, E);
#endif
            pg8::gemm_phase<pg8::EpiAct<1>, pg8::StaticOrder, true, true>(lds, gm, S, E);
        }
        GB();
#ifdef DUP_P2
        ph_p2(a, v, l, lds, lb, NLB);
#endif
        ph_p2(a, v, l, lds, lb, NLB);
        GB();
#ifdef DUP_MLA
        ph_mla(v, lds, lb, NLB, !real);
#endif
#ifdef DUP_MIX3
        ph_memattn(a, v, l, lds, lb, NLB, !real); ph_sg(a, v, l, lds, lb, NLB, !real); ph_conv(a, v, l, lb, NLB, !real);
#endif
        ph_mla(v, lds, lb, NLB, real); ph_memattn(a, v, l, lds, lb, NLB, real); ph_sg(a, v, l, lds, lb, NLB, real); ph_conv(a, v, l, lb, NLB, real);
        GB();
        if (l == 1) { norm_rows(xl, a.in[3] + l * DM, H, SEQ, lb, NLB); GB(); }
        {
            pg8::Gemm gm{Hl, DM, WinT + (size_t)NA * DM, SEQ, GATEW, DM};
            pg8::StaticOrder S; S.init(SEQ, GATEW, NLB, lb);
            pg8::EpiGateQ E{(unsigned char*)GATE, a.in[21] + l * 4096};
#ifdef DUP_P1B
            pg8::gemm_phase<pg8::EpiGateQ, pg8::StaticOrder, true, true>(lds, gm, S, E);
#endif
            pg8::gemm_phase<pg8::EpiGateQ, pg8::StaticOrder, true, true>(lds, gm, S, E);
        }
        GB();
        {
            pg8::Gemm gm{v.G, GW, (const bf16*)(wb + WO_WBR), SEQ, DM, 2048};
            pg8::StaticOrder S; S.init(SEQ, DM, NLB, lb);
            pg8::EpiGate E{(const unsigned char*)GATE, MERGED};
#ifdef DUP_P4
            pg8::gemm_phase<pg8::EpiGate, pg8::StaticOrder, false, true>(lds, gm, S, E);
#endif
            pg8::gemm_phase<pg8::EpiGate, pg8::StaticOrder, false, true>(lds, gm, S, E);
        }
        GB();
        {
            pg8::Gemm gm{MERGED, DM, (const bf16*)(wb + WO_WOUT), SEQ, DM, DM};
            pg8::StaticOrder S; S.init(SEQ, DM, NLB, lb);
#ifdef DUP_P5
            { pg8::EpiRes E0{xl, outg, DM, !real}; pg8::gemm_phase<pg8::EpiRes, pg8::StaticOrder, false, true>(lds, gm, S, E0); }
#endif
            pg8::EpiRes E{xl, outg, DM, real};
            pg8::gemm_phase<pg8::EpiRes, pg8::StaticOrder, false, true>(lds, gm, S, E);
        }
        if (l == 0) { GB(); norm_rows(outg, a.in[3] + DM, H, SEQ, lb, NLB); GB(); }
    }
#undef GB
}

extern "C" void kernel_launch(void* const* d_in, const int* in_sizes, int n_in, void* d_out, int out_size, void* d_ws, size_t ws_size, hipStream_t stream) {
    static int grid = 0;
    if (grid == 0) {
        if (n_in != 24 || out_size != T * DM || ws_size < WS_END) { fprintf(stderr, "kernel_launch: unexpected problem (n_in %d out %d ws %zu)\n", n_in, out_size, ws_size); grid = -1; return; }
        int dev = 0, cus = 0, per_cu = 0;
        hipGetDevice(&dev); hipDeviceGetAttribute(&cus, hipDeviceAttributeMultiprocessorCount, dev);
        if (hipFuncSetAttribute((const void*)mk_fwd, hipFuncAttributeMaxDynamicSharedMemorySize, LDS_BYTES) != hipSuccess) { fprintf(stderr, "kernel_launch: hipFuncSetAttribute failed\n"); grid = -1; return; }
        if (hipOccupancyMaxActiveBlocksPerMultiprocessor(&per_cu, (const void*)mk_fwd, NTHR, LDS_BYTES) != hipSuccess || per_cu < 1) { fprintf(stderr, "kernel_launch: occupancy query says %d\n", per_cu); per_cu = 1; }
        (void)hipGetLastError();
        if (cus < 256) { fprintf(stderr, "kernel_launch: needs 256 CUs, device has %d\n", cus); grid = -1; return; }
        grid = 256;
    }
    if (grid < 0) return;
    if (hipMemsetAsync(d_ws, 0, 65536, stream) != hipSuccess) { fprintf(stderr, "kernel_launch: memset failed\n"); return; }
    Args a{};
    for (int i = 0; i < 24; ++i) a.in[i] = (const float*)d_in[i];
    a.out = (float*)d_out; a.ws = (unsigned char*)d_ws;
    a.ph_lo = 0; a.ph_hi = NPH; void* args[] = {&a};
    hipError_t e = hipLaunchCooperativeKernel((void*)mk_fwd, dim3(grid), dim3(NTHR), args, LDS_BYTES, stream);
    if (e != hipSuccess) fprintf(stderr, "cooperative launch failed: %s (grid %d)\n", hipGetErrorString(e), grid);
}
```

```cpp
#include <hip/hip_runtime.h>
#include <hip/hip_cooperative_groups.h>
#include <cstdio>
#include <cstdint>
namespace cg = cooperative_groups;
namespace pg8 {
#define PG8_LAS __attribute__((address_space(3)))
typedef unsigned short bf16_t;
typedef short bf16x8 __attribute__((ext_vector_type(8)));
typedef float f32x4 __attribute__((ext_vector_type(4)));
typedef unsigned u32x4 __attribute__((ext_vector_type(4)));
constexpr int BM = 256, BK = 64, HALF = 128, HTB = HALF * BK * 2  , STAGE_BYTES = 8 * HTB, NXCD = 8, WGM = 8;

__host__ __device__ __forceinline__ int lds_byte(int r, int c) { const int st = (r >> 4) * 2 + (c >> 5), rr = r & 15, cc = c & 31, ob = rr * 64 + cc * 2; return st * 1024 + (ob ^ (((ob >> 9) & 1) << 5)); }
__host__ __device__ __forceinline__ void stage_rc(int b, int& R, int& C) { const int st = b / 1024, sb = b % 1024, swz = sb ^ (((sb >> 9) & 1) << 5); R = (st >> 1) * 16 + swz / 64; C = (st & 1) * 32 + (swz % 64) / 2; }
__host__ __device__ __forceinline__ int perm32(int rho) { const int n = rho >> 4, i = rho & 15; return 8 * (i >> 2) + 4 * n + (i & 3); }

struct Unit { int pm, pn; };
struct Gemm { const bf16_t* A; int lda; const bf16_t* Bt; int M, N, K; };

struct StaticOrder {
    int nM, nN, nwg, G, c;
    __host__ __device__ void init(int M, int N, int G_, int c_) { nM = M / BM; nN = N / BM; nwg = nM * nN; G = G_; c = c_; }
    __host__ __device__ bool next(int i, Unit& u) const {
        const long L = (long)i * G + c; if (L >= nwg) return false;
        int wgid = (int)L; { const int q = nwg / NXCD, r = nwg % NXCD, xcd = wgid % NXCD, off = wgid / NXCD; wgid = (xcd < r ? xcd * (q + 1) : r * (q + 1) + (xcd - r) * q) + off; }
        const int nig = WGM * nN, gid = wgid / nig, fm = gid * WGM, gsz = (nM - fm) < WGM ? (nM - fm) : WGM;
        u.pm = fm + ((wgid % nig) % gsz); u.pn = (wgid % nig) / gsz; return true;
    }
    __device__ __forceinline__ void a_ready(const Unit&) const {}
    __device__ __forceinline__ void done(const Unit&) const {}
};

__device__ __forceinline__ unsigned cvt_pk_bf16(float lo, float hi) { unsigned r; asm volatile("v_cvt_pk_bf16_f32 %0, %1, %2" : "=v"(r) : "v"(lo), "v"(hi)); return r; }
__device__ __forceinline__ int opaque_tid() { int t = threadIdx.x; asm volatile("" : "+v"(t)); return t; }
__device__ __forceinline__ float bflo(unsigned u) { return __uint_as_float(u << 16); }
__device__ __forceinline__ float bfhi(unsigned u) { return __uint_as_float(u & 0xffff0000u); }
__device__ __forceinline__ float sigm(float x) { return __builtin_amdgcn_rcpf(1.0f + __expf(-x)); }

template <int ACT> struct EpiAct {
    static constexpr bool PERM = true, AFTER_DRAIN = false, HAS_MID = false;
    bf16_t* O0; int ld0; int npn0; bf16_t* O1; int ld1; const float* bias;
    __device__ __forceinline__ void operator()(const f32x4 (&acc)[2][2][4][2], const Unit& u, int wr, int wc, int fr, int fq) const {
        const int row0 = u.pm * BM + wr * 64 + fr;
        const bool second = (u.pn >= npn0);
        bf16_t* base = second ? O1 : O0; const int ld = second ? ld1 : ld0; const int colt = second ? (u.pn - npn0) * BM : u.pn * BM;
        const int col0 = colt + wc * 32 + 8 * fq;
#pragma unroll
        for (int bj = 0; bj < 2; ++bj) {
            f32x4 b0 = (f32x4){0.f, 0.f, 0.f, 0.f}, b1 = b0;
            if (ACT == 2) { b0 = *(const f32x4*)(bias + col0 + bj * HALF); b1 = *(const f32x4*)(bias + col0 + bj * HALF + 4); }
#pragma unroll
            for (int ai = 0; ai < 2; ++ai)
#pragma unroll
                for (int m = 0; m < 4; ++m) {
                    bf16_t* rowp = base + (size_t)(row0 + ai * HALF + m * 16) * ld + col0 + bj * HALF;
                    f32x4 v0 = acc[ai][bj][m][0], v1 = acc[ai][bj][m][1];
                    if (ACT != 0 && second) {
#pragma unroll
                        for (int e = 0; e < 4; ++e) {
                            if (ACT == 1) { v0[e] = v0[e] * sigm(v0[e]); v1[e] = v1[e] * sigm(v1[e]); }
                            if (ACT == 2) { v0[e] = sigm(v0[e] + b0[e]); v1[e] = sigm(v1[e] + b1[e]); }
                        }
                    }
                    u32x4 w; w.x = cvt_pk_bf16(v0[0], v0[1]); w.y = cvt_pk_bf16(v0[2], v0[3]); w.z = cvt_pk_bf16(v1[0], v1[1]); w.w = cvt_pk_bf16(v1[2], v1[3]);
                    *(u32x4*)rowp = w;
                }
        }
    }
};

struct EpiGateQ {
    static constexpr bool PERM = true, AFTER_DRAIN = false, HAS_MID = false;
    bf16_t* O; const float* bias;
    __device__ __forceinline__ void operator()(const f32x4 (&acc)[2][2][4][2], const Unit& u, int wr, int wc, int fr, int fq) const {
        const int row0 = u.pm * BM + wr * 64 + fr, col0 = u.pn * BM + wc * 32 + 8 * fq;
        const float nl2e = -1.4426950408889634f;
#pragma unroll
        for (int bj = 0; bj < 2; ++bj) {
            const f32x4 b0 = *(const f32x4*)(bias + col0 + bj * HALF) * nl2e, b1 = *(const f32x4*)(bias + col0 + bj * HALF + 4) * nl2e;
#pragma unroll
            for (int ai = 0; ai < 2; ++ai)
#pragma unroll
                for (int m = 0; m < 4; ++m) {
                    const f32x4 t0 = acc[ai][bj][m][0] * nl2e + b0, t1 = acc[ai][bj][m][1] * nl2e + b1;
                    float e0[4], e1[4];
#pragma unroll
                    for (int e = 0; e < 4; ++e) { e0[e] = 1.0f + __builtin_amdgcn_exp2f(fminf(t0[e], 100.0f)); e1[e] = 1.0f + __builtin_amdgcn_exp2f(fminf(t1[e], 100.0f)); }
                    u32x4 w; w.x = cvt_pk_bf16(e0[0], e0[1]); w.y = cvt_pk_bf16(e0[2], e0[3]); w.z = cvt_pk_bf16(e1[0], e1[1]); w.w = cvt_pk_bf16(e1[2], e1[3]);
                    *(u32x4*)(O + (size_t)(row0 + ai * HALF + m * 16) * 4096 + col0 + bj * HALF) = w;
                }
        }
    }
};

struct EpiGate {
    static constexpr bool PERM = true, AFTER_DRAIN = false, HAS_MID = true;
    const bf16_t* GATE; bf16_t* O;
    __device__ __forceinline__ void mid(f32x4 (&acc)[2][2][4][2], const Unit& u, int nb, int wr, int wc, int fr_, int fq_) const {
        int fr = fr_, fq = fq_; asm volatile("" : "+v"(fr), "+v"(fq));
        const int row0 = u.pm * BM + wr * 64 + fr, col0 = u.pn * BM + wc * 32 + 8 * fq;
#pragma unroll
        for (int ai = 0; ai < 2; ++ai)
#pragma unroll
            for (int bj = 0; bj < 2; ++bj) {
                u32x4 ga[4], gb[4];
#pragma unroll
                for (int m = 0; m < 4; ++m) { const bf16_t* gp = GATE + (size_t)(row0 + ai * HALF + m * 16) * 4096 + (nb - 1) * 1024 + col0 + bj * HALF; ga[m] = *(const u32x4*)gp; gb[m] = *(const u32x4*)(gp + 1024); }
                __builtin_amdgcn_sched_barrier(0);
#pragma unroll
                for (int m = 0; m < 4; ++m) { const u32x4 a = ga[m], b = gb[m];
                    f32x4 r0, r1;
                    r0[0] = bflo(b.x) * __builtin_amdgcn_rcpf(bflo(a.x)); r0[1] = bfhi(b.x) * __builtin_amdgcn_rcpf(bfhi(a.x));
                    r0[2] = bflo(b.y) * __builtin_amdgcn_rcpf(bflo(a.y)); r0[3] = bfhi(b.y) * __builtin_amdgcn_rcpf(bfhi(a.y));
                    r1[0] = bflo(b.z) * __builtin_amdgcn_rcpf(bflo(a.z)); r1[1] = bfhi(b.z) * __builtin_amdgcn_rcpf(bfhi(a.z));
                    r1[2] = bflo(b.w) * __builtin_amdgcn_rcpf(bflo(a.w)); r1[3] = bfhi(b.w) * __builtin_amdgcn_rcpf(bfhi(a.w));
                    acc[ai][bj][m][0] = acc[ai][bj][m][0] * r0; acc[ai][bj][m][1] = acc[ai][bj][m][1] * r1; }
                __builtin_amdgcn_sched_barrier(0);
            }
    }
    __device__ __forceinline__ void operator()(const f32x4 (&acc)[2][2][4][2], const Unit& u, int wr, int wc, int fr, int fq) const {
        const int row0 = u.pm * BM + wr * 64 + fr, col0 = u.pn * BM + wc * 32 + 8 * fq;
#pragma unroll
        for (int ai = 0; ai < 2; ++ai)
#pragma unroll
            for (int bj = 0; bj < 2; ++bj) {
                u32x4 ga[4];
#pragma unroll
                for (int m = 0; m < 4; ++m) ga[m] = *(const u32x4*)(GATE + (size_t)(row0 + ai * HALF + m * 16) * 4096 + 3 * 1024 + col0 + bj * HALF);
                __builtin_amdgcn_sched_barrier(0);
#pragma unroll
                for (int m = 0; m < 4; ++m) { const u32x4 a = ga[m]; const f32x4 v0 = acc[ai][bj][m][0], v1 = acc[ai][bj][m][1];
                    u32x4 w; w.x = cvt_pk_bf16(v0[0] * __builtin_amdgcn_rcpf(bflo(a.x)), v0[1] * __builtin_amdgcn_rcpf(bfhi(a.x))); w.y = cvt_pk_bf16(v0[2] * __builtin_amdgcn_rcpf(bflo(a.y)), v0[3] * __builtin_amdgcn_rcpf(bfhi(a.y)));
                    w.z = cvt_pk_bf16(v1[0] * __builtin_amdgcn_rcpf(bflo(a.z)), v1[1] * __builtin_amdgcn_rcpf(bfhi(a.z))); w.w = cvt_pk_bf16(v1[2] * __builtin_amdgcn_rcpf(bflo(a.w)), v1[3] * __builtin_amdgcn_rcpf(bfhi(a.w)));
                    *(u32x4*)(O + (size_t)(row0 + ai * HALF + m * 16) * 1024 + col0 + bj * HALF) = w; }
                __builtin_amdgcn_sched_barrier(0);
            }
    }
};

struct EpiRes {
    static constexpr bool PERM = false, AFTER_DRAIN = false, HAS_MID = false;
    const float* base; float* out; int ldc; bool st;
    __device__ __forceinline__ void operator()(const f32x4 (&acc)[2][2][4][2], const Unit& u, int wr, int wc, int fr, int fq) const {
        const int row0 = u.pm * BM + wr * 64 + fr, col0 = u.pn * BM + wc * 32 + 4 * fq;
#pragma unroll
        for (int ai = 0; ai < 2; ++ai)
#pragma unroll
            for (int m = 0; m < 4; ++m)
#pragma unroll
                for (int bj = 0; bj < 2; ++bj)
#pragma unroll
                    for (int n = 0; n < 2; ++n) {
                        const size_t o = (size_t)(row0 + ai * HALF + m * 16) * ldc + col0 + bj * HALF + 16 * n;
                        const f32x4 x = *(const f32x4*)(base + o);
                        if (st) *(f32x4*)(out + o) = x + acc[ai][bj][m][n];
                    }
    }
};
template <class Epi, class Sched, bool ALIGN_EPI = false, bool SP2 = false>
__device__ __forceinline__ void gemm_phase(PG8_LAS unsigned char* lds, const Gemm g, const Sched& S, const Epi& E) {
    const int tid = pg8::opaque_tid(), wid = __builtin_amdgcn_readfirstlane(tid >> 6), lane = tid & 63, wr = wid >> 2, wc = wid & 3, fr = lane & 15, fq = lane >> 4;
    const int K = g.K, nt = K / BK;
    unsigned voffA[2], voffB[2];
#pragma unroll
    for (int i = 0; i < 2; ++i) { int R, C; stage_rc(tid * 16 + i * 8192, R, C); const int Rb = Epi::PERM ? ((R & ~31) + perm32(R & 31)) : R;
        voffA[i] = (unsigned)(R * g.lda + C) * 2u; voffB[i] = (unsigned)(Rb * K + C) * 2u; }
    const size_t kstep = (size_t)(BK * 2);
    const size_t hstepA = (size_t)HALF * g.lda * 2, hstepB = (size_t)HALF * K * 2;
    const size_t tstepA = 2 * hstepA, tstepB = 2 * hstepB;
    const unsigned ldsw = (unsigned)wid * 1024u;
    const int aoff = lds_byte(wr * 64 + fr, fq * 8), boff = lds_byte(wc * 32 + fr, fq * 8);
#define PG8_SA(b, h) (((b) * 2 + (h)) * HTB)
#define PG8_SB(b, h) ((4 + (b) * 2 + (h)) * HTB)
#define PG8_STAGE(bufoff, gbase, voff) do { _Pragma("unroll") for (int _i = 0; _i < 2; ++_i) \
        __builtin_amdgcn_global_load_lds((const unsigned*)((const char*)(gbase) + (voff)[_i]), (PG8_LAS unsigned*)(lds + (bufoff) + ldsw + _i * 8192), 16, 0, 0); } while (0)
#define PG8_LDA(dst, b, h) do { _Pragma("unroll") for (int m = 0; m < 4; ++m) _Pragma("unroll") for (int k = 0; k < 2; ++k) dst[m][k] = *(const PG8_LAS bf16x8*)(lds + PG8_SA(b, h) + aoff + m * 2048 + k * 1024); } while (0)
#define PG8_LDB(dst, b, h) do { _Pragma("unroll") for (int n = 0; n < 2; ++n) _Pragma("unroll") for (int k = 0; k < 2; ++k) dst[n][k] = *(const PG8_LAS bf16x8*)(lds + PG8_SB(b, h) + boff + n * 2048 + k * 1024); } while (0)
#define PG8_MMA(ai, bj, At, Bt) do { __builtin_amdgcn_s_setprio(1); _Pragma("unroll") for (int m = 0; m < 4; ++m) _Pragma("unroll") for (int n = 0; n < 2; ++n) _Pragma("unroll") for (int k = 0; k < 2; ++k) \
        acc[ai][bj][m][n] = __builtin_amdgcn_mfma_f32_16x16x32_bf16(Bt[n][k], At[m][k], acc[ai][bj][m][n], 0, 0, 0); __builtin_amdgcn_s_setprio(0); } while (0)
#define PG8_WAIT_V(n) asm volatile("s_waitcnt vmcnt(" #n ")" ::: "memory")
#define PG8_WAIT_L(n) asm volatile("s_waitcnt lgkmcnt(" #n ")" ::: "memory")
#define PG8_BAR __builtin_amdgcn_s_barrier()
#define PG8_SCHED __builtin_amdgcn_sched_barrier(0)
    Unit cur, nxt; int ui = 0;
    if (!S.next(0, cur)) return;
    f32x4 acc[2][2][4][2];
#pragma unroll
    for (int a = 0; a < 2; ++a)
#pragma unroll
        for (int b = 0; b < 2; ++b)
#pragma unroll
            for (int m = 0; m < 4; ++m)
#pragma unroll
                for (int n = 0; n < 2; ++n) acc[a][b][m][n] = (f32x4){0.f, 0.f, 0.f, 0.f};
    bf16x8 At[4][2], B0[2][2], B1[2][2];
    const char* cA = (const char*)g.A + (size_t)cur.pm * tstepA; const char* cB = (const char*)g.Bt + (size_t)cur.pn * tstepB;
    S.a_ready(cur);
    if constexpr (SP2) {
        PG8_STAGE(PG8_SB(0, 0), cB, voffB); PG8_STAGE(PG8_SB(0, 1), cB + hstepB, voffB); PG8_STAGE(PG8_SA(0, 0), cA, voffA); PG8_STAGE(PG8_SA(0, 1), cA + hstepA, voffA);
        if (wr == 1) PG8_BAR;
        PG8_WAIT_V(2); PG8_BAR;
        PG8_STAGE(PG8_SB(1, 0), cB + kstep, voffB); PG8_STAGE(PG8_SA(1, 0), cA + kstep, voffA); PG8_STAGE(PG8_SB(1, 1), cB + hstepB + kstep, voffB);
        PG8_WAIT_V(6); PG8_BAR;
    } else {
        PG8_STAGE(PG8_SB(0, 0), cB, voffB); PG8_STAGE(PG8_SA(0, 0), cA, voffA); PG8_STAGE(PG8_SB(0, 1), cB + hstepB, voffB); PG8_STAGE(PG8_SA(0, 1), cA + hstepA, voffA);
        if (wr == 1) PG8_BAR;
        PG8_WAIT_V(4); PG8_BAR;
        PG8_STAGE(PG8_SB(1, 0), cB + kstep, voffB); PG8_STAGE(PG8_SA(1, 0), cA + kstep, voffA); PG8_STAGE(PG8_SB(1, 1), cB + hstepB + kstep, voffB);
        PG8_WAIT_V(6); PG8_BAR;
    }
    for (;;) {
        const bool has_next = S.next(ui + 1, nxt);
        const char* nA = has_next ? (const char*)g.A + (size_t)nxt.pm * tstepA : cA; const char* nB = has_next ? (const char*)g.Bt + (size_t)nxt.pn * tstepB : cB;
        for (int t = 0; t < nt; t += 2) {
            if constexpr (Epi::HAS_MID) { if (t != 0 && (t & 7) == 0) E.mid(acc, cur, t >> 3, wr, wc, fr, fq); }
            const bool last = (t == nt - 2);
            const char* a1 = cA + (size_t)(t + 1) * kstep;
            const char* a2 = last ? nA : cA + (size_t)(t + 2) * kstep; const char* b2 = last ? nB : cB + (size_t)(t + 2) * kstep;
            const char* a3 = a2 + kstep; const char* b3 = b2 + kstep;
            if (last && has_next) S.a_ready(nxt);
            if constexpr (SP2) {
            PG8_LDB(B0, 0, 0); PG8_LDB(B1, 0, 1); PG8_SCHED; PG8_LDA(At, 0, 0); PG8_STAGE(PG8_SA(1, 1), a1 + hstepA, voffA);
            PG8_WAIT_V(8); PG8_WAIT_L(0); PG8_BAR; PG8_MMA(0, 0, At, B0); PG8_MMA(0, 1, At, B1); PG8_BAR; PG8_SCHED;
            PG8_LDA(At, 0, 1); PG8_STAGE(PG8_SB(0, 0), b2, voffB); PG8_STAGE(PG8_SB(0, 1), b2 + hstepB, voffB); PG8_STAGE(PG8_SA(0, 0), a2, voffA);
            PG8_WAIT_V(8); PG8_WAIT_L(0); PG8_BAR; PG8_MMA(1, 0, At, B0); PG8_MMA(1, 1, At, B1); PG8_BAR; PG8_SCHED;
            PG8_LDB(B0, 1, 0); PG8_LDB(B1, 1, 1); PG8_SCHED; PG8_LDA(At, 1, 0); PG8_STAGE(PG8_SA(0, 1), a2 + hstepA, voffA);
            PG8_WAIT_V(8); PG8_WAIT_L(0); PG8_BAR; PG8_MMA(0, 0, At, B0); PG8_MMA(0, 1, At, B1); PG8_BAR; PG8_SCHED;
            PG8_LDA(At, 1, 1); PG8_STAGE(PG8_SB(1, 0), b3, voffB); PG8_STAGE(PG8_SB(1, 1), b3 + hstepB, voffB); PG8_STAGE(PG8_SA(1, 0), a3, voffA);
            PG8_WAIT_V(8); PG8_WAIT_L(0); PG8_BAR; PG8_MMA(1, 0, At, B0); PG8_MMA(1, 1, At, B1); PG8_BAR; PG8_SCHED;
            } else {
            PG8_LDB(B0, 0, 0); PG8_SCHED; PG8_LDA(At, 0, 0); PG8_STAGE(PG8_SA(1, 1), a1 + hstepA, voffA);
            PG8_WAIT_L(8); PG8_BAR; PG8_WAIT_L(0); PG8_MMA(0, 0, At, B0); PG8_BAR; PG8_SCHED;
            PG8_LDB(B1, 0, 1); PG8_STAGE(PG8_SB(0, 0), b2, voffB);
            PG8_BAR; PG8_WAIT_L(0); PG8_MMA(0, 1, At, B1); PG8_BAR;
            PG8_LDA(At, 0, 1); PG8_STAGE(PG8_SA(0, 0), a2, voffA);
            PG8_BAR; PG8_WAIT_L(0); PG8_MMA(1, 0, At, B0); PG8_BAR; PG8_SCHED;
            PG8_STAGE(PG8_SB(0, 1), b2 + hstepB, voffB);
            PG8_WAIT_V(6); PG8_BAR; PG8_MMA(1, 1, At, B1); PG8_BAR;
            PG8_LDB(B0, 1, 0); PG8_SCHED; PG8_LDA(At, 1, 0); PG8_STAGE(PG8_SA(0, 1), a2 + hstepA, voffA);
            PG8_WAIT_L(8); PG8_BAR; PG8_WAIT_L(0); PG8_MMA(0, 0, At, B0); PG8_BAR; PG8_SCHED;
            PG8_LDB(B1, 1, 1); PG8_STAGE(PG8_SB(1, 0), b3, voffB);
            PG8_BAR; PG8_WAIT_L(0); PG8_MMA(0, 1, At, B1); PG8_BAR;
            PG8_LDA(At, 1, 1); PG8_STAGE(PG8_SA(1, 0), a3, voffA);
            PG8_BAR; PG8_WAIT_L(0); PG8_MMA(1, 0, At, B0); PG8_BAR; PG8_SCHED;
            PG8_STAGE(PG8_SB(1, 1), b3 + hstepB, voffB);
            PG8_WAIT_V(6); PG8_BAR; PG8_MMA(1, 1, At, B1); PG8_BAR;
            }
        }
        if constexpr (ALIGN_EPI) { if (wr == 0) PG8_BAR; }
        if constexpr (!Epi::AFTER_DRAIN) { E(acc, cur, wr, wc, fr, fq); S.done(cur); }
        if (!has_next) break;
#pragma unroll
        for (int a = 0; a < 2; ++a)
#pragma unroll
            for (int b = 0; b < 2; ++b)
#pragma unroll
                for (int m = 0; m < 4; ++m)
#pragma unroll
                    for (int n = 0; n < 2; ++n) acc[a][b][m][n] = (f32x4){0.f, 0.f, 0.f, 0.f};
        cur = nxt; cA = nA; cB = nB; ++ui;
        if constexpr (ALIGN_EPI) { if (wr == 1) PG8_BAR; }
    }
    PG8_WAIT_V(0);
    if constexpr (!ALIGN_EPI) { if (wr == 0) PG8_BAR; }
    PG8_BAR;
    if constexpr (Epi::AFTER_DRAIN) { E.fused(acc, cur, wr, wc, fr, fq, lds, wid, lane); S.done(cur); }
#undef PG8_SA
#undef PG8_SB
#undef PG8_STAGE
#undef PG8_LDA
#undef PG8_LDB
#undef PG8_MMA
#undef PG8_WAIT_V
#undef PG8_WAIT_L
#undef PG8_BAR
#undef PG8_SCHED
}
}
constexpr int NWAVES = 8, NTHR = 512;
constexpr int BATCH = 8, SEQ = 2048, DM = 1024, T = BATCH * SEQ, DEPTH = 2, MEML = 256, MEMT = BATCH * MEML;
constexpr int INW = 9632, INWP = 9728, NA = 5632  , MIXW = 3584, GW = 2048, GATEW = 4096;
constexpr float EPS = 1e-6f;
constexpr int MC_CQ = 0, MC_CKV = 256, MC_KR = 384, MC_BG = 512, MC_CG = 1024, MC_XIN = 1536, MC_U = 2048, MC_V = 2560, MC_MQ = 3072;
constexpr size_t MiB = 1u << 20;
constexpr size_t WS_W0 = 1 * MiB, WS_W1 = 275 * MiB;
constexpr size_t WO_WIN = 0, WO_WUQ = 19 * MiB, WO_WUKV = WO_WUQ + 768 * 256 * 2, WO_WBR = WO_WUKV + 1024 * 128 * 2, WO_WOUT = WO_WBR + 4 * MiB, WO_END = WO_WOUT + 2 * MiB;
static_assert(WO_END <= 26 * MiB, "weights");
constexpr size_t WS_SLAB = 35 * MiB, SLAB = 30 * MiB;
constexpr size_t SO_MIX = 0, SO_GATE = 0, SO_Q = 14 * MiB, SO_K = 17 * MiB, SO_VT = 20 * MiB, SO_H = 18 * MiB, SO_MERGED = 18 * MiB, SO_G = 22 * MiB;
constexpr size_t WS_WMEMT = 147 * MiB, WS_MEMN = 151 * MiB, WS_KVRAW = 27 * MiB;
constexpr size_t WS_END = 301 * MiB;
constexpr int LDS_BYTES = 147456;

#define LAS __attribute__((address_space(3)))
typedef unsigned short bf16;
typedef unsigned v4u __attribute__((ext_vector_type(4)));
typedef unsigned v2u __attribute__((ext_vector_type(2)));
typedef float f32x4 __attribute__((ext_vector_type(4)));
typedef short bf16x8 __attribute__((ext_vector_type(8)));
using pg8::cvt_pk_bf16; using pg8::bflo; using pg8::bfhi; using pg8::sigm;

__device__ __forceinline__ float wave_sum(float v) {
#pragma unroll
    for (int o = 1; o < 64; o <<= 1) v += __shfl_xor(v, o);
    return v;
}
__device__ __forceinline__ f32x4 mfma16(bf16x8 a, bf16x8 b, f32x4 c) { return __builtin_amdgcn_mfma_f32_16x16x32_bf16(a, b, c, 0, 0, 0); }
__device__ __forceinline__ bf16x8 as_bf8(v4u v) { return __builtin_bit_cast(bf16x8, v); }

struct Args { const float* in[24]; float* out; unsigned char* ws; int ph_lo, ph_hi; };
struct BV { bf16* MIX; bf16* G; bf16* Q; bf16* K; bf16* Vt; const bf16* kvraw0; const bf16* kvraw1; const int* pos; };

__device__ __forceinline__ void tr_item(const float* W, int K, int N, bf16* WT, int ldt, int coff, int win, LAS float* scr, int item, int lane) {
    const int nblk = N / 32, kb = item / nblk, nb = item % nblk, k0 = 64 * kb, n0 = 32 * nb;
    const int radd = (win && n0 >= 416) ? 96 : 0;
#pragma unroll 8
    for (int i = 0; i < 32; ++i) { const int kk = 2 * i + (lane >> 5); scr[kk * 33 + (lane & 31)] = __builtin_nontemporal_load(&W[(size_t)(k0 + kk) * N + n0 + (lane & 31)]); }
    asm volatile("s_waitcnt lgkmcnt(0)" ::: "memory");
    const int c = lane & 7;
#pragma unroll
    for (int j = 0; j < 4; ++j) { const int n = (lane >> 3) + 8 * j; const LAS float* s = scr + (8 * c) * 33 + n;
        v4u o; o.x = cvt_pk_bf16(s[0 * 33], s[1 * 33]); o.y = cvt_pk_bf16(s[2 * 33], s[3 * 33]); o.z = cvt_pk_bf16(s[4 * 33], s[5 * 33]); o.w = cvt_pk_bf16(s[6 * 33], s[7 * 33]);
        *(v4u*)(WT + (size_t)(radd + n0 + n) * ldt + coff + k0 + 8 * c) = o; }
    asm volatile("s_waitcnt lgkmcnt(0)" ::: "memory");
}
__device__ __forceinline__ void rms_row(const float* xrow, const float* g, bf16* orow, int lane) {
    const f32x4* xr = (const f32x4*)xrow + lane; const f32x4* gr = (const f32x4*)g + lane;
    f32x4 v[4]; float s = 0.f;
#pragma unroll
    for (int j = 0; j < 4; ++j) { v[j] = xr[64 * j]; s += (v[j].x * v[j].x + v[j].y * v[j].y) + (v[j].z * v[j].z + v[j].w * v[j].w); }
    const float rstd = 1.0f / sqrtf(wave_sum(s) * (1.f / 1024.f) + EPS);
    v2u* o8 = (v2u*)orow + lane;
#pragma unroll
    for (int j = 0; j < 4; ++j) { const f32x4 gg = gr[64 * j]; v2u o; o.x = cvt_pk_bf16(v[j].x * rstd * gg.x, v[j].y * rstd * gg.y); o.y = cvt_pk_bf16(v[j].z * rstd * gg.z, v[j].w * rstd * gg.w); o8[64 * j] = o; }
}
template <bool NT = false> __device__ __forceinline__ void norm_rows(const float* x, const float* g, bf16* H, int rows, int bid, int nb) {
    const int tid = pg8::opaque_tid(), lane = tid & 63, gw = bid * NWAVES + (tid >> 6), ngw = nb * NWAVES;
    const f32x4* gr = (const f32x4*)g + lane;
    for (int m = gw; m < rows; m += 2 * ngw) {
        const int m2 = m + ngw; const bool has2 = m2 < rows;
        const f32x4* xa = (const f32x4*)(x + (size_t)m * DM) + lane; const f32x4* xb = (const f32x4*)(x + (size_t)(has2 ? m2 : m) * DM) + lane;
        f32x4 va[4], vb[4]; float sa = 0.f, sb = 0.f;
#pragma unroll
        for (int j = 0; j < 4; ++j) { if (NT) { va[j] = __builtin_nontemporal_load(xa + 64 * j); vb[j] = __builtin_nontemporal_load(xb + 64 * j); } else { va[j] = xa[64 * j]; vb[j] = xb[64 * j]; } }
#pragma unroll
        for (int j = 0; j < 4; ++j) { sa += (va[j].x * va[j].x + va[j].y * va[j].y) + (va[j].z * va[j].z + va[j].w * va[j].w); sb += (vb[j].x * vb[j].x + vb[j].y * vb[j].y) + (vb[j].z * vb[j].z + vb[j].w * vb[j].w); }
        const float ra = 1.0f / sqrtf(wave_sum(sa) * (1.f / 1024.f) + EPS), rb = 1.0f / sqrtf(wave_sum(sb) * (1.f / 1024.f) + EPS);
        v2u* oa = (v2u*)(H + (size_t)m * DM) + lane; v2u* ob = (v2u*)(H + (size_t)m2 * DM) + lane;
#pragma unroll
        for (int j = 0; j < 4; ++j) { const f32x4 gg = gr[64 * j]; v2u o;
            o.x = cvt_pk_bf16(va[j].x * ra * gg.x, va[j].y * ra * gg.y); o.y = cvt_pk_bf16(va[j].z * ra * gg.z, va[j].w * ra * gg.w); oa[64 * j] = o;
            if (has2) { o.x = cvt_pk_bf16(vb[j].x * rb * gg.x, vb[j].y * rb * gg.y); o.y = cvt_pk_bf16(vb[j].z * rb * gg.z, vb[j].w * rb * gg.w); ob[64 * j] = o; } }
    }
}

constexpr int I_IN = 16 * 301, I_UQ = 4 * 24, I_UKV = 2 * 32, I_MEM = 16 * 32, I_BR = 8 * 32, I_OUT = 16 * 32;
constexpr int PER_L = I_IN + I_UQ + I_UKV + I_MEM + 4 * I_BR + I_OUT;
__device__ __forceinline__ void w_item(const Args& a, int l, int r, LAS float* scr, int lane) {
    unsigned char* wb = a.ws + (l ? WS_W1 : WS_W0);
    if (r < I_IN) { tr_item(a.in[4] + (size_t)l * DM * INW, DM, INW, (bf16*)(wb + WO_WIN), DM, 0, 1, scr, r, lane); return; } r -= I_IN;
    if (r < I_UQ) { tr_item(a.in[7] + (size_t)l * 256 * 768, 256, 768, (bf16*)(wb + WO_WUQ), 256, 0, 0, scr, r, lane); return; } r -= I_UQ;
    if (r < I_UKV) { tr_item(a.in[8] + (size_t)l * 128 * 1024, 128, 1024, (bf16*)(wb + WO_WUKV), 128, 0, 0, scr, r, lane); return; } r -= I_UKV;
    if (r < I_MEM) { tr_item(a.in[18] + (size_t)l * DM * 1024, DM, 1024, (bf16*)(a.ws + WS_SLAB + SO_Q + l * 2 * MiB), DM, 0, 0, scr, r, lane); return; } r -= I_MEM;
    if (r < 4 * I_BR) { const int n = r / I_BR; tr_item(a.in[22] + ((size_t)l * 4 + n) * 512 * DM, 512, DM, (bf16*)(wb + WO_WBR), 2048, n * 512, 0, scr, r % I_BR, lane); return; } r -= 4 * I_BR;
    tr_item(a.in[23] + (size_t)l * DM * DM, DM, DM, (bf16*)(wb + WO_WOUT), DM, 0, 0, scr, r, lane);
}
__device__ __forceinline__ void ph_prologue(const Args& a, LAS unsigned char* lds, int bid, int nb) {
    const int tid = pg8::opaque_tid(), lane = tid & 63, wave = tid >> 6;
    LAS float* scr = (LAS float*)(lds + wave * 16384);
    const int gw = bid * NWAVES + wave, ngw = nb * NWAVES;
    for (int it = gw; it < PER_L + I_MEM; it += ngw) {
        if (it < PER_L) w_item(a, 0, it, scr, lane); else w_item(a, 1, I_IN + I_UQ + I_UKV + (it - PER_L), scr, lane);
    }
    for (int i = bid * NTHR + tid; i < 2 * 96 * 128; i += nb * NTHR) { const int l = i / (96 * 128), r = i % (96 * 128);
        *(v4u*)(a.ws + (l ? WS_W1 : WS_W0) + WO_WIN + (size_t)(416 * 1024) * 2 + (size_t)r * 16) = (v4u){0u, 0u, 0u, 0u}; }
    for (int l = 0; l < 2; ++l) norm_rows<true>(a.in[1], a.in[17] + l * DM, (bf16*)(a.ws + WS_SLAB + (size_t)(1 + l) * SLAB + SO_Q), MEMT, bid, nb);
    for (int g = 0; g < BATCH; ++g) norm_rows<true>(a.in[0] + (size_t)g * SEQ * DM, a.in[3], (bf16*)(a.out + (size_t)g * SEQ * DM), SEQ, bid, nb);
}
__device__ __forceinline__ void ph_prologue_b(const Args& a, LAS unsigned char* lds, int bid) {
    const int tid = pg8::opaque_tid(), lane = tid & 63, wave = tid >> 6;
    LAS float* scr = (LAS float*)(lds + wave * 16384);
    if (bid < 32 || (bid >= 128 && bid < 160)) return;
    const int rank = bid < 128 ? bid - 32 : bid - 64;
    for (int it = rank * NWAVES + wave; it < PER_L - I_MEM; it += 192 * NWAVES) {
        int r = it; if (r >= I_IN + I_UQ + I_UKV) r += I_MEM;
        w_item(a, 1, r, scr, lane);
    }
}

__device__ __forceinline__ void ph_p2(const Args& a, const BV& v, int l, LAS unsigned char* lds, int bid, int nb) {
    const int tid = pg8::opaque_tid(), lane = tid & 63, w = tid >> 6;
    const bf16* MIX = v.MIX;
    const unsigned char* wb = a.ws + (l ? WS_W1 : WS_W0);
    const bf16* WuqT = (const bf16*)(wb + WO_WUQ); const bf16* WukvT = (const bf16*)(wb + WO_WUKV);
    const float* cqg = a.in[5] + l * 256; const float* ckvg = a.in[6] + l * 128; const float* qg = a.in[9] + l * 96; const float* kg = a.in[10] + l * 96;
    const int* pos = v.pos;
    bf16* Qb = v.Q; bf16* Kb = v.K; bf16* Vtb = v.Vt;
    constexpr int AQ_LD = 264, AKV_LD = 136;
    LAS bf16* Aq = (LAS bf16*)lds; LAS bf16* Akv = (LAS bf16*)(lds + 33792);
    LAS float* kr = (LAS float*)(lds + 51200); LAS float* cs = (LAS float*)(lds + 59392); LAS float* sn = (LAS float*)(lds + 63488);
    const float* cqg0 = cqg; const float* ckvg0 = ckvg; const float* qg0 = qg; const float* kg0 = kg;
    for (int u = bid; u < SEQ / 64; u += nb) {
        const int t0 = u * 64;
        int c16 = lane & 15, q4 = lane >> 4; asm volatile("" : "+v"(c16), "+v"(q4));
        int zo = 0; asm volatile("" : "+s"(zo));
        const float* cqg = cqg0 + zo; const float* ckvg = ckvg0 + zo; const float* qg = qg0 + zo; const float* kg = kg0 + zo;
        __syncthreads();
        {
            const int row = tid >> 3, part = tid & 7;
            const bf16* src = MIX + (size_t)(t0 + row) * MIXW;
            v4u x[4]; float ss = 0.f;
#pragma unroll
            for (int i = 0; i < 4; ++i) { x[i] = *(const v4u*)(src + MC_CQ + part * 32 + i * 8);
                ss += bflo(x[i].x) * bflo(x[i].x) + bfhi(x[i].x) * bfhi(x[i].x) + bflo(x[i].y) * bflo(x[i].y) + bfhi(x[i].y) * bfhi(x[i].y)
                    + bflo(x[i].z) * bflo(x[i].z) + bfhi(x[i].z) * bfhi(x[i].z) + bflo(x[i].w) * bflo(x[i].w) + bfhi(x[i].w) * bfhi(x[i].w); }
            ss += __shfl_xor(ss, 1); ss += __shfl_xor(ss, 2); ss += __shfl_xor(ss, 4);
            float rstd = 1.0f / sqrtf(ss * (1.f / 256.f) + EPS);
#pragma unroll
            for (int i = 0; i < 4; ++i) { const float* gp = cqg + part * 32 + i * 8; v4u o;
                o.x = cvt_pk_bf16(bflo(x[i].x) * rstd * gp[0], bfhi(x[i].x) * rstd * gp[1]); o.y = cvt_pk_bf16(bflo(x[i].y) * rstd * gp[2], bfhi(x[i].y) * rstd * gp[3]);
                o.z = cvt_pk_bf16(bflo(x[i].z) * rstd * gp[4], bfhi(x[i].z) * rstd * gp[5]); o.w = cvt_pk_bf16(bflo(x[i].w) * rstd * gp[6], bfhi(x[i].w) * rstd * gp[7]);
                *(LAS v4u*)(Aq + row * AQ_LD + part * 32 + i * 8) = o; }
            v4u y[2]; ss = 0.f;
#pragma unroll
            for (int i = 0; i < 2; ++i) { y[i] = *(const v4u*)(src + MC_CKV + part * 16 + i * 8);
                ss += bflo(y[i].x) * bflo(y[i].x) + bfhi(y[i].x) * bfhi(y[i].x) + bflo(y[i].y) * bflo(y[i].y) + bfhi(y[i].y) * bfhi(y[i].y)
                    + bflo(y[i].z) * bflo(y[i].z) + bfhi(y[i].z) * bfhi(y[i].z) + bflo(y[i].w) * bflo(y[i].w) + bfhi(y[i].w) * bfhi(y[i].w); }
            ss += __shfl_xor(ss, 1); ss += __shfl_xor(ss, 2); ss += __shfl_xor(ss, 4);
            rstd = 1.0f / sqrtf(ss * (1.f / 128.f) + EPS);
#pragma unroll
            for (int i = 0; i < 2; ++i) { const float* gp = ckvg + part * 16 + i * 8; v4u o;
                o.x = cvt_pk_bf16(bflo(y[i].x) * rstd * gp[0], bfhi(y[i].x) * rstd * gp[1]); o.y = cvt_pk_bf16(bflo(y[i].y) * rstd * gp[2], bfhi(y[i].y) * rstd * gp[3]);
                o.z = cvt_pk_bf16(bflo(y[i].z) * rstd * gp[4], bfhi(y[i].z) * rstd * gp[5]); o.w = cvt_pk_bf16(bflo(y[i].w) * rstd * gp[6], bfhi(y[i].w) * rstd * gp[7]);
                *(LAS v4u*)(Akv + row * AKV_LD + part * 16 + i * 8) = o; }
            const v2u z = *(const v2u*)(src + MC_KR + part * 4);
            kr[row * 32 + part * 4 + 0] = bflo(z.x); kr[row * 32 + part * 4 + 1] = bfhi(z.x); kr[row * 32 + part * 4 + 2] = bflo(z.y); kr[row * 32 + part * 4 + 3] = bfhi(z.y);
#pragma unroll
            for (int i = 0; i < 2; ++i) { const int e = tid * 2 + i, r = e >> 4, f = e & 15;
                const float invf = exp2f(-(float)f * (13.287712379549449f / 16.0f));
                const float ang = (float)pos[t0 + r] * invf; float sv, cv; sincosf(ang, &sv, &cv); cs[e] = cv; sn[e] = sv; }
        }
        __syncthreads();
        const int h = w;
        {
            f32x4 acc[4][6];
#pragma unroll
            for (int mt = 0; mt < 4; ++mt)
#pragma unroll
                for (int nt = 0; nt < 6; ++nt) acc[mt][nt] = (f32x4){0.f, 0.f, 0.f, 0.f};
            const bf16* wq0 = WuqT + (size_t)(h * 96 + c16) * 256 + 8 * q4;
            v4u wf[6], wn[6];
#pragma unroll
            for (int nt = 0; nt < 6; ++nt) wf[nt] = *(const v4u*)(wq0 + nt * 16 * 256);
#pragma unroll 1
            for (int ks = 0; ks < 8; ++ks) {
                if (ks + 1 < 8) {
#pragma unroll
                    for (int nt = 0; nt < 6; ++nt) wn[nt] = *(const v4u*)(wq0 + nt * 16 * 256 + (ks + 1) * 32); }
                bf16x8 tf[4];
#pragma unroll
                for (int mt = 0; mt < 4; ++mt) tf[mt] = as_bf8(*(const LAS v4u*)(Aq + (mt * 16 + c16) * AQ_LD + ks * 32 + 8 * q4));
#pragma unroll
                for (int nt = 0; nt < 6; ++nt)
#pragma unroll
                    for (int mt = 0; mt < 4; ++mt) acc[mt][nt] = mfma16(as_bf8(wf[nt]), tf[mt], acc[mt][nt]);
#pragma unroll
                for (int nt = 0; nt < 6; ++nt) wf[nt] = wn[nt];
            }
#pragma unroll
            for (int mt = 0; mt < 4; ++mt) {
                float ss = 0.f;
#pragma unroll
                for (int nt = 0; nt < 6; ++nt) ss += acc[mt][nt][0] * acc[mt][nt][0] + acc[mt][nt][1] * acc[mt][nt][1] + acc[mt][nt][2] * acc[mt][nt][2] + acc[mt][nt][3] * acc[mt][nt][3];
                ss += __shfl_xor(ss, 16); ss += __shfl_xor(ss, 32);
                const float rstd = 1.0f / sqrtf(ss * (1.f / 96.f) + EPS);
                const int r = mt * 16 + c16, t = t0 + r, b = t >> 11, s = t & 2047;
                bf16* qrow = Qb + ((size_t)(b * 8 + h) * SEQ + s) * 96;
#pragma unroll
                for (int nt = 0; nt < 4; ++nt) { const float* gp = qg + nt * 16 + 4 * q4; v2u o;
                    o.x = cvt_pk_bf16(acc[mt][nt][0] * rstd * gp[0], acc[mt][nt][1] * rstd * gp[1]); o.y = cvt_pk_bf16(acc[mt][nt][2] * rstd * gp[2], acc[mt][nt][3] * rstd * gp[3]);
                    *(v2u*)(qrow + nt * 16 + 4 * q4) = o; }
                float o1[4], o2[4];
#pragma unroll
                for (int j = 0; j < 4; ++j) { const int f = 4 * q4 + j; const float x1 = acc[mt][4][j] * rstd * qg[64 + f], x2 = acc[mt][5][j] * rstd * qg[80 + f];
                    const float cv = cs[r * 16 + f], sv = sn[r * 16 + f]; o1[j] = x1 * cv - x2 * sv; o2[j] = x1 * sv + x2 * cv; }
                v2u p1, p2; p1.x = cvt_pk_bf16(o1[0], o1[1]); p1.y = cvt_pk_bf16(o1[2], o1[3]); p2.x = cvt_pk_bf16(o2[0], o2[1]); p2.y = cvt_pk_bf16(o2[2], o2[3]);
                *(v2u*)(qrow + 64 + 4 * q4) = p1; *(v2u*)(qrow + 80 + 4 * q4) = p2;
            }
        }
        __builtin_amdgcn_sched_barrier(0);
        {
            f32x4 acc[4][4];
#pragma unroll
            for (int mt = 0; mt < 4; ++mt)
#pragma unroll
                for (int nt = 0; nt < 4; ++nt) acc[mt][nt] = (f32x4){0.f, 0.f, 0.f, 0.f};
            const bf16* wk0 = WukvT + (size_t)(h * 128 + c16) * 128 + 8 * q4;
            v4u wf[4], wn[4];
#pragma unroll
            for (int nt = 0; nt < 4; ++nt) wf[nt] = *(const v4u*)(wk0 + nt * 16 * 128);
#pragma unroll 1
            for (int ks = 0; ks < 4; ++ks) {
                if (ks + 1 < 4) {
#pragma unroll
                    for (int nt = 0; nt < 4; ++nt) wn[nt] = *(const v4u*)(wk0 + nt * 16 * 128 + (ks + 1) * 32); }
                bf16x8 tf[4];
#pragma unroll
                for (int mt = 0; mt < 4; ++mt) tf[mt] = as_bf8(*(const LAS v4u*)(Akv + (mt * 16 + c16) * AKV_LD + ks * 32 + 8 * q4));
#pragma unroll
                for (int nt = 0; nt < 4; ++nt)
#pragma unroll
                    for (int mt = 0; mt < 4; ++mt) acc[mt][nt] = mfma16(as_bf8(wf[nt]), tf[mt], acc[mt][nt]);
#pragma unroll
                for (int nt = 0; nt < 4; ++nt) wf[nt] = wn[nt];
            }
#pragma unroll
            for (int mt = 0; mt < 4; ++mt) {
                const int r = mt * 16 + c16, t = t0 + r, b = t >> 11, s = t & 2047;
                float kr1[4], kr2[4]; float ss = 0.f;
#pragma unroll
                for (int j = 0; j < 4; ++j) { kr1[j] = kr[r * 32 + 4 * q4 + j]; kr2[j] = kr[r * 32 + 16 + 4 * q4 + j]; ss += kr1[j] * kr1[j] + kr2[j] * kr2[j]; }
#pragma unroll
                for (int nt = 0; nt < 4; ++nt) ss += acc[mt][nt][0] * acc[mt][nt][0] + acc[mt][nt][1] * acc[mt][nt][1] + acc[mt][nt][2] * acc[mt][nt][2] + acc[mt][nt][3] * acc[mt][nt][3];
                ss += __shfl_xor(ss, 16); ss += __shfl_xor(ss, 32);
                const float rstd = 1.0f / sqrtf(ss * (1.f / 96.f) + EPS);
                bf16* krow = Kb + ((size_t)(b * 8 + h) * SEQ + s) * 96;
#pragma unroll
                for (int nt = 0; nt < 4; ++nt) { const float* gp = kg + nt * 16 + 4 * q4; v2u o;
                    o.x = cvt_pk_bf16(acc[mt][nt][0] * rstd * gp[0], acc[mt][nt][1] * rstd * gp[1]); o.y = cvt_pk_bf16(acc[mt][nt][2] * rstd * gp[2], acc[mt][nt][3] * rstd * gp[3]);
                    *(v2u*)(krow + nt * 16 + 4 * q4) = o; }
                float o1[4], o2[4];
#pragma unroll
                for (int j = 0; j < 4; ++j) { const int f = 4 * q4 + j; const float x1 = kr1[j] * rstd * kg[64 + f], x2 = kr2[j] * rstd * kg[80 + f];
                    const float cv = cs[r * 16 + f], sv = sn[r * 16 + f]; o1[j] = x1 * cv - x2 * sv; o2[j] = x1 * sv + x2 * cv; }
                v2u p1, p2; p1.x = cvt_pk_bf16(o1[0], o1[1]); p1.y = cvt_pk_bf16(o1[2], o1[3]); p2.x = cvt_pk_bf16(o2[0], o2[1]); p2.y = cvt_pk_bf16(o2[2], o2[3]);
                *(v2u*)(krow + 64 + 4 * q4) = p1; *(v2u*)(krow + 80 + 4 * q4) = p2;
            }
        }
        __builtin_amdgcn_sched_barrier(0);
        {
            f32x4 acc[4][4];
#pragma unroll
            for (int mt = 0; mt < 4; ++mt)
#pragma unroll
                for (int nt = 0; nt < 4; ++nt) acc[mt][nt] = (f32x4){0.f, 0.f, 0.f, 0.f};
            const bf16* wk0 = WukvT + (size_t)(h * 128 + 64 + c16) * 128 + 8 * q4;
            v4u wf[4], wn[4];
#pragma unroll
            for (int nt = 0; nt < 4; ++nt) wf[nt] = *(const v4u*)(wk0 + nt * 16 * 128);
#pragma unroll 1
            for (int ks = 0; ks < 4; ++ks) {
                if (ks + 1 < 4) {
#pragma unroll
                    for (int nt = 0; nt < 4; ++nt) wn[nt] = *(const v4u*)(wk0 + nt * 16 * 128 + (ks + 1) * 32); }
                bf16x8 tf[4];
#pragma unroll
                for (int mt = 0; mt < 4; ++mt) tf[mt] = as_bf8(*(const LAS v4u*)(Akv + (mt * 16 + c16) * AKV_LD + ks * 32 + 8 * q4));
#pragma unroll
                for (int nt = 0; nt < 4; ++nt)
#pragma unroll
                    for (int mt = 0; mt < 4; ++mt) acc[mt][nt] = mfma16(as_bf8(wf[nt]), tf[mt], acc[mt][nt]);
#pragma unroll
                for (int nt = 0; nt < 4; ++nt) wf[nt] = wn[nt];
            }
#pragma unroll
            for (int mt = 0; mt < 4; ++mt) {
                const int r = mt * 16 + c16, t = t0 + r, b = t >> 11, s = t & 2047;
                bf16* vcol = Vtb + (size_t)(b * 8 + h) * 64 * SEQ + s;
#pragma unroll
                for (int nt = 0; nt < 4; ++nt)
#pragma unroll
                    for (int j = 0; j < 4; ++j) { const int d = nt * 16 + 4 * q4 + j; vcol[(size_t)d * SEQ] = (bf16)(cvt_pk_bf16(acc[mt][nt][j], 0.f) & 0xffffu); }
            }
        }
    }
}
template <int DQK, int DV, bool CAUSAL, bool QNORM>
__device__ __forceinline__ void attn_block(LAS unsigned char* lds, const bf16* Qp, int qpitch, const float* qg, const bf16* Kp, const bf16* Vtp, int vpitch,
                                           int nkt, int row0seq, float scale_log2, bf16* Gp, int gpitch, bool st, const float* kg) {
    constexpr int KS = DQK / 32, DT = DV / 16, KROW = DQK + 8, VROW = 72, KBUF = 64 * KROW * 2, VBUF = DV * VROW * 2;
    constexpr int NKC = 8 * DQK, NVC = 8 * DV, KPT = (NKC + NTHR - 1) / NTHR, VPT = (NVC + NTHR - 1) / NTHR;
    static_assert(2 * KBUF + 2 * VBUF <= 131072, "attention LDS");
    const int tid = pg8::opaque_tid(), lane = tid & 63, w = tid >> 6, c16 = lane & 15, q4 = lane >> 4;
    __syncthreads();
    bf16x8 qf[2][KS];
    {
        v4u raw[2][KS];
#pragma unroll
        for (int qt = 0; qt < 2; ++qt)
#pragma unroll
            for (int ks = 0; ks < KS; ++ks) raw[qt][ks] = *(const v4u*)(Qp + (size_t)(32 * w + 16 * qt + c16) * qpitch + ks * 32 + 8 * q4);
        if (QNORM) {
#pragma unroll
            for (int qt = 0; qt < 2; ++qt) {
                float ss = 0.f;
#pragma unroll
                for (int ks = 0; ks < KS; ++ks) { const v4u x = raw[qt][ks];
                    ss += bflo(x.x) * bflo(x.x) + bfhi(x.x) * bfhi(x.x) + bflo(x.y) * bflo(x.y) + bfhi(x.y) * bfhi(x.y) + bflo(x.z) * bflo(x.z) + bfhi(x.z) * bfhi(x.z) + bflo(x.w) * bflo(x.w) + bfhi(x.w) * bfhi(x.w); }
                ss += __shfl_xor(ss, 16); ss += __shfl_xor(ss, 32);
                const float rstd = 1.0f / sqrtf(ss * (1.f / DQK) + EPS);
#pragma unroll
                for (int ks = 0; ks < KS; ++ks) { const v4u x = raw[qt][ks]; const float* gp = qg + ks * 32 + 8 * q4; v4u o;
                    o.x = cvt_pk_bf16(bflo(x.x) * rstd * gp[0], bfhi(x.x) * rstd * gp[1]); o.y = cvt_pk_bf16(bflo(x.y) * rstd * gp[2], bfhi(x.y) * rstd * gp[3]);
                    o.z = cvt_pk_bf16(bflo(x.z) * rstd * gp[4], bfhi(x.z) * rstd * gp[5]); o.w = cvt_pk_bf16(bflo(x.w) * rstd * gp[6], bfhi(x.w) * rstd * gp[7]);
                    raw[qt][ks] = o; }
            }
        }
#pragma unroll
        for (int qt = 0; qt < 2; ++qt)
#pragma unroll
            for (int ks = 0; ks < KS; ++ks) qf[qt][ks] = as_bf8(raw[qt][ks]);
    }
    v4u kreg[KPT], vreg[VPT];
#define ATT_GLOAD(kt) do { if constexpr (!QNORM) { \
    _Pragma("unroll") for (int i = 0; i < KPT; ++i) { const int ch = tid + i * NTHR; if (ch < NKC) kreg[i] = *(const v4u*)(Kp + (size_t)(kt) * 64 * DQK + (size_t)ch * 8); } \
    _Pragma("unroll") for (int i = 0; i < VPT; ++i) { const int ch = tid + i * NTHR; if (ch < NVC) vreg[i] = *(const v4u*)(Vtp + (size_t)(ch >> 3) * vpitch + (kt) * 64 + (ch & 7) * 8); } \
  } else { \
    _Pragma("unroll") for (int i = 0; i < KPT; ++i) { const int ch = tid + i * NTHR; kreg[i] = *(const v4u*)(Kp + (size_t)((kt) * 64 + (ch >> 4)) * 1024 + (ch & 15) * 8); } \
    _Pragma("unroll") for (int i = 0; i < VPT; ++i) { const int ch = tid + i * NTHR; vreg[i] = *(const v4u*)(Vtp + (size_t)((kt) * 64 + (ch & 63)) * 1024 + (ch >> 6) * 8); } \
  } } while (0)
#define ATT_LSTORE(buf) do { if constexpr (!QNORM) { \
    _Pragma("unroll") for (int i = 0; i < KPT; ++i) { const int ch = tid + i * NTHR; if (ch < NKC) *(LAS v4u*)(lds + (buf) * KBUF + (ch / (DQK / 8)) * (KROW * 2) + (ch % (DQK / 8)) * 16) = kreg[i]; } \
    _Pragma("unroll") for (int i = 0; i < VPT; ++i) { const int ch = tid + i * NTHR; if (ch < NVC) *(LAS v4u*)(lds + 2 * KBUF + (buf) * VBUF + (ch >> 3) * (VROW * 2) + (ch & 7) * 16) = vreg[i]; } \
  } else { \
    _Pragma("unroll") for (int i = 0; i < KPT; ++i) { const int ch = tid + i * NTHR; const v4u x = kreg[i]; \
        float ss = bflo(x.x) * bflo(x.x) + bfhi(x.x) * bfhi(x.x) + bflo(x.y) * bflo(x.y) + bfhi(x.y) * bfhi(x.y) + bflo(x.z) * bflo(x.z) + bfhi(x.z) * bfhi(x.z) + bflo(x.w) * bflo(x.w) + bfhi(x.w) * bfhi(x.w); \
        ss += __shfl_xor(ss, 1); ss += __shfl_xor(ss, 2); ss += __shfl_xor(ss, 4); ss += __shfl_xor(ss, 8); \
        const float rs = 1.0f / sqrtf(ss * (1.f / 128.f) + EPS); const float* gp = kg + (ch & 15) * 8; v4u o; \
        o.x = cvt_pk_bf16(bflo(x.x) * rs * gp[0], bfhi(x.x) * rs * gp[1]); o.y = cvt_pk_bf16(bflo(x.y) * rs * gp[2], bfhi(x.y) * rs * gp[3]); \
        o.z = cvt_pk_bf16(bflo(x.z) * rs * gp[4], bfhi(x.z) * rs * gp[5]); o.w = cvt_pk_bf16(bflo(x.w) * rs * gp[6], bfhi(x.w) * rs * gp[7]); \
        *(LAS v4u*)(lds + (buf) * KBUF + (ch >> 4) * (KROW * 2) + (ch & 15) * 16) = o; } \
    _Pragma("unroll") for (int i = 0; i < VPT; ++i) { const int ch = tid + i * NTHR; const v4u x = vreg[i]; \
        LAS bf16* vd = (LAS bf16*)(lds + 2 * KBUF + (buf) * VBUF) + ((ch >> 6) * 8) * VROW + (ch & 63); \
        vd[0 * VROW] = (bf16)(x.x & 0xffffu); vd[1 * VROW] = (bf16)(x.x >> 16); vd[2 * VROW] = (bf16)(x.y & 0xffffu); vd[3 * VROW] = (bf16)(x.y >> 16); \
        vd[4 * VROW] = (bf16)(x.z & 0xffffu); vd[5 * VROW] = (bf16)(x.z >> 16); vd[6 * VROW] = (bf16)(x.w & 0xffffu); vd[7 * VROW] = (bf16)(x.w >> 16); } \
  } } while (0)
    ATT_GLOAD(0); ATT_LSTORE(0);
    __syncthreads();
    float m_run[2] = {-1e30f, -1e30f}, l_run[2] = {0.f, 0.f};
    f32x4 o[DT][2];
#pragma unroll
    for (int dt = 0; dt < DT; ++dt) { o[dt][0] = (f32x4){0.f, 0.f, 0.f, 0.f}; o[dt][1] = (f32x4){0.f, 0.f, 0.f, 0.f}; }
    const int rw0 = row0seq + 32 * w;
    for (int kt = 0; kt < nkt; ++kt) {
        if (kt + 1 < nkt) ATT_GLOAD(kt + 1);
        const int k0 = kt * 64;
        const bool active = !CAUSAL || (k0 <= rw0 + 31);
        if (active) {
            const LAS unsigned char* kb = lds + (kt & 1) * KBUF; const LAS unsigned char* vb = lds + 2 * KBUF + (kt & 1) * VBUF;
            f32x4 s[4][2];
#pragma unroll
            for (int kk = 0; kk < 4; ++kk) { s[kk][0] = (f32x4){0.f, 0.f, 0.f, 0.f}; s[kk][1] = (f32x4){0.f, 0.f, 0.f, 0.f}; }
#pragma unroll
            for (int kk = 0; kk < 4; ++kk)
#pragma unroll
                for (int ks = 0; ks < KS; ++ks) { const bf16x8 kf = as_bf8(*(const LAS v4u*)(kb + (kk * 16 + c16) * (KROW * 2) + (ks * 32 + 8 * q4) * 2));
                    s[kk][0] = mfma16(kf, qf[0][ks], s[kk][0]); s[kk][1] = mfma16(kf, qf[1][ks], s[kk][1]); }
            const bool needmask = CAUSAL && (k0 + 63 > rw0);
            bf16x8 pf[2][2];
#pragma unroll
            for (int qt = 0; qt < 2; ++qt) {
                const int rowi = rw0 + 16 * qt + c16;
                float tmax = -INFINITY;
#pragma unroll
                for (int kk = 0; kk < 4; ++kk)
#pragma unroll
                    for (int j = 0; j < 4; ++j) { float v = s[kk][qt][j];
                        if (needmask) { const int key = k0 + kk * 16 + 4 * q4 + j; v = (key > rowi) ? -INFINITY : v; }
                        s[kk][qt][j] = v; tmax = fmaxf(tmax, v); }
                tmax = fmaxf(tmax, __shfl_xor(tmax, 16)); tmax = fmaxf(tmax, __shfl_xor(tmax, 32));
                const float mnew = fmaxf(m_run[qt], tmax * scale_log2), alpha = __builtin_amdgcn_exp2f(m_run[qt] - mnew);
                m_run[qt] = mnew;
                float psum = 0.f;
#pragma unroll
                for (int kk = 0; kk < 4; ++kk)
#pragma unroll
                    for (int j = 0; j < 4; ++j) { const float p = __builtin_amdgcn_exp2f(__builtin_fmaf(s[kk][qt][j], scale_log2, -mnew)); s[kk][qt][j] = p; psum += p; }
                l_run[qt] = l_run[qt] * alpha + psum;
#pragma unroll
                for (int dt = 0; dt < DT; ++dt) o[dt][qt] = o[dt][qt] * alpha;
#pragma unroll
                for (int kp = 0; kp < 2; ++kp) { v4u pp;
                    pp.x = cvt_pk_bf16(s[2 * kp][qt][0], s[2 * kp][qt][1]); pp.y = cvt_pk_bf16(s[2 * kp][qt][2], s[2 * kp][qt][3]);
                    pp.z = cvt_pk_bf16(s[2 * kp + 1][qt][0], s[2 * kp + 1][qt][1]); pp.w = cvt_pk_bf16(s[2 * kp + 1][qt][2], s[2 * kp + 1][qt][3]);
                    pf[qt][kp] = as_bf8(pp); }
            }
#pragma unroll
            for (int dt = 0; dt < DT; ++dt)
#pragma unroll
                for (int kp = 0; kp < 2; ++kp) {
                    const LAS unsigned char* vp = vb + (dt * 16 + c16) * (VROW * 2) + (32 * kp + 4 * q4) * 2;
                    const v2u a0 = *(const LAS v2u*)vp, a1 = *(const LAS v2u*)(vp + 32);
                    const bf16x8 vf = as_bf8((v4u){a0.x, a0.y, a1.x, a1.y});
                    o[dt][0] = mfma16(vf, pf[0][kp], o[dt][0]); o[dt][1] = mfma16(vf, pf[1][kp], o[dt][1]);
                }
        }
        if (kt + 1 < nkt) ATT_LSTORE((kt + 1) & 1);
        __syncthreads();
    }
#undef ATT_GLOAD
#undef ATT_LSTORE
#pragma unroll
    for (int qt = 0; qt < 2; ++qt) {
        float lt = l_run[qt]; lt += __shfl_xor(lt, 16); lt += __shfl_xor(lt, 32);
        const float inv = 1.0f / lt;
        bf16* gr = Gp + (size_t)(32 * w + 16 * qt + c16) * gpitch + 4 * q4;
#pragma unroll
        for (int dt = 0; dt < DT; ++dt) { const v2u g = *(const v2u*)(gr + dt * 16); v2u r;
            r.x = cvt_pk_bf16(o[dt][qt][0] * inv * bflo(g.x), o[dt][qt][1] * inv * bfhi(g.x)); r.y = cvt_pk_bf16(o[dt][qt][2] * inv * bflo(g.y), o[dt][qt][3] * inv * bfhi(g.y));
            if (st) *(v2u*)(gr + dt * 16) = r; }
    }
}

__device__ __forceinline__ void ph_mla(const BV& v, LAS unsigned char* lds, int bid, int nb, bool st) {
    const bf16* Qb = v.Q; const bf16* Kb = v.K; const bf16* Vtb = v.Vt; bf16* G = v.G;
    const float sc = 0.10206207261596577f * 1.4426950408889634f;
    for (int u = bid; u < 32; u += nb) {
        const int b = 0, h = (u >> 2) & 7, p = u & 3;
        for (int half = 0; half < 2; ++half) {
            const int jb = half ? p : 7 - p;
            const size_t bh = (size_t)(b * 8 + h);
            attn_block<96, 64, true, false>(lds, Qb + (bh * SEQ + 256 * jb) * 96, 96, nullptr, Kb + bh * SEQ * 96, Vtb + bh * 64 * SEQ, SEQ, 4 * (jb + 1), 256 * jb, sc,
                                            G + (size_t)(b * SEQ + 256 * jb) * GW + h * 64, GW, st, nullptr);
        }
    }
}
__device__ __forceinline__ void ph_memattn(const Args& a, const BV& v, int l, LAS unsigned char* lds, int bid, int nb, bool st) {
    const bf16* MIX = v.MIX; bf16* G = v.G;
    const bf16* kvraw = l ? v.kvraw1 : v.kvraw0;
    const float sc = 0.08838834764831845f * 1.4426950408889634f;
    for (int u = bid; u < 32; u += nb) {
        const int tb = u >> 2, h = u & 3, t0 = tb * 256, b = 0;
        attn_block<128, 128, false, true>(lds, MIX + (size_t)t0 * MIXW + MC_MQ + h * 128, MIXW, a.in[19] + l * 128, kvraw + (size_t)(b * 256) * 1024 + h * 128, kvraw + (size_t)(b * 256) * 1024 + 512 + h * 128, 256,
                                          4, 0, sc, G + (size_t)t0 * GW + 3 * 512 + h * 128, GW, st, a.in[20] + l * 128);
    }
}

__device__ __forceinline__ void ph_sg(const Args& a, const BV& v, int l, LAS unsigned char* lds, int bid, int nb, bool st) {
    const int tid = pg8::opaque_tid(), lane = tid & 63, w = tid >> 6, c16 = lane & 15, q4 = lane >> 4;
    const bf16* MIX = v.MIX; bf16* G = v.G;
    const float* lng = a.in[13] + l * 512; const float* lnb = a.in[14] + l * 512; const float* ws_ = a.in[15] + (size_t)l * 4 * 128 * 128; const float* bs = a.in[16] + l * 4 * 128;
    LAS float* stat = (LAS float*)lds; LAS bf16* vT = (LAS bf16*)(lds + 1024); constexpr int VLD = 136;
    for (int u = bid; u < 32; u += nb) {
        const int c = u >> 1, gp2 = u & 1, t0 = c * 128;
        __syncthreads();
        {   const int row = tid >> 2, part = tid & 3; const bf16* src = MIX + (size_t)(t0 + row) * MIXW + MC_V + part * 128;
            float s1 = 0.f, s2 = 0.f;
#pragma unroll 4
            for (int i = 0; i < 16; ++i) { const v4u x = *(const v4u*)(src + i * 8);
                const float f0 = bflo(x.x), f1 = bfhi(x.x), f2 = bflo(x.y), f3 = bfhi(x.y), f4 = bflo(x.z), f5 = bfhi(x.z), f6 = bflo(x.w), f7 = bfhi(x.w);
                s1 += ((f0 + f1) + (f2 + f3)) + ((f4 + f5) + (f6 + f7)); s2 += ((f0 * f0 + f1 * f1) + (f2 * f2 + f3 * f3)) + ((f4 * f4 + f5 * f5) + (f6 * f6 + f7 * f7)); }
            s1 += __shfl_xor(s1, 1); s1 += __shfl_xor(s1, 2); s2 += __shfl_xor(s2, 1); s2 += __shfl_xor(s2, 2);
            const float mean = s1 * (1.f / 512.f), var = fmaxf(s2 * (1.f / 512.f) - mean * mean, 0.f);
            if (part == 0) { stat[row * 2] = mean; stat[row * 2 + 1] = 1.0f / sqrtf(var + EPS); }
        }
        __syncthreads();
        {   const int s = tid & 127, dq = tid >> 7; const bf16* src = MIX + (size_t)(t0 + s) * MIXW + MC_V + gp2 * 256 + dq * 64;
            const float mean = stat[s * 2], rstd = stat[s * 2 + 1];
#pragma unroll
            for (int i = 0; i < 8; ++i) { const v4u x = *(const v4u*)(src + i * 8); const int d0 = dq * 64 + i * 8; const float* gp = lng + gp2 * 256 + d0; const float* bp = lnb + gp2 * 256 + d0;
                float f[8] = {bflo(x.x), bfhi(x.x), bflo(x.y), bfhi(x.y), bflo(x.z), bfhi(x.z), bflo(x.w), bfhi(x.w)};
#pragma unroll
                for (int e = 0; e < 8; ++e) { const float y = (f[e] - mean) * rstd * gp[e] + bp[e]; vT[(d0 + e) * VLD + s] = (bf16)(cvt_pk_bf16(y, 0.f) & 0xffffu); } }
        }
        __syncthreads();
#pragma unroll 1
        for (int half = 0; half < 2; ++half) {
            const int g = gp2 * 2 + half, rt = half ? 7 - w : w;
            f32x4 acc[8];
#pragma unroll
            for (int nt = 0; nt < 8; ++nt) acc[nt] = (f32x4){0.f, 0.f, 0.f, 0.f};
            const int tt = 16 * rt + c16, nks = (rt >> 1) + 1;
            const float* wrow = ws_ + ((size_t)g * 128 + tt) * 128;
            for (int ks = 0; ks < nks; ++ks) {
                const int s0 = ks * 32 + 8 * q4;
                const f32x4 w0 = *(const f32x4*)(wrow + s0), w1 = *(const f32x4*)(wrow + s0 + 4);
                float wv[8] = {w0[0], w0[1], w0[2], w0[3], w1[0], w1[1], w1[2], w1[3]};
#pragma unroll
                for (int e = 0; e < 8; ++e) wv[e] = (s0 + e <= tt) ? wv[e] : 0.f;
                v4u wp; wp.x = cvt_pk_bf16(wv[0], wv[1]); wp.y = cvt_pk_bf16(wv[2], wv[3]); wp.z = cvt_pk_bf16(wv[4], wv[5]); wp.w = cvt_pk_bf16(wv[6], wv[7]);
                const bf16x8 bfrag = as_bf8(wp);
#pragma unroll
                for (int nt = 0; nt < 8; ++nt) { const bf16x8 af = as_bf8(*(const LAS v4u*)(vT + (half * 128 + nt * 16 + c16) * VLD + s0)); acc[nt] = mfma16(af, bfrag, acc[nt]); }
            }
            const int t = t0 + tt; const float bias = bs[g * 128 + tt];
            const bf16* up = MIX + (size_t)t * MIXW + MC_U + g * 128 + 4 * q4; bf16* gp = G + (size_t)t * GW + 2 * 512 + g * 128 + 4 * q4;
#pragma unroll
            for (int nt = 0; nt < 8; ++nt) { const v2u uu = *(const v2u*)(up + nt * 16), gg = *(const v2u*)(gp + nt * 16); v2u r;
                r.x = cvt_pk_bf16(bflo(uu.x) * (acc[nt][0] + bias) * bflo(gg.x), bfhi(uu.x) * (acc[nt][1] + bias) * bfhi(gg.x));
                r.y = cvt_pk_bf16(bflo(uu.y) * (acc[nt][2] + bias) * bflo(gg.y), bfhi(uu.y) * (acc[nt][3] + bias) * bfhi(gg.y));
                if (st) *(v2u*)(gp + nt * 16) = r; }
        }
    }
}

__device__ __forceinline__ void ph_conv(const Args& a, const BV& v, int l, int bid, int nb, bool st) {
    const bf16* MIX = v.MIX; bf16* G = v.G;
    const float* cw = a.in[11] + l * 3 * 512; const float* cb = a.in[12] + l * 512;
    for (int idx = bid * NTHR + pg8::opaque_tid(); idx < (SEQ / 4) * 64; idx += nb * NTHR) {
        const int t4 = (idx >> 6) * 4, c = (idx & 63) * 8;
        float w0[8], w1[8], w2[8], bb[8];
#pragma unroll
        for (int e = 0; e < 8; ++e) { w0[e] = cw[c + e]; w1[e] = cw[512 + c + e]; w2[e] = cw[1024 + c + e]; bb[e] = cb[c + e]; }
        v4u cgv[6], xv[6], bgv[4], ggv[4];
#pragma unroll
        for (int r = 0; r < 6; ++r) { const int t = t4 - 2 + r; const bf16* row = MIX + (size_t)(t < 0 ? 0 : t) * MIXW; cgv[r] = *(const v4u*)(row + MC_CG + c); xv[r] = *(const v4u*)(row + MC_XIN + c); }
#pragma unroll
        for (int r = 0; r < 4; ++r) { bgv[r] = *(const v4u*)(MIX + (size_t)(t4 + r) * MIXW + MC_BG + c); ggv[r] = *(const v4u*)(G + (size_t)(t4 + r) * GW + 512 + c); }
        float z[6][8];
#pragma unroll
        for (int r = 0; r < 6; ++r) { const float m = (t4 - 2 + r < 0) ? 0.f : 1.f;
            z[r][0] = m * bflo(cgv[r].x) * bflo(xv[r].x); z[r][1] = m * bfhi(cgv[r].x) * bfhi(xv[r].x); z[r][2] = m * bflo(cgv[r].y) * bflo(xv[r].y); z[r][3] = m * bfhi(cgv[r].y) * bfhi(xv[r].y);
            z[r][4] = m * bflo(cgv[r].z) * bflo(xv[r].z); z[r][5] = m * bfhi(cgv[r].z) * bfhi(xv[r].z); z[r][6] = m * bflo(cgv[r].w) * bflo(xv[r].w); z[r][7] = m * bfhi(cgv[r].w) * bfhi(xv[r].w); }
#pragma unroll
        for (int r = 0; r < 4; ++r) {
            const v4u bg = bgv[r], gg = ggv[r];
            const float bgf[8] = {bflo(bg.x), bfhi(bg.x), bflo(bg.y), bfhi(bg.y), bflo(bg.z), bfhi(bg.z), bflo(bg.w), bfhi(bg.w)};
            const float ggf[8] = {bflo(gg.x), bfhi(gg.x), bflo(gg.y), bfhi(gg.y), bflo(gg.z), bfhi(gg.z), bflo(gg.w), bfhi(gg.w)};
            float y[8];
#pragma unroll
            for (int e = 0; e < 8; ++e) y[e] = bgf[e] * (bb[e] + w0[e] * z[r][e] + w1[e] * z[r + 1][e] + w2[e] * z[r + 2][e]) * ggf[e];
            v4u o; o.x = cvt_pk_bf16(y[0], y[1]); o.y = cvt_pk_bf16(y[2], y[3]); o.z = cvt_pk_bf16(y[4], y[5]); o.w = cvt_pk_bf16(y[6], y[7]);
            if (st) *(v4u*)(G + (size_t)(t4 + r) * GW + 512 + c) = o;
        }
    }
}
#define XB_TMO      128
#define XB_XCNT(j)  (256  + 64 * (j))
#define XB_XSUB(j)  (1280 + 64 * (j))
#define XB_XGEN(j)  (2304 + 64 * (j))
#define XB_TOP      3328
#define XB_TOPGEN   3392
#define XCD_BAR_WORDS 3456
#define XB_SPIN_CAP (1u << 18)

__device__ __forceinline__ unsigned xb_ld(unsigned* p)              { return __hip_atomic_load(p, __ATOMIC_RELAXED, __HIP_MEMORY_SCOPE_AGENT); }
__device__ __forceinline__ unsigned xb_add(unsigned* p, unsigned v) { return __hip_atomic_fetch_add(p, v, __ATOMIC_RELAXED, __HIP_MEMORY_SCOPE_AGENT); }
__device__ __forceinline__ unsigned xb_xcc_id() { return (unsigned)__builtin_amdgcn_s_getreg((3 << 11) | 20) & 0xFu; }
#define XB_SPIN(cond, bar) do { unsigned _sp = 0; while (cond) { __builtin_amdgcn_s_sleep(1); \
    if ((++_sp & 255u) == 0u) { if (xb_ld(&(bar)[XB_TMO])) break; if (_sp > XB_SPIN_CAP) { atomicAdd(&(bar)[XB_TMO], 1u); break; } } } } while (0)

struct XcdBarrier {
    unsigned* bar; unsigned x;
    volatile LAS unsigned* st;
};

__device__ __forceinline__ XcdBarrier xcd_barrier_post(unsigned* bar, volatile LAS unsigned* st) {
    XcdBarrier b; b.bar = bar; b.x = xb_xcc_id(); b.st = st;
    if (threadIdx.x == 0) (void)xb_add(&bar[XB_XCNT(b.x)], 1u);
    return b;
}
__device__ __forceinline__ void xcd_barrier_complete(unsigned* bar, unsigned x, unsigned& nloc, unsigned& nx) {
    const unsigned G = gridDim.x * gridDim.y * gridDim.z;
    unsigned sum, cnt, mine, sp = 0u;
    for (;;) {
        sum = 0u; cnt = 0u; mine = 0u;
#pragma unroll
        for (unsigned j = 0; j < 16; ++j) { const unsigned c = xb_ld(&bar[XB_XCNT(j)]); sum += c; cnt += (c > 0u) ? 1u : 0u; mine = (j == x) ? c : mine; }
        if (sum == G) break;
        __builtin_amdgcn_s_sleep(1);
        if ((++sp & 255u) == 0u) { if (xb_ld(&bar[XB_TMO])) break; if (sp > XB_SPIN_CAP) { atomicAdd(&bar[XB_TMO], 1u); break; } }
    }
    nloc = mine > 0u ? mine : 1u; nx = cnt > 0u ? cnt : 1u;
}

__device__ __forceinline__ void xcd_barrier(const XcdBarrier& b) {
    asm volatile("s_waitcnt vmcnt(0)" ::: "memory");
    __syncthreads();
    if (threadIdx.x == 0) {
        unsigned* bar = b.bar;
        __builtin_amdgcn_s_waitcnt(0);
        unsigned nloc = b.st[0], nx = b.st[1];
        if (nloc == 0u) { xcd_barrier_complete(bar, b.x, nloc, nx); b.st[0] = nloc; b.st[1] = nx; }
        const unsigned old = xb_add(&bar[XB_XSUB(b.x)], 1u);
        const unsigned gen = old / nloc;
        if (old + 1u == (gen + 1u) * nloc) {
            __builtin_amdgcn_fence(__ATOMIC_RELEASE, "agent");
            asm volatile("s_waitcnt vmcnt(0)" ::: "memory");
            const unsigned og = xb_add(&bar[XB_TOP], 1u);
            const unsigned tg = og / nx;
            if (og + 1u == (tg + 1u) * nx) xb_add(&bar[XB_TOPGEN], 1u);
            else XB_SPIN(xb_ld(&bar[XB_TOPGEN]) == tg, bar);
            __builtin_amdgcn_fence(__ATOMIC_ACQUIRE, "agent");
            xb_add(&bar[XB_XGEN(b.x)], 1u);
            asm volatile("s_waitcnt vmcnt(0)" ::: "memory");
        } else {
            XB_SPIN(xb_ld(&bar[XB_XGEN(b.x)]) == gen, bar);
            __builtin_amdgcn_fence(__ATOMIC_ACQUIRE, "agent");
            asm volatile("s_waitcnt vmcnt(0)" ::: "memory");
        }
    }
    __syncthreads();
}

#ifndef MK_PER_PHASE
#define MK_PER_PHASE 0
#endif
constexpr int NPH = 1 + 8 + 7;
__device__ __forceinline__ void group_barrier(unsigned* cnt, unsigned& round, unsigned npart, bool local) {
    asm volatile("s_waitcnt vmcnt(0)" ::: "memory");
    __syncthreads();
    if (threadIdx.x == 0) {
        if (!local) { __builtin_amdgcn_fence(__ATOMIC_RELEASE, "agent"); asm volatile("s_waitcnt vmcnt(0)" ::: "memory"); }
        (void)__hip_atomic_fetch_add(cnt, 1u, __ATOMIC_RELAXED, __HIP_MEMORY_SCOPE_AGENT);
        const unsigned target = (round + 1u) * npart; unsigned sp = 0u;
        while (__hip_atomic_load(cnt, __ATOMIC_RELAXED, __HIP_MEMORY_SCOPE_AGENT) < target) { __builtin_amdgcn_s_sleep(1); if (++sp > (1u << 24)) break; }
        __builtin_amdgcn_fence(__ATOMIC_ACQUIRE, "agent");
        asm volatile("s_waitcnt vmcnt(0)" ::: "memory");
    }
    __syncthreads();
    ++round;
}

__global__ void __launch_bounds__(NTHR, 2) mk_fwd(Args a) {
    extern __shared__ __attribute__((aligned(16))) unsigned char lds_raw[];
    LAS unsigned char* lds = (LAS unsigned char*)lds_raw;
    cg::grid_group grid = cg::this_grid();
    const int bid = blockIdx.x, nb = gridDim.x;
    const bool real = (a.ph_hi > 0);
    volatile LAS unsigned* MISC = (volatile LAS unsigned*)(lds + 131072);
    if (threadIdx.x < 32) MISC[threadIdx.x] = 0u;
    __syncthreads();
    const XcdBarrier bar = xcd_barrier_post((unsigned*)a.ws + 1024, MISC + 8);
#ifdef TSPROBE
    unsigned long long* ts = (unsigned long long*)(a.ws + 100000); int nts = 0;
#define STAMP() do { if (bid == 0 && threadIdx.x == 0) ts[nts] = __builtin_amdgcn_s_memrealtime(); ++nts; } while (0)
#else
#define STAMP() do {} while (0)
#endif
    STAMP();
#ifdef DUP_PRO
    ph_prologue(a, lds, bid, nb); __syncthreads();
#endif
    if (threadIdx.x == 0) atomicOr((unsigned*)a.ws + 15360 + (bid & 7), 1u << xb_xcc_id());
#ifdef XCCPROBE
    if (threadIdx.x == 0) { unsigned* tb = (unsigned*)a.ws + 14336; const unsigned x = xb_xcc_id();
        atomicOr(tb + (bid & 7), 1u << x); atomicOr(tb + 8 + (bid >> 5), 1u << x); }
#endif
    ph_prologue(a, lds, bid, nb);
    if (a.ph_hi < 0) grid.sync();
    xcd_barrier(bar);
    STAMP();
    for (int ll = 0; ll < 2; ++ll) {
        pg8::Gemm g2{(const bf16*)(a.ws + WS_SLAB + (size_t)(1 + ll) * SLAB + SO_Q), DM, (const bf16*)(a.ws + WS_SLAB + SO_Q + ll * 2 * MiB), MEMT, 1024, DM};
        pg8::StaticOrder S2; S2.init(MEMT, 1024, nb, (bid + 128 * ll) % nb);
        pg8::EpiAct<0> E2{(bf16*)(a.ws + WS_KVRAW + ll * 4 * MiB), 1024, 1 << 20, nullptr, 0, nullptr};
        pg8::gemm_phase<pg8::EpiAct<0>, pg8::StaticOrder, true, true>(lds, g2, S2, E2);
    }
    __syncthreads();
    ph_prologue_b(a, lds, bid);
    unsigned* done2 = (unsigned*)a.ws + 14848;
    asm volatile("s_waitcnt vmcnt(0)" ::: "memory");
    __syncthreads();
    if (threadIdx.x == 0) { __builtin_amdgcn_fence(__ATOMIC_RELEASE, "agent"); asm volatile("s_waitcnt vmcnt(0)" ::: "memory"); (void)__hip_atomic_fetch_add(done2, 1u, __ATOMIC_RELAXED, __HIP_MEMORY_SCOPE_AGENT); }
    STAMP();
    const int g = bid & 7, lb = bid >> 3; constexpr int NLB = 32;
    unsigned* gcnt = (unsigned*)a.ws + 8192 + 64 * g; unsigned round = 0u;
    const bool glocal = __builtin_popcount(__hip_atomic_load((unsigned*)a.ws + 15360 + g, __ATOMIC_RELAXED, __HIP_MEMORY_SCOPE_AGENT)) == 1;
    unsigned char* slab = a.ws + WS_SLAB + (size_t)g * SLAB;
    BV v; v.MIX = (bf16*)(slab + SO_MIX); v.G = (bf16*)(slab + SO_G); v.Q = (bf16*)(slab + SO_Q); v.K = (bf16*)(slab + SO_K); v.Vt = (bf16*)(slab + SO_VT);
    v.kvraw0 = (const bf16*)(a.ws + WS_KVRAW) + (size_t)g * MEML * 1024; v.kvraw1 = (const bf16*)(a.ws + WS_KVRAW + 4 * MiB) + (size_t)g * MEML * 1024; v.pos = (const int*)a.in[2] + g * SEQ;
    bf16* H = (bf16*)(slab + SO_H); bf16* GATE = (bf16*)(slab + SO_GATE); bf16* MERGED = (bf16*)(slab + SO_MERGED);
    float* outg = a.out + (size_t)g * SEQ * DM;
#ifdef DUP_GB
#define GB() do { group_barrier(gcnt, round, 32u, glocal); group_barrier(gcnt, round, 32u, glocal); group_barrier(gcnt, round, 32u, glocal); } while (0)
#else
#define GB() do { group_barrier(gcnt, round, 32u, glocal); STAMP(); } while (0)
#endif
#ifdef STAGGER_TICKS
    if (g >= 4) { const unsigned long long t0 = __builtin_amdgcn_s_memrealtime(); while (__builtin_amdgcn_s_memrealtime() - t0 < (unsigned long long)(STAGGER_TICKS)) __builtin_amdgcn_s_sleep(32); }
#endif
    for (int l = 0; l < 2; ++l) {
        const unsigned char* wb = a.ws + (l ? WS_W1 : WS_W0);
        const bf16* WinT = (const bf16*)(wb + WO_WIN);
        const float* xl = l ? outg : a.in[0] + (size_t)g * SEQ * DM;
        const bf16* Hl = l ? H : (const bf16*)outg;
        {
            pg8::Gemm gm{Hl, DM, WinT, SEQ, NA, DM};
            pg8::StaticOrder S; S.init(SEQ, NA, NLB, lb);
            pg8::EpiAct<1> E{v.MIX, MIXW, 14, v.G, GW, nullptr};
#ifdef DUP_P1A
            pg8::gemm_phase<pg8::EpiAct<1>, pg8::StaticOrder, true, true>(lds, gm, S, E);
#endif
            pg8::gemm_phase<pg8::EpiAct<1>, pg8::StaticOrder, true, true>(lds, gm, S, E);
        }
        GB();
        if (l == 0) {
            if (threadIdx.x == 0) { unsigned sp = 0u; while (__hip_atomic_load(done2, __ATOMIC_RELAXED, __HIP_MEMORY_SCOPE_AGENT) < (unsigned)nb) { __builtin_amdgcn_s_sleep(2); if (++sp > (1u << 24)) break; }
                __builtin_amdgcn_fence(__ATOMIC_ACQUIRE, "agent"); asm volatile("s_waitcnt vmcnt(0)" ::: "memory"); }
            __syncthreads();
        }
#ifdef DUP_P2
        ph_p2(a, v, l, lds, lb, NLB);
#endif
        ph_p2(a, v, l, lds, lb, NLB);
        ph_memattn(a, v, l, lds, lb, NLB, real); ph_sg(a, v, l, lds, lb, NLB, real); ph_conv(a, v, l, lb, NLB, real);
        GB();
#ifdef DUP_MLA
        ph_mla(v, lds, lb, NLB, !real);
#endif
#ifdef DUP_MIX3
        ph_memattn(a, v, l, lds, lb, NLB, !real); ph_sg(a, v, l, lds, lb, NLB, !real); ph_conv(a, v, l, lb, NLB, !real);
#endif
        ph_mla(v, lds, lb, NLB, real);
        GB();
        if (l == 1) { norm_rows(xl, a.in[3] + l * DM, H, SEQ, lb, NLB); GB(); }
        {
            pg8::Gemm gm{Hl, DM, WinT + (size_t)NA * DM, SEQ, GATEW, DM};
            pg8::StaticOrder S; S.init(SEQ, GATEW, NLB, lb);
            pg8::EpiGateQ E{GATE, a.in[21] + l * 4096};
#ifdef DUP_P1B
            pg8::gemm_phase<pg8::EpiGateQ, pg8::StaticOrder, true, true>(lds, gm, S, E);
#endif
            pg8::gemm_phase<pg8::EpiGateQ, pg8::StaticOrder, true, true>(lds, gm, S, E);
        }
        GB();
        {
            pg8::Gemm gm{v.G, GW, (const bf16*)(wb + WO_WBR), SEQ, DM, 2048};
            pg8::StaticOrder S; S.init(SEQ, DM, NLB, lb);
            pg8::EpiGate E{GATE, MERGED};
#ifdef DUP_P4
            pg8::gemm_phase<pg8::EpiGate, pg8::StaticOrder, false, true>(lds, gm, S, E);
#endif
            pg8::gemm_phase<pg8::EpiGate, pg8::StaticOrder, false, true>(lds, gm, S, E);
            pg8::Unit u4; S.next(0, u4); unsigned pr4 = 0u;
            group_barrier((unsigned*)a.ws + 20480 + 64 * ((l * 8 + g) * 8 + u4.pm), pr4, 4u, glocal);
        }
        {
            pg8::Gemm gm{MERGED, DM, (const bf16*)(wb + WO_WOUT), SEQ, DM, DM};
            pg8::StaticOrder S; S.init(SEQ, DM, NLB, lb);
#ifdef DUP_P5
            { pg8::EpiRes E0{xl, outg, DM, !real}; pg8::gemm_phase<pg8::EpiRes, pg8::StaticOrder, false, true>(lds, gm, S, E0); }
#endif
            pg8::EpiRes E{xl, outg, DM, real};
            pg8::gemm_phase<pg8::EpiRes, pg8::StaticOrder, false, true>(lds, gm, S, E);
            if (l == 0) {
                pg8::Unit u; S.next(0, u);
                unsigned pround = 0u;
                group_barrier((unsigned*)a.ws + 16384 + 64 * (g * 8 + u.pm), pround, 4u, glocal);
                const int r0 = u.pm * 256 + u.pn * 64;
                norm_rows(outg + (size_t)r0 * DM, a.in[3] + DM, H + (size_t)r0 * DM, 64, 0, 1);
            }
        }
        if (l == 0) GB();
    }
#ifdef XCCPROBE
    if (bid == 0) { __syncthreads(); asm volatile("s_waitcnt vmcnt(0)" ::: "memory");
        if (threadIdx.x == 0) { pg8::StaticOrder S; S.init(SEQ, DM, NLB, lb); pg8::Unit u; S.next(0, u);
            const unsigned* tb = (const unsigned*)a.ws + 14336; int A = 0, B = 0;
            for (int r = 0; r < 8; ++r) { const unsigned ma = __hip_atomic_load(tb + r, __ATOMIC_RELAXED, __HIP_MEMORY_SCOPE_AGENT), mb = __hip_atomic_load(tb + 8 + r, __ATOMIC_RELAXED, __HIP_MEMORY_SCOPE_AGENT);
                A += (__builtin_popcount(ma) != 1); B += (__builtin_popcount(mb) != 1); }
            outg[(size_t)(u.pm * 256) * DM + u.pn * 256] += 1.0f + 10.0f * (float)A + (float)B; } }
#endif
#ifdef TSPROBE
    STAMP();
    if (bid == 0) {
        __syncthreads();
        asm volatile("s_waitcnt vmcnt(0)" ::: "memory");
        const float d1 = (float)(ts[TS_A1] - ts[TS_A0]) * 0.01f, d2 = (float)(ts[TS_B1] - ts[TS_B0]) * 0.01f;
        pg8::StaticOrder S; S.init(SEQ, DM, NLB, lb); pg8::Unit u; S.next(0, u);
        float* tile = outg + (size_t)(u.pm * 256) * DM + u.pn * 256;
        for (int i = 0; i < 128; ++i) { const int e = threadIdx.x + 512 * i; tile[(size_t)(e >> 8) * DM + (e & 255)] += 0.004f * d2; }
        __syncthreads();
        if (threadIdx.x == 0) tile[0] += 0.02f * d1;
    }
#endif
#undef GB
}

extern "C" void kernel_launch(void* const* d_in, const int* in_sizes, int n_in, void* d_out, int out_size, void* d_ws, size_t ws_size, hipStream_t stream) {
    static int grid = 0;
    if (grid == 0) {
        if (n_in != 24 || out_size != T * DM || ws_size < WS_END) { fprintf(stderr, "kernel_launch: unexpected problem (n_in %d out %d ws %zu)\n", n_in, out_size, ws_size); grid = -1; return; }
        int dev = 0, cus = 0, per_cu = 0;
        hipGetDevice(&dev); hipDeviceGetAttribute(&cus, hipDeviceAttributeMultiprocessorCount, dev);
        if (hipFuncSetAttribute((const void*)mk_fwd, hipFuncAttributeMaxDynamicSharedMemorySize, LDS_BYTES) != hipSuccess) { fprintf(stderr, "kernel_launch: hipFuncSetAttribute failed\n"); grid = -1; return; }
        if (hipOccupancyMaxActiveBlocksPerMultiprocessor(&per_cu, (const void*)mk_fwd, NTHR, LDS_BYTES) != hipSuccess || per_cu < 1) { fprintf(stderr, "kernel_launch: occupancy query says %d\n", per_cu); per_cu = 1; }
        (void)hipGetLastError();
        if (cus < 256) { fprintf(stderr, "kernel_launch: needs 256 CUs, device has %d\n", cus); grid = -1; return; }
        grid = 256;
    }
    if (grid < 0) return;
    if (hipMemsetAsync(d_ws, 0, 131072, stream) != hipSuccess) { fprintf(stderr, "kernel_launch: memset failed\n"); return; }
    Args a{};
    for (int i = 0; i < 24; ++i) a.in[i] = (const float*)d_in[i];
    a.out = (float*)d_out; a.ws = (unsigned char*)d_ws;
    a.ph_lo = 0; a.ph_hi = NPH; void* args[] = {&a};
    hipError_t e = hipLaunchCooperativeKernel((void*)mk_fwd, dim3(grid), dim3(NTHR), args, LDS_BYTES, stream);
    if (e != hipSuccess) fprintf(stderr, "cooperative launch failed: %s (grid %d)\n", hipGetErrorString(e), grid);
}
```

```cpp
#include <hip/hip_runtime.h>
#include <hip/hip_cooperative_groups.h>
#include <cstdio>
#include <cstdint>
namespace cg = cooperative_groups;
namespace pg8 {
#define PG8_LAS __attribute__((address_space(3)))
typedef unsigned short bf16_t;
typedef short bf16x8 __attribute__((ext_vector_type(8)));
typedef float f32x4 __attribute__((ext_vector_type(4)));
typedef unsigned u32x4 __attribute__((ext_vector_type(4)));
constexpr int BM = 256, BK = 64, HALF = 128, HTB = HALF * BK * 2  , STAGE_BYTES = 8 * HTB, NXCD = 8, WGM = 8;

__host__ __device__ __forceinline__ int lds_byte(int r, int c) { const int st = (r >> 4) * 2 + (c >> 5), rr = r & 15, cc = c & 31, ob = rr * 64 + cc * 2; return st * 1024 + (ob ^ (((ob >> 9) & 1) << 5)); }
__host__ __device__ __forceinline__ void stage_rc(int b, int& R, int& C) { const int st = b / 1024, sb = b % 1024, swz = sb ^ (((sb >> 9) & 1) << 5); R = (st >> 1) * 16 + swz / 64; C = (st & 1) * 32 + (swz % 64) / 2; }
__host__ __device__ __forceinline__ int perm32(int rho) { const int n = rho >> 4, i = rho & 15; return 8 * (i >> 2) + 4 * n + (i & 3); }

struct Unit { int pm, pn; };
struct Gemm { const bf16_t* A; int lda; const bf16_t* Bt; int M, N, K; };

struct StaticOrder {
    int nM, nN, nwg, G, c;
    __host__ __device__ void init(int M, int N, int G_, int c_) { nM = M / BM; nN = N / BM; nwg = nM * nN; G = G_; c = c_; }
    __host__ __device__ bool next(int i, Unit& u) const {
        const long L = (long)i * G + c; if (L >= nwg) return false;
        int wgid = (int)L; { const int q = nwg / NXCD, r = nwg % NXCD, xcd = wgid % NXCD, off = wgid / NXCD; wgid = (xcd < r ? xcd * (q + 1) : r * (q + 1) + (xcd - r) * q) + off; }
        const int nig = WGM * nN, gid = wgid / nig, fm = gid * WGM, gsz = (nM - fm) < WGM ? (nM - fm) : WGM;
        u.pm = fm + ((wgid % nig) % gsz); u.pn = (wgid % nig) / gsz; return true;
    }
    __device__ __forceinline__ void a_ready(const Unit&) const {}
    __device__ __forceinline__ void done(const Unit&) const {}
};

__device__ __forceinline__ unsigned cvt_pk_bf16(float lo, float hi) { unsigned r; asm volatile("v_cvt_pk_bf16_f32 %0, %1, %2" : "=v"(r) : "v"(lo), "v"(hi)); return r; }
__device__ __forceinline__ int opaque_tid() { int t = threadIdx.x; asm volatile("" : "+v"(t)); return t; }
__device__ __forceinline__ float bflo(unsigned u) { return __uint_as_float(u << 16); }
__device__ __forceinline__ float bfhi(unsigned u) { return __uint_as_float(u & 0xffff0000u); }
__device__ __forceinline__ float sigm(float x) { return __builtin_amdgcn_rcpf(1.0f + __expf(-x)); }

template <int ACT> struct EpiAct {
    static constexpr bool PERM = true, AFTER_DRAIN = false, HAS_MID = false;
    bf16_t* O0; int ld0; int npn0; bf16_t* O1; int ld1; const float* bias;
    __device__ __forceinline__ void operator()(const f32x4 (&acc)[2][2][4][2], const Unit& u, int wr, int wc, int fr, int fq) const {
        const int row0 = u.pm * BM + wr * 64 + fr;
        const bool second = (u.pn >= npn0);
        bf16_t* base = second ? O1 : O0; const int ld = second ? ld1 : ld0; const int colt = second ? (u.pn - npn0) * BM : u.pn * BM;
        const int col0 = colt + wc * 32 + 8 * fq;
#pragma unroll
        for (int bj = 0; bj < 2; ++bj) {
            f32x4 b0 = (f32x4){0.f, 0.f, 0.f, 0.f}, b1 = b0;
            if (ACT == 2) { b0 = *(const f32x4*)(bias + col0 + bj * HALF); b1 = *(const f32x4*)(bias + col0 + bj * HALF + 4); }
#pragma unroll
            for (int ai = 0; ai < 2; ++ai)
#pragma unroll
                for (int m = 0; m < 4; ++m) {
                    bf16_t* rowp = base + (size_t)(row0 + ai * HALF + m * 16) * ld + col0 + bj * HALF;
                    f32x4 v0 = acc[ai][bj][m][0], v1 = acc[ai][bj][m][1];
                    if (ACT != 0 && second) {
#pragma unroll
                        for (int e = 0; e < 4; ++e) {
                            if (ACT == 1) { v0[e] = v0[e] * sigm(v0[e]); v1[e] = v1[e] * sigm(v1[e]); }
                            if (ACT == 2) { v0[e] = sigm(v0[e] + b0[e]); v1[e] = sigm(v1[e] + b1[e]); }
                        }
                    }
                    u32x4 w; w.x = cvt_pk_bf16(v0[0], v0[1]); w.y = cvt_pk_bf16(v0[2], v0[3]); w.z = cvt_pk_bf16(v1[0], v1[1]); w.w = cvt_pk_bf16(v1[2], v1[3]);
                    *(u32x4*)rowp = w;
                }
        }
    }
};

struct EpiGateQ {
    static constexpr bool PERM = true, AFTER_DRAIN = false, HAS_MID = false;
    bf16_t* O; const float* bias;
    __device__ __forceinline__ void operator()(const f32x4 (&acc)[2][2][4][2], const Unit& u, int wr, int wc, int fr, int fq) const {
        const int row0 = u.pm * BM + wr * 64 + fr, col0 = u.pn * BM + wc * 32 + 8 * fq;
        const float nl2e = -1.4426950408889634f;
#pragma unroll
        for (int bj = 0; bj < 2; ++bj) {
            const f32x4 b0 = *(const f32x4*)(bias + col0 + bj * HALF) * nl2e, b1 = *(const f32x4*)(bias + col0 + bj * HALF + 4) * nl2e;
#pragma unroll
            for (int ai = 0; ai < 2; ++ai)
#pragma unroll
                for (int m = 0; m < 4; ++m) {
                    const f32x4 t0 = acc[ai][bj][m][0] * nl2e + b0, t1 = acc[ai][bj][m][1] * nl2e + b1;
                    float e0[4], e1[4];
#pragma unroll
                    for (int e = 0; e < 4; ++e) { e0[e] = 1.0f + __builtin_amdgcn_exp2f(fminf(t0[e], 100.0f)); e1[e] = 1.0f + __builtin_amdgcn_exp2f(fminf(t1[e], 100.0f)); }
                    u32x4 w; w.x = cvt_pk_bf16(e0[0], e0[1]); w.y = cvt_pk_bf16(e0[2], e0[3]); w.z = cvt_pk_bf16(e1[0], e1[1]); w.w = cvt_pk_bf16(e1[2], e1[3]);
                    *(u32x4*)(O + (size_t)(row0 + ai * HALF + m * 16) * 4096 + col0 + bj * HALF) = w;
                }
        }
    }
};

struct EpiGate {
    static constexpr bool PERM = true, AFTER_DRAIN = false, HAS_MID = true;
    const bf16_t* GATE; bf16_t* O;
    __device__ __forceinline__ void mid(f32x4 (&acc)[2][2][4][2], const Unit& u, int nb, int wr, int wc, int fr_, int fq_) const {
        int fr = fr_, fq = fq_; asm volatile("" : "+v"(fr), "+v"(fq));
        const int row0 = u.pm * BM + wr * 64 + fr, col0 = u.pn * BM + wc * 32 + 8 * fq;
#pragma unroll
        for (int ai = 0; ai < 2; ++ai)
#pragma unroll
            for (int bj = 0; bj < 2; ++bj) {
                u32x4 ga[4], gb[4];
#pragma unroll
                for (int m = 0; m < 4; ++m) { const bf16_t* gp = GATE + (size_t)(row0 + ai * HALF + m * 16) * 4096 + (nb - 1) * 1024 + col0 + bj * HALF; ga[m] = *(const u32x4*)gp; gb[m] = *(const u32x4*)(gp + 1024); }
                __builtin_amdgcn_sched_barrier(0);
#pragma unroll
                for (int m = 0; m < 4; ++m) { const u32x4 a = ga[m], b = gb[m];
                    f32x4 r0, r1;
                    r0[0] = bflo(b.x) * __builtin_amdgcn_rcpf(bflo(a.x)); r0[1] = bfhi(b.x) * __builtin_amdgcn_rcpf(bfhi(a.x));
                    r0[2] = bflo(b.y) * __builtin_amdgcn_rcpf(bflo(a.y)); r0[3] = bfhi(b.y) * __builtin_amdgcn_rcpf(bfhi(a.y));
                    r1[0] = bflo(b.z) * __builtin_amdgcn_rcpf(bflo(a.z)); r1[1] = bfhi(b.z) * __builtin_amdgcn_rcpf(bfhi(a.z));
                    r1[2] = bflo(b.w) * __builtin_amdgcn_rcpf(bflo(a.w)); r1[3] = bfhi(b.w) * __builtin_amdgcn_rcpf(bfhi(a.w));
                    acc[ai][bj][m][0] = acc[ai][bj][m][0] * r0; acc[ai][bj][m][1] = acc[ai][bj][m][1] * r1; }
                __builtin_amdgcn_sched_barrier(0);
            }
    }
    __device__ __forceinline__ void operator()(const f32x4 (&acc)[2][2][4][2], const Unit& u, int wr, int wc, int fr, int fq) const {
        const int row0 = u.pm * BM + wr * 64 + fr, col0 = u.pn * BM + wc * 32 + 8 * fq;
#pragma unroll
        for (int ai = 0; ai < 2; ++ai)
#pragma unroll
            for (int bj = 0; bj < 2; ++bj) {
                u32x4 ga[4];
#pragma unroll
                for (int m = 0; m < 4; ++m) ga[m] = *(const u32x4*)(GATE + (size_t)(row0 + ai * HALF + m * 16) * 4096 + 3 * 1024 + col0 + bj * HALF);
                __builtin_amdgcn_sched_barrier(0);
#pragma unroll
                for (int m = 0; m < 4; ++m) { const u32x4 a = ga[m]; const f32x4 v0 = acc[ai][bj][m][0], v1 = acc[ai][bj][m][1];
                    u32x4 w; w.x = cvt_pk_bf16(v0[0] * __builtin_amdgcn_rcpf(bflo(a.x)), v0[1] * __builtin_amdgcn_rcpf(bfhi(a.x))); w.y = cvt_pk_bf16(v0[2] * __builtin_amdgcn_rcpf(bflo(a.y)), v0[3] * __builtin_amdgcn_rcpf(bfhi(a.y)));
                    w.z = cvt_pk_bf16(v1[0] * __builtin_amdgcn_rcpf(bflo(a.z)), v1[1] * __builtin_amdgcn_rcpf(bfhi(a.z))); w.w = cvt_pk_bf16(v1[2] * __builtin_amdgcn_rcpf(bflo(a.w)), v1[3] * __builtin_amdgcn_rcpf(bfhi(a.w)));
                    *(u32x4*)(O + (size_t)(row0 + ai * HALF + m * 16) * 1024 + col0 + bj * HALF) = w; }
                __builtin_amdgcn_sched_barrier(0);
            }
    }
};

struct EpiRes {
    static constexpr bool PERM = false, AFTER_DRAIN = false, HAS_MID = false;
    const float* base; float* out; int ldc; bool st;
    __device__ __forceinline__ void operator()(const f32x4 (&acc)[2][2][4][2], const Unit& u, int wr, int wc, int fr, int fq) const {
        const int row0 = u.pm * BM + wr * 64 + fr, col0 = u.pn * BM + wc * 32 + 4 * fq;
#pragma unroll
        for (int ai = 0; ai < 2; ++ai)
#pragma unroll
            for (int m = 0; m < 4; ++m)
#pragma unroll
                for (int bj = 0; bj < 2; ++bj)
#pragma unroll
                    for (int n = 0; n < 2; ++n) {
                        const size_t o = (size_t)(row0 + ai * HALF + m * 16) * ldc + col0 + bj * HALF + 16 * n;
                        const f32x4 x = *(const f32x4*)(base + o);
                        if (st) *(f32x4*)(out + o) = x + acc[ai][bj][m][n];
                    }
    }
};
template <class Epi, class Sched, bool ALIGN_EPI = false, bool SP2 = false>
__device__ __forceinline__ void gemm_phase(PG8_LAS unsigned char* lds, const Gemm g, const Sched& S, const Epi& E) {
    const int tid = pg8::opaque_tid(), wid = __builtin_amdgcn_readfirstlane(tid >> 6), lane = tid & 63, wr = wid >> 2, wc = wid & 3, fr = lane & 15, fq = lane >> 4;
    const int K = g.K, nt = K / BK;
    unsigned voffA[2], voffB[2];
#pragma unroll
    for (int i = 0; i < 2; ++i) { int R, C; stage_rc(tid * 16 + i * 8192, R, C); const int Rb = Epi::PERM ? ((R & ~31) + perm32(R & 31)) : R;
        voffA[i] = (unsigned)(R * g.lda + C) * 2u; voffB[i] = (unsigned)(Rb * K + C) * 2u; }
    const size_t kstep = (size_t)(BK * 2);
    const size_t hstepA = (size_t)HALF * g.lda * 2, hstepB = (size_t)HALF * K * 2;
    const size_t tstepA = 2 * hstepA, tstepB = 2 * hstepB;
    const unsigned ldsw = (unsigned)wid * 1024u;
    const int aoff = lds_byte(wr * 64 + fr, fq * 8), boff = lds_byte(wc * 32 + fr, fq * 8);
#define PG8_SA(b, h) (((b) * 2 + (h)) * HTB)
#define PG8_SB(b, h) ((4 + (b) * 2 + (h)) * HTB)
#define PG8_STAGE(bufoff, gbase, voff) do { _Pragma("unroll") for (int _i = 0; _i < 2; ++_i) \
        __builtin_amdgcn_global_load_lds((const unsigned*)((const char*)(gbase) + (voff)[_i]), (PG8_LAS unsigned*)(lds + (bufoff) + ldsw + _i * 8192), 16, 0, 0); } while (0)
#define PG8_LDA(dst, b, h) do { _Pragma("unroll") for (int m = 0; m < 4; ++m) _Pragma("unroll") for (int k = 0; k < 2; ++k) dst[m][k] = *(const PG8_LAS bf16x8*)(lds + PG8_SA(b, h) + aoff + m * 2048 + k * 1024); } while (0)
#define PG8_LDB(dst, b, h) do { _Pragma("unroll") for (int n = 0; n < 2; ++n) _Pragma("unroll") for (int k = 0; k < 2; ++k) dst[n][k] = *(const PG8_LAS bf16x8*)(lds + PG8_SB(b, h) + boff + n * 2048 + k * 1024); } while (0)
#define PG8_MMA(ai, bj, At, Bt) do { __builtin_amdgcn_s_setprio(1); _Pragma("unroll") for (int m = 0; m < 4; ++m) _Pragma("unroll") for (int n = 0; n < 2; ++n) _Pragma("unroll") for (int k = 0; k < 2; ++k) \
        acc[ai][bj][m][n] = __builtin_amdgcn_mfma_f32_16x16x32_bf16(Bt[n][k], At[m][k], acc[ai][bj][m][n], 0, 0, 0); __builtin_amdgcn_s_setprio(0); } while (0)
#define PG8_WAIT_V(n) asm volatile("s_waitcnt vmcnt(" #n ")" ::: "memory")
#define PG8_WAIT_L(n) asm volatile("s_waitcnt lgkmcnt(" #n ")" ::: "memory")
#define PG8_BAR __builtin_amdgcn_s_barrier()
#define PG8_SCHED __builtin_amdgcn_sched_barrier(0)
    Unit cur, nxt; int ui = 0;
    if (!S.next(0, cur)) return;
    f32x4 acc[2][2][4][2];
#pragma unroll
    for (int a = 0; a < 2; ++a)
#pragma unroll
        for (int b = 0; b < 2; ++b)
#pragma unroll
            for (int m = 0; m < 4; ++m)
#pragma unroll
                for (int n = 0; n < 2; ++n) acc[a][b][m][n] = (f32x4){0.f, 0.f, 0.f, 0.f};
    bf16x8 At[4][2], B0[2][2], B1[2][2];
    const char* cA = (const char*)g.A + (size_t)cur.pm * tstepA; const char* cB = (const char*)g.Bt + (size_t)cur.pn * tstepB;
    S.a_ready(cur);
    if constexpr (SP2) {
        PG8_STAGE(PG8_SB(0, 0), cB, voffB); PG8_STAGE(PG8_SB(0, 1), cB + hstepB, voffB); PG8_STAGE(PG8_SA(0, 0), cA, voffA); PG8_STAGE(PG8_SA(0, 1), cA + hstepA, voffA);
        if (wr == 1) PG8_BAR;
        PG8_WAIT_V(2); PG8_BAR;
        PG8_STAGE(PG8_SB(1, 0), cB + kstep, voffB); PG8_STAGE(PG8_SA(1, 0), cA + kstep, voffA); PG8_STAGE(PG8_SB(1, 1), cB + hstepB + kstep, voffB);
        PG8_WAIT_V(6); PG8_BAR;
    } else {
        PG8_STAGE(PG8_SB(0, 0), cB, voffB); PG8_STAGE(PG8_SA(0, 0), cA, voffA); PG8_STAGE(PG8_SB(0, 1), cB + hstepB, voffB); PG8_STAGE(PG8_SA(0, 1), cA + hstepA, voffA);
        if (wr == 1) PG8_BAR;
        PG8_WAIT_V(4); PG8_BAR;
        PG8_STAGE(PG8_SB(1, 0), cB + kstep, voffB); PG8_STAGE(PG8_SA(1, 0), cA + kstep, voffA); PG8_STAGE(PG8_SB(1, 1), cB + hstepB + kstep, voffB);
        PG8_WAIT_V(6); PG8_BAR;
    }
    for (;;) {
        const bool has_next = S.next(ui + 1, nxt);
        const char* nA = has_next ? (const char*)g.A + (size_t)nxt.pm * tstepA : cA; const char* nB = has_next ? (const char*)g.Bt + (size_t)nxt.pn * tstepB : cB;
        for (int t = 0; t < nt; t += 2) {
            if constexpr (Epi::HAS_MID) { if (t != 0 && (t & 7) == 0) E.mid(acc, cur, t >> 3, wr, wc, fr, fq); }
            const bool last = (t == nt - 2);
            const char* a1 = cA + (size_t)(t + 1) * kstep;
            const char* a2 = last ? nA : cA + (size_t)(t + 2) * kstep; const char* b2 = last ? nB : cB + (size_t)(t + 2) * kstep;
            const char* a3 = a2 + kstep; const char* b3 = b2 + kstep;
            if (last && has_next) S.a_ready(nxt);
            if constexpr (SP2) {
            PG8_LDB(B0, 0, 0); PG8_LDB(B1, 0, 1); PG8_SCHED; PG8_LDA(At, 0, 0); PG8_STAGE(PG8_SA(1, 1), a1 + hstepA, voffA);
            PG8_WAIT_V(8); PG8_WAIT_L(0); PG8_BAR; PG8_MMA(0, 0, At, B0); PG8_MMA(0, 1, At, B1); PG8_BAR; PG8_SCHED;
            PG8_LDA(At, 0, 1); PG8_STAGE(PG8_SB(0, 0), b2, voffB); PG8_STAGE(PG8_SB(0, 1), b2 + hstepB, voffB); PG8_STAGE(PG8_SA(0, 0), a2, voffA);
            PG8_WAIT_V(8); PG8_WAIT_L(0); PG8_BAR; PG8_MMA(1, 0, At, B0); PG8_MMA(1, 1, At, B1); PG8_BAR; PG8_SCHED;
            PG8_LDB(B0, 1, 0); PG8_LDB(B1, 1, 1); PG8_SCHED; PG8_LDA(At, 1, 0); PG8_STAGE(PG8_SA(0, 1), a2 + hstepA, voffA);
            PG8_WAIT_V(8); PG8_WAIT_L(0); PG8_BAR; PG8_MMA(0, 0, At, B0); PG8_MMA(0, 1, At, B1); PG8_BAR; PG8_SCHED;
            PG8_LDA(At, 1, 1); PG8_STAGE(PG8_SB(1, 0), b3, voffB); PG8_STAGE(PG8_SB(1, 1), b3 + hstepB, voffB); PG8_STAGE(PG8_SA(1, 0), a3, voffA);
            PG8_WAIT_V(8); PG8_WAIT_L(0); PG8_BAR; PG8_MMA(1, 0, At, B0); PG8_MMA(1, 1, At, B1); PG8_BAR; PG8_SCHED;
            } else {
            PG8_LDB(B0, 0, 0); PG8_SCHED; PG8_LDA(At, 0, 0); PG8_STAGE(PG8_SA(1, 1), a1 + hstepA, voffA);
            PG8_WAIT_L(8); PG8_BAR; PG8_WAIT_L(0); PG8_MMA(0, 0, At, B0); PG8_BAR; PG8_SCHED;
            PG8_LDB(B1, 0, 1); PG8_STAGE(PG8_SB(0, 0), b2, voffB);
            PG8_BAR; PG8_WAIT_L(0); PG8_MMA(0, 1, At, B1); PG8_BAR;
            PG8_LDA(At, 0, 1); PG8_STAGE(PG8_SA(0, 0), a2, voffA);
            PG8_BAR; PG8_WAIT_L(0); PG8_MMA(1, 0, At, B0); PG8_BAR; PG8_SCHED;
            PG8_STAGE(PG8_SB(0, 1), b2 + hstepB, voffB);
            PG8_WAIT_V(6); PG8_BAR; PG8_MMA(1, 1, At, B1); PG8_BAR;
            PG8_LDB(B0, 1, 0); PG8_SCHED; PG8_LDA(At, 1, 0); PG8_STAGE(PG8_SA(0, 1), a2 + hstepA, voffA);
            PG8_WAIT_L(8); PG8_BAR; PG8_WAIT_L(0); PG8_MMA(0, 0, At, B0); PG8_BAR; PG8_SCHED;
            PG8_LDB(B1, 1, 1); PG8_STAGE(PG8_SB(1, 0), b3, voffB);
            PG8_BAR; PG8_WAIT_L(0); PG8_MMA(0, 1, At, B1); PG8_BAR;
            PG8_LDA(At, 1, 1); PG8_STAGE(PG8_SA(1, 0), a3, voffA);
            PG8_BAR; PG8_WAIT_L(0); PG8_MMA(1, 0, At, B0); PG8_BAR; PG8_SCHED;
            PG8_STAGE(PG8_SB(1, 1), b3 + hstepB, voffB);
            PG8_WAIT_V(6); PG8_BAR; PG8_MMA(1, 1, At, B1); PG8_BAR;
            }
        }
        if constexpr (ALIGN_EPI) { if (wr == 0) PG8_BAR; }
        if constexpr (!Epi::AFTER_DRAIN) { E(acc, cur, wr, wc, fr, fq); S.done(cur); }
        if (!has_next) break;
#pragma unroll
        for (int a = 0; a < 2; ++a)
#pragma unroll
            for (int b = 0; b < 2; ++b)
#pragma unroll
                for (int m = 0; m < 4; ++m)
#pragma unroll
                    for (int n = 0; n < 2; ++n) acc[a][b][m][n] = (f32x4){0.f, 0.f, 0.f, 0.f};
        cur = nxt; cA = nA; cB = nB; ++ui;
        if constexpr (ALIGN_EPI) { if (wr == 1) PG8_BAR; }
    }
    PG8_WAIT_V(0);
    if constexpr (!ALIGN_EPI) { if (wr == 0) PG8_BAR; }
    PG8_BAR;
    if constexpr (Epi::AFTER_DRAIN) { E.fused(acc, cur, wr, wc, fr, fq, lds, wid, lane); S.done(cur); }
#undef PG8_SA
#undef PG8_SB
#undef PG8_STAGE
#undef PG8_LDA
#undef PG8_LDB
#undef PG8_MMA
#undef PG8_WAIT_V
#undef PG8_WAIT_L
#undef PG8_BAR
#undef PG8_SCHED
}
}
constexpr int NWAVES = 8, NTHR = 512;
constexpr int BATCH = 8, SEQ = 2048, DM = 1024, T = BATCH * SEQ, DEPTH = 2, MEML = 256, MEMT = BATCH * MEML;
constexpr int INW = 9632, INWP = 9728, NA = 5632  , MIXW = 3584, GW = 2048, GATEW = 4096;
constexpr float EPS = 1e-6f;
constexpr int MC_CQ = 0, MC_CKV = 256, MC_KR = 384, MC_BG = 512, MC_CG = 1024, MC_XIN = 1536, MC_U = 2048, MC_V = 2560, MC_MQ = 3072;
constexpr size_t MiB = 1u << 20;
constexpr size_t WS_W0 = 1 * MiB, WS_W1 = 275 * MiB;
constexpr size_t WO_WIN = 0, WO_WUQ = 19 * MiB, WO_WUKV = WO_WUQ + 768 * 256 * 2, WO_WBR = WO_WUKV + 1024 * 128 * 2, WO_WOUT = WO_WBR + 4 * MiB, WO_END = WO_WOUT + 2 * MiB;
static_assert(WO_END <= 26 * MiB, "weights");
constexpr size_t WS_SLAB = 35 * MiB, SLAB = 30 * MiB;
constexpr size_t SO_MIX = 0, SO_GATE = 0, SO_Q = 14 * MiB, SO_K = 17 * MiB, SO_VT = 20 * MiB, SO_H = 18 * MiB, SO_MERGED = 18 * MiB, SO_G = 22 * MiB;
constexpr size_t WS_WMEMT = 147 * MiB, WS_MEMN = 151 * MiB, WS_KVRAW = 27 * MiB;
constexpr size_t WS_END = 301 * MiB;
constexpr int LDS_BYTES = 147456;

#define LAS __attribute__((address_space(3)))
typedef unsigned short bf16;
typedef unsigned v4u __attribute__((ext_vector_type(4)));
typedef unsigned v2u __attribute__((ext_vector_type(2)));
typedef float f32x4 __attribute__((ext_vector_type(4)));
typedef short bf16x8 __attribute__((ext_vector_type(8)));
using pg8::cvt_pk_bf16; using pg8::bflo; using pg8::bfhi; using pg8::sigm;

__device__ __forceinline__ float wave_sum(float v) {
#pragma unroll
    for (int o = 1; o < 64; o <<= 1) v += __shfl_xor(v, o);
    return v;
}
__device__ __forceinline__ f32x4 mfma16(bf16x8 a, bf16x8 b, f32x4 c) { return __builtin_amdgcn_mfma_f32_16x16x32_bf16(a, b, c, 0, 0, 0); }
__device__ __forceinline__ bf16x8 as_bf8(v4u v) { return __builtin_bit_cast(bf16x8, v); }

struct Args { const float* in[24]; float* out; unsigned char* ws; int ph_lo, ph_hi; };
struct BV { bf16* MIX; bf16* G; bf16* Q; bf16* K; bf16* Vt; const bf16* kvraw0; const bf16* kvraw1; const int* pos; };

__device__ __forceinline__ void tr_item(const float* W, int K, int N, bf16* WT, int ldt, int coff, int win, LAS float* scr, int item, int lane) {
    const int nblk = N / 32, kb = item / nblk, nb = item % nblk, k0 = 64 * kb, n0 = 32 * nb;
    const int radd = (win && n0 >= 416) ? 96 : 0;
#pragma unroll 8
    for (int i = 0; i < 32; ++i) { const int kk = 2 * i + (lane >> 5); scr[kk * 33 + (lane & 31)] = __builtin_nontemporal_load(&W[(size_t)(k0 + kk) * N + n0 + (lane & 31)]); }
    asm volatile("s_waitcnt lgkmcnt(0)" ::: "memory");
    const int c = lane & 7;
#pragma unroll
    for (int j = 0; j < 4; ++j) { const int n = (lane >> 3) + 8 * j; const LAS float* s = scr + (8 * c) * 33 + n;
        v4u o; o.x = cvt_pk_bf16(s[0 * 33], s[1 * 33]); o.y = cvt_pk_bf16(s[2 * 33], s[3 * 33]); o.z = cvt_pk_bf16(s[4 * 33], s[5 * 33]); o.w = cvt_pk_bf16(s[6 * 33], s[7 * 33]);
        *(v4u*)(WT + (size_t)(radd + n0 + n) * ldt + coff + k0 + 8 * c) = o; }
    asm volatile("s_waitcnt lgkmcnt(0)" ::: "memory");
}
__device__ __forceinline__ void rms_row(const float* xrow, const float* g, bf16* orow, int lane) {
    const f32x4* xr = (const f32x4*)xrow + lane; const f32x4* gr = (const f32x4*)g + lane;
    f32x4 v[4]; float s = 0.f;
#pragma unroll
    for (int j = 0; j < 4; ++j) { v[j] = xr[64 * j]; s += (v[j].x * v[j].x + v[j].y * v[j].y) + (v[j].z * v[j].z + v[j].w * v[j].w); }
    const float rstd = 1.0f / sqrtf(wave_sum(s) * (1.f / 1024.f) + EPS);
    v2u* o8 = (v2u*)orow + lane;
#pragma unroll
    for (int j = 0; j < 4; ++j) { const f32x4 gg = gr[64 * j]; v2u o; o.x = cvt_pk_bf16(v[j].x * rstd * gg.x, v[j].y * rstd * gg.y); o.y = cvt_pk_bf16(v[j].z * rstd * gg.z, v[j].w * rstd * gg.w); o8[64 * j] = o; }
}
template <bool NT = false> __device__ __forceinline__ void norm_rows(const float* x, const float* g, bf16* H, int rows, int bid, int nb) {
    const int tid = pg8::opaque_tid(), lane = tid & 63, gw = bid * NWAVES + (tid >> 6), ngw = nb * NWAVES;
    const f32x4* gr = (const f32x4*)g + lane;
    for (int m = gw; m < rows; m += 2 * ngw) {
        const int m2 = m + ngw; const bool has2 = m2 < rows;
        const f32x4* xa = (const f32x4*)(x + (size_t)m * DM) + lane; const f32x4* xb = (const f32x4*)(x + (size_t)(has2 ? m2 : m) * DM) + lane;
        f32x4 va[4], vb[4]; float sa = 0.f, sb = 0.f;
#pragma unroll
        for (int j = 0; j < 4; ++j) { if (NT) { va[j] = __builtin_nontemporal_load(xa + 64 * j); vb[j] = __builtin_nontemporal_load(xb + 64 * j); } else { va[j] = xa[64 * j]; vb[j] = xb[64 * j]; } }
#pragma unroll
        for (int j = 0; j < 4; ++j) { sa += (va[j].x * va[j].x + va[j].y * va[j].y) + (va[j].z * va[j].z + va[j].w * va[j].w); sb += (vb[j].x * vb[j].x + vb[j].y * vb[j].y) + (vb[j].z * vb[j].z + vb[j].w * vb[j].w); }
        const float ra = 1.0f / sqrtf(wave_sum(sa) * (1.f / 1024.f) + EPS), rb = 1.0f / sqrtf(wave_sum(sb) * (1.f / 1024.f) + EPS);
        v2u* oa = (v2u*)(H + (size_t)m * DM) + lane; v2u* ob = (v2u*)(H + (size_t)m2 * DM) + lane;
#pragma unroll
        for (int j = 0; j < 4; ++j) { const f32x4 gg = gr[64 * j]; v2u o;
            o.x = cvt_pk_bf16(va[j].x * ra * gg.x, va[j].y * ra * gg.y); o.y = cvt_pk_bf16(va[j].z * ra * gg.z, va[j].w * ra * gg.w); oa[64 * j] = o;
            if (has2) { o.x = cvt_pk_bf16(vb[j].x * rb * gg.x, vb[j].y * rb * gg.y); o.y = cvt_pk_bf16(vb[j].z * rb * gg.z, vb[j].w * rb * gg.w); ob[64 * j] = o; } }
    }
}

constexpr int I_IN = 16 * 301, I_UQ = 4 * 24, I_UKV = 2 * 32, I_MEM = 16 * 32, I_BR = 8 * 32, I_OUT = 16 * 32;
constexpr int PER_L = I_IN + I_UQ + I_UKV + I_MEM + 4 * I_BR + I_OUT;
__device__ __forceinline__ void w_item(const Args& a, int l, int r, LAS float* scr, int lane) {
    unsigned char* wb = a.ws + (l ? WS_W1 : WS_W0);
    if (r < I_IN) { tr_item(a.in[4] + (size_t)l * DM * INW, DM, INW, (bf16*)(wb + WO_WIN), DM, 0, 1, scr, r, lane); return; } r -= I_IN;
    if (r < I_UQ) { tr_item(a.in[7] + (size_t)l * 256 * 768, 256, 768, (bf16*)(wb + WO_WUQ), 256, 0, 0, scr, r, lane); return; } r -= I_UQ;
    if (r < I_UKV) { tr_item(a.in[8] + (size_t)l * 128 * 1024, 128, 1024, (bf16*)(wb + WO_WUKV), 128, 0, 0, scr, r, lane); return; } r -= I_UKV;
    if (r < I_MEM) { tr_item(a.in[18] + (size_t)l * DM * 1024, DM, 1024, (bf16*)(a.ws + WS_SLAB + SO_Q + l * 2 * MiB), DM, 0, 0, scr, r, lane); return; } r -= I_MEM;
    if (r < 4 * I_BR) { const int n = r / I_BR; tr_item(a.in[22] + ((size_t)l * 4 + n) * 512 * DM, 512, DM, (bf16*)(wb + WO_WBR), 2048, n * 512, 0, scr, r % I_BR, lane); return; } r -= 4 * I_BR;
    tr_item(a.in[23] + (size_t)l * DM * DM, DM, DM, (bf16*)(wb + WO_WOUT), DM, 0, 0, scr, r, lane);
}
__device__ __forceinline__ void ph_prologue(const Args& a, LAS unsigned char* lds, int bid, int nb) {
    const int tid = pg8::opaque_tid(), lane = tid & 63, wave = tid >> 6;
    LAS float* scr = (LAS float*)(lds + wave * 16384);
    const int gw = bid * NWAVES + wave, ngw = nb * NWAVES;
    for (int it = gw; it < PER_L + I_MEM; it += ngw) {
        if (it < PER_L) w_item(a, 0, it, scr, lane); else w_item(a, 1, I_IN + I_UQ + I_UKV + (it - PER_L), scr, lane);
    }
    for (int i = bid * NTHR + tid; i < 2 * 96 * 128; i += nb * NTHR) { const int l = i / (96 * 128), r = i % (96 * 128);
        *(v4u*)(a.ws + (l ? WS_W1 : WS_W0) + WO_WIN + (size_t)(416 * 1024) * 2 + (size_t)r * 16) = (v4u){0u, 0u, 0u, 0u}; }
    for (int l = 0; l < 2; ++l) norm_rows<true>(a.in[1], a.in[17] + l * DM, (bf16*)(a.ws + WS_SLAB + (size_t)(1 + l) * SLAB + SO_Q), MEMT, bid, nb);
    for (int g = 0; g < BATCH; ++g) norm_rows<true>(a.in[0] + (size_t)g * SEQ * DM, a.in[3], (bf16*)(a.out + (size_t)g * SEQ * DM), SEQ, bid, nb);
}
__device__ __forceinline__ void ph_prologue_b(const Args& a, LAS unsigned char* lds, int bid) {
    const int tid = pg8::opaque_tid(), lane = tid & 63, wave = tid >> 6;
    LAS float* scr = (LAS float*)(lds + wave * 16384);
    if (bid < 32 || (bid >= 128 && bid < 160)) return;
    const int rank = bid < 128 ? bid - 32 : bid - 64;
    for (int it = rank * NWAVES + wave; it < PER_L - I_MEM; it += 192 * NWAVES) {
        int r = it; if (r >= I_IN + I_UQ + I_UKV) r += I_MEM;
        w_item(a, 1, r, scr, lane);
    }
}

__device__ __forceinline__ void ph_p2(const Args& a, const BV& v, int l, LAS unsigned char* lds, int bid, int nb) {
    const int tid = pg8::opaque_tid(), lane = tid & 63, w = tid >> 6;
    const bf16* MIX = v.MIX;
    const unsigned char* wb = a.ws + (l ? WS_W1 : WS_W0);
    const bf16* WuqT = (const bf16*)(wb + WO_WUQ); const bf16* WukvT = (const bf16*)(wb + WO_WUKV);
    const float* cqg = a.in[5] + l * 256; const float* ckvg = a.in[6] + l * 128; const float* qg = a.in[9] + l * 96; const float* kg = a.in[10] + l * 96;
    const int* pos = v.pos;
    bf16* Qb = v.Q; bf16* Kb = v.K; bf16* Vtb = v.Vt;
    constexpr int AQ_LD = 264, AKV_LD = 136;
    LAS bf16* Aq = (LAS bf16*)lds; LAS bf16* Akv = (LAS bf16*)(lds + 33792);
    LAS float* kr = (LAS float*)(lds + 51200); LAS float* cs = (LAS float*)(lds + 59392); LAS float* sn = (LAS float*)(lds + 63488);
    const float* cqg0 = cqg; const float* ckvg0 = ckvg; const float* qg0 = qg; const float* kg0 = kg;
    for (int u = bid; u < SEQ / 64; u += nb) {
        const int t0 = u * 64;
        int c16 = lane & 15, q4 = lane >> 4; asm volatile("" : "+v"(c16), "+v"(q4));
        int zo = 0; asm volatile("" : "+s"(zo));
        const float* cqg = cqg0 + zo; const float* ckvg = ckvg0 + zo; const float* qg = qg0 + zo; const float* kg = kg0 + zo;
        __syncthreads();
        {
            const int row = tid >> 3, part = tid & 7;
            const bf16* src = MIX + (size_t)(t0 + row) * MIXW;
            v4u x[4]; float ss = 0.f;
#pragma unroll
            for (int i = 0; i < 4; ++i) { x[i] = *(const v4u*)(src + MC_CQ + part * 32 + i * 8);
                ss += bflo(x[i].x) * bflo(x[i].x) + bfhi(x[i].x) * bfhi(x[i].x) + bflo(x[i].y) * bflo(x[i].y) + bfhi(x[i].y) * bfhi(x[i].y)
                    + bflo(x[i].z) * bflo(x[i].z) + bfhi(x[i].z) * bfhi(x[i].z) + bflo(x[i].w) * bflo(x[i].w) + bfhi(x[i].w) * bfhi(x[i].w); }
            ss += __shfl_xor(ss, 1); ss += __shfl_xor(ss, 2); ss += __shfl_xor(ss, 4);
            float rstd = 1.0f / sqrtf(ss * (1.f / 256.f) + EPS);
#pragma unroll
            for (int i = 0; i < 4; ++i) { const float* gp = cqg + part * 32 + i * 8; v4u o;
                o.x = cvt_pk_bf16(bflo(x[i].x) * rstd * gp[0], bfhi(x[i].x) * rstd * gp[1]); o.y = cvt_pk_bf16(bflo(x[i].y) * rstd * gp[2], bfhi(x[i].y) * rstd * gp[3]);
                o.z = cvt_pk_bf16(bflo(x[i].z) * rstd * gp[4], bfhi(x[i].z) * rstd * gp[5]); o.w = cvt_pk_bf16(bflo(x[i].w) * rstd * gp[6], bfhi(x[i].w) * rstd * gp[7]);
                *(LAS v4u*)(Aq + row * AQ_LD + part * 32 + i * 8) = o; }
            v4u y[2]; ss = 0.f;
#pragma unroll
            for (int i = 0; i < 2; ++i) { y[i] = *(const v4u*)(src + MC_CKV + part * 16 + i * 8);
                ss += bflo(y[i].x) * bflo(y[i].x) + bfhi(y[i].x) * bfhi(y[i].x) + bflo(y[i].y) * bflo(y[i].y) + bfhi(y[i].y) * bfhi(y[i].y)
                    + bflo(y[i].z) * bflo(y[i].z) + bfhi(y[i].z) * bfhi(y[i].z) + bflo(y[i].w) * bflo(y[i].w) + bfhi(y[i].w) * bfhi(y[i].w); }
            ss += __shfl_xor(ss, 1); ss += __shfl_xor(ss, 2); ss += __shfl_xor(ss, 4);
            rstd = 1.0f / sqrtf(ss * (1.f / 128.f) + EPS);
#pragma unroll
            for (int i = 0; i < 2; ++i) { const float* gp = ckvg + part * 16 + i * 8; v4u o;
                o.x = cvt_pk_bf16(bflo(y[i].x) * rstd * gp[0], bfhi(y[i].x) * rstd * gp[1]); o.y = cvt_pk_bf16(bflo(y[i].y) * rstd * gp[2], bfhi(y[i].y) * rstd * gp[3]);
                o.z = cvt_pk_bf16(bflo(y[i].z) * rstd * gp[4], bfhi(y[i].z) * rstd * gp[5]); o.w = cvt_pk_bf16(bflo(y[i].w) * rstd * gp[6], bfhi(y[i].w) * rstd * gp[7]);
                *(LAS v4u*)(Akv + row * AKV_LD + part * 16 + i * 8) = o; }
            const v2u z = *(const v2u*)(src + MC_KR + part * 4);
            kr[row * 32 + part * 4 + 0] = bflo(z.x); kr[row * 32 + part * 4 + 1] = bfhi(z.x); kr[row * 32 + part * 4 + 2] = bflo(z.y); kr[row * 32 + part * 4 + 3] = bfhi(z.y);
#pragma unroll
            for (int i = 0; i < 2; ++i) { const int e = tid * 2 + i, r = e >> 4, f = e & 15;
                const float invf = exp2f(-(float)f * (13.287712379549449f / 16.0f));
                const float ang = (float)pos[t0 + r] * invf; float sv, cv; sincosf(ang, &sv, &cv); cs[e] = cv; sn[e] = sv; }
        }
        __syncthreads();
        const int h = w;
        {
            f32x4 acc[4][6];
#pragma unroll
            for (int mt = 0; mt < 4; ++mt)
#pragma unroll
                for (int nt = 0; nt < 6; ++nt) acc[mt][nt] = (f32x4){0.f, 0.f, 0.f, 0.f};
            const bf16* wq0 = WuqT + (size_t)(h * 96 + c16) * 256 + 8 * q4;
            v4u wf[6], wn[6];
#pragma unroll
            for (int nt = 0; nt < 6; ++nt) wf[nt] = *(const v4u*)(wq0 + nt * 16 * 256);
#pragma unroll 1
            for (int ks = 0; ks < 8; ++ks) {
                if (ks + 1 < 8) {
#pragma unroll
                    for (int nt = 0; nt < 6; ++nt) wn[nt] = *(const v4u*)(wq0 + nt * 16 * 256 + (ks + 1) * 32); }
                bf16x8 tf[4];
#pragma unroll
                for (int mt = 0; mt < 4; ++mt) tf[mt] = as_bf8(*(const LAS v4u*)(Aq + (mt * 16 + c16) * AQ_LD + ks * 32 + 8 * q4));
#pragma unroll
                for (int nt = 0; nt < 6; ++nt)
#pragma unroll
                    for (int mt = 0; mt < 4; ++mt) acc[mt][nt] = mfma16(as_bf8(wf[nt]), tf[mt], acc[mt][nt]);
#pragma unroll
                for (int nt = 0; nt < 6; ++nt) wf[nt] = wn[nt];
            }
#pragma unroll
            for (int mt = 0; mt < 4; ++mt) {
                float ss = 0.f;
#pragma unroll
                for (int nt = 0; nt < 6; ++nt) ss += acc[mt][nt][0] * acc[mt][nt][0] + acc[mt][nt][1] * acc[mt][nt][1] + acc[mt][nt][2] * acc[mt][nt][2] + acc[mt][nt][3] * acc[mt][nt][3];
                ss += __shfl_xor(ss, 16); ss += __shfl_xor(ss, 32);
                const float rstd = 1.0f / sqrtf(ss * (1.f / 96.f) + EPS);
                const int r = mt * 16 + c16, t = t0 + r, b = t >> 11, s = t & 2047;
                bf16* qrow = Qb + ((size_t)(b * 8 + h) * SEQ + s) * 96;
#pragma unroll
                for (int nt = 0; nt < 4; ++nt) { const float* gp = qg + nt * 16 + 4 * q4; v2u o;
                    o.x = cvt_pk_bf16(acc[mt][nt][0] * rstd * gp[0], acc[mt][nt][1] * rstd * gp[1]); o.y = cvt_pk_bf16(acc[mt][nt][2] * rstd * gp[2], acc[mt][nt][3] * rstd * gp[3]);
                    *(v2u*)(qrow + nt * 16 + 4 * q4) = o; }
                float o1[4], o2[4];
#pragma unroll
                for (int j = 0; j < 4; ++j) { const int f = 4 * q4 + j; const float x1 = acc[mt][4][j] * rstd * qg[64 + f], x2 = acc[mt][5][j] * rstd * qg[80 + f];
                    const float cv = cs[r * 16 + f], sv = sn[r * 16 + f]; o1[j] = x1 * cv - x2 * sv; o2[j] = x1 * sv + x2 * cv; }
                v2u p1, p2; p1.x = cvt_pk_bf16(o1[0], o1[1]); p1.y = cvt_pk_bf16(o1[2], o1[3]); p2.x = cvt_pk_bf16(o2[0], o2[1]); p2.y = cvt_pk_bf16(o2[2], o2[3]);
                *(v2u*)(qrow + 64 + 4 * q4) = p1; *(v2u*)(qrow + 80 + 4 * q4) = p2;
            }
        }
        __builtin_amdgcn_sched_barrier(0);
        {
            f32x4 acc[4][4];
#pragma unroll
            for (int mt = 0; mt < 4; ++mt)
#pragma unroll
                for (int nt = 0; nt < 4; ++nt) acc[mt][nt] = (f32x4){0.f, 0.f, 0.f, 0.f};
            const bf16* wk0 = WukvT + (size_t)(h * 128 + c16) * 128 + 8 * q4;
            v4u wf[4], wn[4];
#pragma unroll
            for (int nt = 0; nt < 4; ++nt) wf[nt] = *(const v4u*)(wk0 + nt * 16 * 128);
#pragma unroll 1
            for (int ks = 0; ks < 4; ++ks) {
                if (ks + 1 < 4) {
#pragma unroll
                    for (int nt = 0; nt < 4; ++nt) wn[nt] = *(const v4u*)(wk0 + nt * 16 * 128 + (ks + 1) * 32); }
                bf16x8 tf[4];
#pragma unroll
                for (int mt = 0; mt < 4; ++mt) tf[mt] = as_bf8(*(const LAS v4u*)(Akv + (mt * 16 + c16) * AKV_LD + ks * 32 + 8 * q4));
#pragma unroll
                for (int nt = 0; nt < 4; ++nt)
#pragma unroll
                    for (int mt = 0; mt < 4; ++mt) acc[mt][nt] = mfma16(as_bf8(wf[nt]), tf[mt], acc[mt][nt]);
#pragma unroll
                for (int nt = 0; nt < 4; ++nt) wf[nt] = wn[nt];
            }
#pragma unroll
            for (int mt = 0; mt < 4; ++mt) {
                const int r = mt * 16 + c16, t = t0 + r, b = t >> 11, s = t & 2047;
                float kr1[4], kr2[4]; float ss = 0.f;
#pragma unroll
                for (int j = 0; j < 4; ++j) { kr1[j] = kr[r * 32 + 4 * q4 + j]; kr2[j] = kr[r * 32 + 16 + 4 * q4 + j]; ss += kr1[j] * kr1[j] + kr2[j] * kr2[j]; }
#pragma unroll
                for (int nt = 0; nt < 4; ++nt) ss += acc[mt][nt][0] * acc[mt][nt][0] + acc[mt][nt][1] * acc[mt][nt][1] + acc[mt][nt][2] * acc[mt][nt][2] + acc[mt][nt][3] * acc[mt][nt][3];
                ss += __shfl_xor(ss, 16); ss += __shfl_xor(ss, 32);
                const float rstd = 1.0f / sqrtf(ss * (1.f / 96.f) + EPS);
                bf16* krow = Kb + ((size_t)(b * 8 + h) * SEQ + s) * 96;
#pragma unroll
                for (int nt = 0; nt < 4; ++nt) { const float* gp = kg + nt * 16 + 4 * q4; v2u o;
                    o.x = cvt_pk_bf16(acc[mt][nt][0] * rstd * gp[0], acc[mt][nt][1] * rstd * gp[1]); o.y = cvt_pk_bf16(acc[mt][nt][2] * rstd * gp[2], acc[mt][nt][3] * rstd * gp[3]);
                    *(v2u*)(krow + nt * 16 + 4 * q4) = o; }
                float o1[4], o2[4];
#pragma unroll
                for (int j = 0; j < 4; ++j) { const int f = 4 * q4 + j; const float x1 = kr1[j] * rstd * kg[64 + f], x2 = kr2[j] * rstd * kg[80 + f];
                    const float cv = cs[r * 16 + f], sv = sn[r * 16 + f]; o1[j] = x1 * cv - x2 * sv; o2[j] = x1 * sv + x2 * cv; }
                v2u p1, p2; p1.x = cvt_pk_bf16(o1[0], o1[1]); p1.y = cvt_pk_bf16(o1[2], o1[3]); p2.x = cvt_pk_bf16(o2[0], o2[1]); p2.y = cvt_pk_bf16(o2[2], o2[3]);
                *(v2u*)(krow + 64 + 4 * q4) = p1; *(v2u*)(krow + 80 + 4 * q4) = p2;
            }
        }
        __builtin_amdgcn_sched_barrier(0);
        {
            f32x4 acc[4][4];
#pragma unroll
            for (int mt = 0; mt < 4; ++mt)
#pragma unroll
                for (int nt = 0; nt < 4; ++nt) acc[mt][nt] = (f32x4){0.f, 0.f, 0.f, 0.f};
            const bf16* wk0 = WukvT + (size_t)(h * 128 + 64 + c16) * 128 + 8 * q4;
            v4u wf[4], wn[4];
#pragma unroll
            for (int nt = 0; nt < 4; ++nt) wf[nt] = *(const v4u*)(wk0 + nt * 16 * 128);
#pragma unroll 1
            for (int ks = 0; ks < 4; ++ks) {
                if (ks + 1 < 4) {
#pragma unroll
                    for (int nt = 0; nt < 4; ++nt) wn[nt] = *(const v4u*)(wk0 + nt * 16 * 128 + (ks + 1) * 32); }
                bf16x8 tf[4];
#pragma unroll
                for (int mt = 0; mt < 4; ++mt) tf[mt] = as_bf8(*(const LAS v4u*)(Akv + (mt * 16 + c16) * AKV_LD + ks * 32 + 8 * q4));
#pragma unroll
                for (int nt = 0; nt < 4; ++nt)
#pragma unroll
                    for (int mt = 0; mt < 4; ++mt) acc[mt][nt] = mfma16(as_bf8(wf[nt]), tf[mt], acc[mt][nt]);
#pragma unroll
                for (int nt = 0; nt < 4; ++nt) wf[nt] = wn[nt];
            }
#pragma unroll
            for (int mt = 0; mt < 4; ++mt) {
                const int r = mt * 16 + c16, t = t0 + r, b = t >> 11, s = t & 2047;
                bf16* vcol = Vtb + (size_t)(b * 8 + h) * 64 * SEQ + s;
#pragma unroll
                for (int nt = 0; nt < 4; ++nt)
#pragma unroll
                    for (int j = 0; j < 4; ++j) { const int d = nt * 16 + 4 * q4 + j; vcol[(size_t)d * SEQ] = (bf16)(cvt_pk_bf16(acc[mt][nt][j], 0.f) & 0xffffu); }
            }
        }
    }
}
template <int DQK, int DV, bool CAUSAL, bool QNORM>
__device__ __forceinline__ void attn_block(LAS unsigned char* lds, const bf16* Qp, int qpitch, const float* qg, const bf16* Kp, const bf16* Vtp, int vpitch,
                                           int nkt, int row0seq, float scale_log2, bf16* Gp, int gpitch, bool st, const float* kg) {
    constexpr int KS = DQK / 32, DT = DV / 16, KROW = DQK + 8, VROW = 72, KBUF = 64 * KROW * 2, VBUF = DV * VROW * 2;
    constexpr int NKC = 8 * DQK, NVC = 8 * DV, KPT = (NKC + NTHR - 1) / NTHR, VPT = (NVC + NTHR - 1) / NTHR;
    static_assert(2 * KBUF + 2 * VBUF <= 131072, "attention LDS");
    const int tid = pg8::opaque_tid(), lane = tid & 63, w = tid >> 6, c16 = lane & 15, q4 = lane >> 4;
    __syncthreads();
    bf16x8 qf[2][KS];
    {
        v4u raw[2][KS];
#pragma unroll
        for (int qt = 0; qt < 2; ++qt)
#pragma unroll
            for (int ks = 0; ks < KS; ++ks) raw[qt][ks] = *(const v4u*)(Qp + (size_t)(32 * w + 16 * qt + c16) * qpitch + ks * 32 + 8 * q4);
        if (QNORM) {
#pragma unroll
            for (int qt = 0; qt < 2; ++qt) {
                float ss = 0.f;
#pragma unroll
                for (int ks = 0; ks < KS; ++ks) { const v4u x = raw[qt][ks];
                    ss += bflo(x.x) * bflo(x.x) + bfhi(x.x) * bfhi(x.x) + bflo(x.y) * bflo(x.y) + bfhi(x.y) * bfhi(x.y) + bflo(x.z) * bflo(x.z) + bfhi(x.z) * bfhi(x.z) + bflo(x.w) * bflo(x.w) + bfhi(x.w) * bfhi(x.w); }
                ss += __shfl_xor(ss, 16); ss += __shfl_xor(ss, 32);
                const float rstd = 1.0f / sqrtf(ss * (1.f / DQK) + EPS);
#pragma unroll
                for (int ks = 0; ks < KS; ++ks) { const v4u x = raw[qt][ks]; const float* gp = qg + ks * 32 + 8 * q4; v4u o;
                    o.x = cvt_pk_bf16(bflo(x.x) * rstd * gp[0], bfhi(x.x) * rstd * gp[1]); o.y = cvt_pk_bf16(bflo(x.y) * rstd * gp[2], bfhi(x.y) * rstd * gp[3]);
                    o.z = cvt_pk_bf16(bflo(x.z) * rstd * gp[4], bfhi(x.z) * rstd * gp[5]); o.w = cvt_pk_bf16(bflo(x.w) * rstd * gp[6], bfhi(x.w) * rstd * gp[7]);
                    raw[qt][ks] = o; }
            }
        }
#pragma unroll
        for (int qt = 0; qt < 2; ++qt)
#pragma unroll
            for (int ks = 0; ks < KS; ++ks) qf[qt][ks] = as_bf8(raw[qt][ks]);
    }
    v4u kreg[KPT], vreg[VPT];
#define ATT_GLOAD(kt) do { if constexpr (!QNORM) { \
    _Pragma("unroll") for (int i = 0; i < KPT; ++i) { const int ch = tid + i * NTHR; if (ch < NKC) kreg[i] = *(const v4u*)(Kp + (size_t)(kt) * 64 * DQK + (size_t)ch * 8); } \
    _Pragma("unroll") for (int i = 0; i < VPT; ++i) { const int ch = tid + i * NTHR; if (ch < NVC) vreg[i] = *(const v4u*)(Vtp + (size_t)(ch >> 3) * vpitch + (kt) * 64 + (ch & 7) * 8); } \
  } else { \
    _Pragma("unroll") for (int i = 0; i < KPT; ++i) { const int ch = tid + i * NTHR; kreg[i] = *(const v4u*)(Kp + (size_t)((kt) * 64 + (ch >> 4)) * 1024 + (ch & 15) * 8); } \
    _Pragma("unroll") for (int i = 0; i < VPT; ++i) { const int ch = tid + i * NTHR; vreg[i] = *(const v4u*)(Vtp + (size_t)((kt) * 64 + (ch & 63)) * 1024 + (ch >> 6) * 8); } \
  } } while (0)
#define ATT_LSTORE(buf) do { if constexpr (!QNORM) { \
    _Pragma("unroll") for (int i = 0; i < KPT; ++i) { const int ch = tid + i * NTHR; if (ch < NKC) *(LAS v4u*)(lds + (buf) * KBUF + (ch / (DQK / 8)) * (KROW * 2) + (ch % (DQK / 8)) * 16) = kreg[i]; } \
    _Pragma("unroll") for (int i = 0; i < VPT; ++i) { const int ch = tid + i * NTHR; if (ch < NVC) *(LAS v4u*)(lds + 2 * KBUF + (buf) * VBUF + (ch >> 3) * (VROW * 2) + (ch & 7) * 16) = vreg[i]; } \
  } else { \
    _Pragma("unroll") for (int i = 0; i < KPT; ++i) { const int ch = tid + i * NTHR; const v4u x = kreg[i]; \
        float ss = bflo(x.x) * bflo(x.x) + bfhi(x.x) * bfhi(x.x) + bflo(x.y) * bflo(x.y) + bfhi(x.y) * bfhi(x.y) + bflo(x.z) * bflo(x.z) + bfhi(x.z) * bfhi(x.z) + bflo(x.w) * bflo(x.w) + bfhi(x.w) * bfhi(x.w); \
        ss += __shfl_xor(ss, 1); ss += __shfl_xor(ss, 2); ss += __shfl_xor(ss, 4); ss += __shfl_xor(ss, 8); \
        const float rs = 1.0f / sqrtf(ss * (1.f / 128.f) + EPS); const float* gp = kg + (ch & 15) * 8; v4u o; \
        o.x = cvt_pk_bf16(bflo(x.x) * rs * gp[0], bfhi(x.x) * rs * gp[1]); o.y = cvt_pk_bf16(bflo(x.y) * rs * gp[2], bfhi(x.y) * rs * gp[3]); \
        o.z = cvt_pk_bf16(bflo(x.z) * rs * gp[4], bfhi(x.z) * rs * gp[5]); o.w = cvt_pk_bf16(bflo(x.w) * rs * gp[6], bfhi(x.w) * rs * gp[7]); \
        *(LAS v4u*)(lds + (buf) * KBUF + (ch >> 4) * (KROW * 2) + (ch & 15) * 16) = o; } \
    _Pragma("unroll") for (int i = 0; i < VPT; ++i) { const int ch = tid + i * NTHR; const v4u x = vreg[i]; \
        LAS bf16* vd = (LAS bf16*)(lds + 2 * KBUF + (buf) * VBUF) + ((ch >> 6) * 8) * VROW + (ch & 63); \
        vd[0 * VROW] = (bf16)(x.x & 0xffffu); vd[1 * VROW] = (bf16)(x.x >> 16); vd[2 * VROW] = (bf16)(x.y & 0xffffu); vd[3 * VROW] = (bf16)(x.y >> 16); \
        vd[4 * VROW] = (bf16)(x.z & 0xffffu); vd[5 * VROW] = (bf16)(x.z >> 16); vd[6 * VROW] = (bf16)(x.w & 0xffffu); vd[7 * VROW] = (bf16)(x.w >> 16); } \
  } } while (0)
    ATT_GLOAD(0); ATT_LSTORE(0);
    __syncthreads();
    float m_run[2] = {-1e30f, -1e30f}, l_run[2] = {0.f, 0.f};
    f32x4 o[DT][2];
#pragma unroll
    for (int dt = 0; dt < DT; ++dt) { o[dt][0] = (f32x4){0.f, 0.f, 0.f, 0.f}; o[dt][1] = (f32x4){0.f, 0.f, 0.f, 0.f}; }
    const int rw0 = row0seq + 32 * w;
    for (int kt = 0; kt < nkt; ++kt) {
        if (kt + 1 < nkt) ATT_GLOAD(kt + 1);
        const int k0 = kt * 64;
        const bool active = !CAUSAL || (k0 <= rw0 + 31);
        if (active) {
            const LAS unsigned char* kb = lds + (kt & 1) * KBUF; const LAS unsigned char* vb = lds + 2 * KBUF + (kt & 1) * VBUF;
            f32x4 s[4][2];
#pragma unroll
            for (int kk = 0; kk < 4; ++kk) { s[kk][0] = (f32x4){0.f, 0.f, 0.f, 0.f}; s[kk][1] = (f32x4){0.f, 0.f, 0.f, 0.f}; }
#pragma unroll
            for (int kk = 0; kk < 4; ++kk)
#pragma unroll
                for (int ks = 0; ks < KS; ++ks) { const bf16x8 kf = as_bf8(*(const LAS v4u*)(kb + (kk * 16 + c16) * (KROW * 2) + (ks * 32 + 8 * q4) * 2));
                    s[kk][0] = mfma16(kf, qf[0][ks], s[kk][0]); s[kk][1] = mfma16(kf, qf[1][ks], s[kk][1]); }
            const bool needmask = CAUSAL && (k0 + 63 > rw0);
            bf16x8 pf[2][2];
#pragma unroll
            for (int qt = 0; qt < 2; ++qt) {
                const int rowi = rw0 + 16 * qt + c16;
                float tmax = -INFINITY;
#pragma unroll
                for (int kk = 0; kk < 4; ++kk)
#pragma unroll
                    for (int j = 0; j < 4; ++j) { float v = s[kk][qt][j];
                        if (needmask) { const int key = k0 + kk * 16 + 4 * q4 + j; v = (key > rowi) ? -INFINITY : v; }
                        s[kk][qt][j] = v; tmax = fmaxf(tmax, v); }
                tmax = fmaxf(tmax, __shfl_xor(tmax, 16)); tmax = fmaxf(tmax, __shfl_xor(tmax, 32));
                const float mnew = fmaxf(m_run[qt], tmax * scale_log2), alpha = __builtin_amdgcn_exp2f(m_run[qt] - mnew);
                m_run[qt] = mnew;
                float psum = 0.f;
#pragma unroll
                for (int kk = 0; kk < 4; ++kk)
#pragma unroll
                    for (int j = 0; j < 4; ++j) { const float p = __builtin_amdgcn_exp2f(__builtin_fmaf(s[kk][qt][j], scale_log2, -mnew)); s[kk][qt][j] = p; psum += p; }
                l_run[qt] = l_run[qt] * alpha + psum;
#pragma unroll
                for (int dt = 0; dt < DT; ++dt) o[dt][qt] = o[dt][qt] * alpha;
#pragma unroll
                for (int kp = 0; kp < 2; ++kp) { v4u pp;
                    pp.x = cvt_pk_bf16(s[2 * kp][qt][0], s[2 * kp][qt][1]); pp.y = cvt_pk_bf16(s[2 * kp][qt][2], s[2 * kp][qt][3]);
                    pp.z = cvt_pk_bf16(s[2 * kp + 1][qt][0], s[2 * kp + 1][qt][1]); pp.w = cvt_pk_bf16(s[2 * kp + 1][qt][2], s[2 * kp + 1][qt][3]);
                    pf[qt][kp] = as_bf8(pp); }
            }
            if constexpr (!QNORM) {
                bf16x8 vfr[DT][2];
#pragma unroll
                for (int dt = 0; dt < DT; ++dt)
#pragma unroll
                    for (int kp = 0; kp < 2; ++kp) {
                        const LAS unsigned char* vp = vb + (dt * 16 + c16) * (VROW * 2) + (32 * kp + 4 * q4) * 2;
                        const v2u a0 = *(const LAS v2u*)vp, a1 = *(const LAS v2u*)(vp + 32);
                        vfr[dt][kp] = as_bf8((v4u){a0.x, a0.y, a1.x, a1.y}); }
#pragma unroll
                for (int dt = 0; dt < DT; ++dt)
#pragma unroll
                    for (int kp = 0; kp < 2; ++kp) { o[dt][0] = mfma16(vfr[dt][kp], pf[0][kp], o[dt][0]); o[dt][1] = mfma16(vfr[dt][kp], pf[1][kp], o[dt][1]); }
            } else {
#pragma unroll
            for (int dt = 0; dt < DT; ++dt)
#pragma unroll
                for (int kp = 0; kp < 2; ++kp) {
                    const LAS unsigned char* vp = vb + (dt * 16 + c16) * (VROW * 2) + (32 * kp + 4 * q4) * 2;
                    const v2u a0 = *(const LAS v2u*)vp, a1 = *(const LAS v2u*)(vp + 32);
                    const bf16x8 vf = as_bf8((v4u){a0.x, a0.y, a1.x, a1.y});
                    o[dt][0] = mfma16(vf, pf[0][kp], o[dt][0]); o[dt][1] = mfma16(vf, pf[1][kp], o[dt][1]);
                }
            }
        }
        if (kt + 1 < nkt) ATT_LSTORE((kt + 1) & 1);
        __syncthreads();
    }
#undef ATT_GLOAD
#undef ATT_LSTORE
#pragma unroll
    for (int qt = 0; qt < 2; ++qt) {
        float lt = l_run[qt]; lt += __shfl_xor(lt, 16); lt += __shfl_xor(lt, 32);
        const float inv = 1.0f / lt;
        bf16* gr = Gp + (size_t)(32 * w + 16 * qt + c16) * gpitch + 4 * q4;
#pragma unroll
        for (int dt = 0; dt < DT; ++dt) { const v2u g = *(const v2u*)(gr + dt * 16); v2u r;
            r.x = cvt_pk_bf16(o[dt][qt][0] * inv * bflo(g.x), o[dt][qt][1] * inv * bfhi(g.x)); r.y = cvt_pk_bf16(o[dt][qt][2] * inv * bflo(g.y), o[dt][qt][3] * inv * bfhi(g.y));
            if (st) *(v2u*)(gr + dt * 16) = r; }
    }
}

__device__ __forceinline__ void ph_mla(const BV& v, LAS unsigned char* lds, int bid, int nb, bool st) {
    const bf16* Qb = v.Q; const bf16* Kb = v.K; const bf16* Vtb = v.Vt; bf16* G = v.G;
    const float sc = 0.10206207261596577f * 1.4426950408889634f;
    for (int u = bid; u < 32; u += nb) {
        const int b = 0, h = (u >> 2) & 7, p = u & 3;
        for (int half = 0; half < 2; ++half) {
            const int jb = half ? p : 7 - p;
            const size_t bh = (size_t)(b * 8 + h);
            attn_block<96, 64, true, false>(lds, Qb + (bh * SEQ + 256 * jb) * 96, 96, nullptr, Kb + bh * SEQ * 96, Vtb + bh * 64 * SEQ, SEQ, 4 * (jb + 1), 256 * jb, sc,
                                            G + (size_t)(b * SEQ + 256 * jb) * GW + h * 64, GW, st, nullptr);
        }
    }
}
__device__ __forceinline__ void ph_memattn(const Args& a, const BV& v, int l, LAS unsigned char* lds, int bid, int nb, bool st) {
    const bf16* MIX = v.MIX; bf16* G = v.G;
    const bf16* kvraw = l ? v.kvraw1 : v.kvraw0;
    const float sc = 0.08838834764831845f * 1.4426950408889634f;
    for (int u = bid; u < 32; u += nb) {
        const int tb = u >> 2, h = u & 3, t0 = tb * 256, b = 0;
        attn_block<128, 128, false, true>(lds, MIX + (size_t)t0 * MIXW + MC_MQ + h * 128, MIXW, a.in[19] + l * 128, kvraw + (size_t)(b * 256) * 1024 + h * 128, kvraw + (size_t)(b * 256) * 1024 + 512 + h * 128, 256,
                                          4, 0, sc, G + (size_t)t0 * GW + 3 * 512 + h * 128, GW, st, a.in[20] + l * 128);
    }
}

__device__ __forceinline__ void ph_sg(const Args& a, const BV& v, int l, LAS unsigned char* lds, int bid, int nb, bool st) {
    const int tid = pg8::opaque_tid(), lane = tid & 63, w = tid >> 6, c16 = lane & 15, q4 = lane >> 4;
    const bf16* MIX = v.MIX; bf16* G = v.G;
    const float* lng = a.in[13] + l * 512; const float* lnb = a.in[14] + l * 512; const float* ws_ = a.in[15] + (size_t)l * 4 * 128 * 128; const float* bs = a.in[16] + l * 4 * 128;
    LAS float* stat = (LAS float*)lds; LAS bf16* vT = (LAS bf16*)(lds + 1024); constexpr int VLD = 136;
    for (int u = bid; u < 32; u += nb) {
        const int c = u >> 1, gp2 = u & 1, t0 = c * 128;
        __syncthreads();
        {   const int row = tid >> 2, part = tid & 3; const bf16* src = MIX + (size_t)(t0 + row) * MIXW + MC_V + part * 128;
            float s1 = 0.f, s2 = 0.f;
#pragma unroll 4
            for (int i = 0; i < 16; ++i) { const v4u x = *(const v4u*)(src + i * 8);
                const float f0 = bflo(x.x), f1 = bfhi(x.x), f2 = bflo(x.y), f3 = bfhi(x.y), f4 = bflo(x.z), f5 = bfhi(x.z), f6 = bflo(x.w), f7 = bfhi(x.w);
                s1 += ((f0 + f1) + (f2 + f3)) + ((f4 + f5) + (f6 + f7)); s2 += ((f0 * f0 + f1 * f1) + (f2 * f2 + f3 * f3)) + ((f4 * f4 + f5 * f5) + (f6 * f6 + f7 * f7)); }
            s1 += __shfl_xor(s1, 1); s1 += __shfl_xor(s1, 2); s2 += __shfl_xor(s2, 1); s2 += __shfl_xor(s2, 2);
            const float mean = s1 * (1.f / 512.f), var = fmaxf(s2 * (1.f / 512.f) - mean * mean, 0.f);
            if (part == 0) { stat[row * 2] = mean; stat[row * 2 + 1] = 1.0f / sqrtf(var + EPS); }
        }
        __syncthreads();
        {   const int s = tid & 127, dq = tid >> 7; const bf16* src = MIX + (size_t)(t0 + s) * MIXW + MC_V + gp2 * 256 + dq * 64;
            const float mean = stat[s * 2], rstd = stat[s * 2 + 1];
#pragma unroll
            for (int i = 0; i < 8; ++i) { const v4u x = *(const v4u*)(src + i * 8); const int d0 = dq * 64 + i * 8; const float* gp = lng + gp2 * 256 + d0; const float* bp = lnb + gp2 * 256 + d0;
                float f[8] = {bflo(x.x), bfhi(x.x), bflo(x.y), bfhi(x.y), bflo(x.z), bfhi(x.z), bflo(x.w), bfhi(x.w)};
#pragma unroll
                for (int e = 0; e < 8; ++e) { const float y = (f[e] - mean) * rstd * gp[e] + bp[e]; vT[(d0 + e) * VLD + s] = (bf16)(cvt_pk_bf16(y, 0.f) & 0xffffu); } }
        }
        __syncthreads();
#pragma unroll 1
        for (int half = 0; half < 2; ++half) {
            const int g = gp2 * 2 + half, rt = half ? 7 - w : w;
            f32x4 acc[8];
#pragma unroll
            for (int nt = 0; nt < 8; ++nt) acc[nt] = (f32x4){0.f, 0.f, 0.f, 0.f};
            const int tt = 16 * rt + c16, nks = (rt >> 1) + 1;
            const float* wrow = ws_ + ((size_t)g * 128 + tt) * 128;
            for (int ks = 0; ks < nks; ++ks) {
                const int s0 = ks * 32 + 8 * q4;
                const f32x4 w0 = *(const f32x4*)(wrow + s0), w1 = *(const f32x4*)(wrow + s0 + 4);
                float wv[8] = {w0[0], w0[1], w0[2], w0[3], w1[0], w1[1], w1[2], w1[3]};
#pragma unroll
                for (int e = 0; e < 8; ++e) wv[e] = (s0 + e <= tt) ? wv[e] : 0.f;
                v4u wp; wp.x = cvt_pk_bf16(wv[0], wv[1]); wp.y = cvt_pk_bf16(wv[2], wv[3]); wp.z = cvt_pk_bf16(wv[4], wv[5]); wp.w = cvt_pk_bf16(wv[6], wv[7]);
                const bf16x8 bfrag = as_bf8(wp);
#pragma unroll
                for (int nt = 0; nt < 8; ++nt) { const bf16x8 af = as_bf8(*(const LAS v4u*)(vT + (half * 128 + nt * 16 + c16) * VLD + s0)); acc[nt] = mfma16(af, bfrag, acc[nt]); }
            }
            const int t = t0 + tt; const float bias = bs[g * 128 + tt];
            const bf16* up = MIX + (size_t)t * MIXW + MC_U + g * 128 + 4 * q4; bf16* gp = G + (size_t)t * GW + 2 * 512 + g * 128 + 4 * q4;
#pragma unroll
            for (int nt = 0; nt < 8; ++nt) { const v2u uu = *(const v2u*)(up + nt * 16), gg = *(const v2u*)(gp + nt * 16); v2u r;
                r.x = cvt_pk_bf16(bflo(uu.x) * (acc[nt][0] + bias) * bflo(gg.x), bfhi(uu.x) * (acc[nt][1] + bias) * bfhi(gg.x));
                r.y = cvt_pk_bf16(bflo(uu.y) * (acc[nt][2] + bias) * bflo(gg.y), bfhi(uu.y) * (acc[nt][3] + bias) * bfhi(gg.y));
                if (st) *(v2u*)(gp + nt * 16) = r; }
        }
    }
}

__device__ __forceinline__ void ph_conv(const Args& a, const BV& v, int l, int bid, int nb, bool st) {
    const bf16* MIX = v.MIX; bf16* G = v.G;
    const float* cw = a.in[11] + l * 3 * 512; const float* cb = a.in[12] + l * 512;
    for (int idx = bid * NTHR + pg8::opaque_tid(); idx < (SEQ / 4) * 64; idx += nb * NTHR) {
        const int t4 = (idx >> 6) * 4, c = (idx & 63) * 8;
        float w0[8], w1[8], w2[8], bb[8];
#pragma unroll
        for (int e = 0; e < 8; ++e) { w0[e] = cw[c + e]; w1[e] = cw[512 + c + e]; w2[e] = cw[1024 + c + e]; bb[e] = cb[c + e]; }
        v4u cgv[6], xv[6], bgv[4], ggv[4];
#pragma unroll
        for (int r = 0; r < 6; ++r) { const int t = t4 - 2 + r; const bf16* row = MIX + (size_t)(t < 0 ? 0 : t) * MIXW; cgv[r] = *(const v4u*)(row + MC_CG + c); xv[r] = *(const v4u*)(row + MC_XIN + c); }
#pragma unroll
        for (int r = 0; r < 4; ++r) { bgv[r] = *(const v4u*)(MIX + (size_t)(t4 + r) * MIXW + MC_BG + c); ggv[r] = *(const v4u*)(G + (size_t)(t4 + r) * GW + 512 + c); }
        float z[6][8];
#pragma unroll
        for (int r = 0; r < 6; ++r) { const float m = (t4 - 2 + r < 0) ? 0.f : 1.f;
            z[r][0] = m * bflo(cgv[r].x) * bflo(xv[r].x); z[r][1] = m * bfhi(cgv[r].x) * bfhi(xv[r].x); z[r][2] = m * bflo(cgv[r].y) * bflo(xv[r].y); z[r][3] = m * bfhi(cgv[r].y) * bfhi(xv[r].y);
            z[r][4] = m * bflo(cgv[r].z) * bflo(xv[r].z); z[r][5] = m * bfhi(cgv[r].z) * bfhi(xv[r].z); z[r][6] = m * bflo(cgv[r].w) * bflo(xv[r].w); z[r][7] = m * bfhi(cgv[r].w) * bfhi(xv[r].w); }
#pragma unroll
        for (int r = 0; r < 4; ++r) {
            const v4u bg = bgv[r], gg = ggv[r];
            const float bgf[8] = {bflo(bg.x), bfhi(bg.x), bflo(bg.y), bfhi(bg.y), bflo(bg.z), bfhi(bg.z), bflo(bg.w), bfhi(bg.w)};
            const float ggf[8] = {bflo(gg.x), bfhi(gg.x), bflo(gg.y), bfhi(gg.y), bflo(gg.z), bfhi(gg.z), bflo(gg.w), bfhi(gg.w)};
            float y[8];
#pragma unroll
            for (int e = 0; e < 8; ++e) y[e] = bgf[e] * (bb[e] + w0[e] * z[r][e] + w1[e] * z[r + 1][e] + w2[e] * z[r + 2][e]) * ggf[e];
            v4u o; o.x = cvt_pk_bf16(y[0], y[1]); o.y = cvt_pk_bf16(y[2], y[3]); o.z = cvt_pk_bf16(y[4], y[5]); o.w = cvt_pk_bf16(y[6], y[7]);
            if (st) *(v4u*)(G + (size_t)(t4 + r) * GW + 512 + c) = o;
        }
    }
}
#define XB_TMO      128
#define XB_XCNT(j)  (256  + 64 * (j))
#define XB_XSUB(j)  (1280 + 64 * (j))
#define XB_XGEN(j)  (2304 + 64 * (j))
#define XB_TOP      3328
#define XB_TOPGEN   3392
#define XCD_BAR_WORDS 3456
#define XB_SPIN_CAP (1u << 18)

__device__ __forceinline__ unsigned xb_ld(unsigned* p)              { return __hip_atomic_load(p, __ATOMIC_RELAXED, __HIP_MEMORY_SCOPE_AGENT); }
__device__ __forceinline__ unsigned xb_add(unsigned* p, unsigned v) { return __hip_atomic_fetch_add(p, v, __ATOMIC_RELAXED, __HIP_MEMORY_SCOPE_AGENT); }
__device__ __forceinline__ unsigned xb_xcc_id() { return (unsigned)__builtin_amdgcn_s_getreg((3 << 11) | 20) & 0xFu; }
#define XB_SPIN(cond, bar) do { unsigned _sp = 0; while (cond) { __builtin_amdgcn_s_sleep(1); \
    if ((++_sp & 255u) == 0u) { if (xb_ld(&(bar)[XB_TMO])) break; if (_sp > XB_SPIN_CAP) { atomicAdd(&(bar)[XB_TMO], 1u); break; } } } } while (0)

struct XcdBarrier {
    unsigned* bar; unsigned x;
    volatile LAS unsigned* st;
};

__device__ __forceinline__ XcdBarrier xcd_barrier_post(unsigned* bar, volatile LAS unsigned* st) {
    XcdBarrier b; b.bar = bar; b.x = xb_xcc_id(); b.st = st;
    if (threadIdx.x == 0) (void)xb_add(&bar[XB_XCNT(b.x)], 1u);
    return b;
}
__device__ __forceinline__ void xcd_barrier_complete(unsigned* bar, unsigned x, unsigned& nloc, unsigned& nx) {
    const unsigned G = gridDim.x * gridDim.y * gridDim.z;
    unsigned sum, cnt, mine, sp = 0u;
    for (;;) {
        sum = 0u; cnt = 0u; mine = 0u;
#pragma unroll
        for (unsigned j = 0; j < 16; ++j) { const unsigned c = xb_ld(&bar[XB_XCNT(j)]); sum += c; cnt += (c > 0u) ? 1u : 0u; mine = (j == x) ? c : mine; }
        if (sum == G) break;
        __builtin_amdgcn_s_sleep(1);
        if ((++sp & 255u) == 0u) { if (xb_ld(&bar[XB_TMO])) break; if (sp > XB_SPIN_CAP) { atomicAdd(&bar[XB_TMO], 1u); break; } }
    }
    nloc = mine > 0u ? mine : 1u; nx = cnt > 0u ? cnt : 1u;
}

__device__ __forceinline__ void xcd_barrier(const XcdBarrier& b) {
    asm volatile("s_waitcnt vmcnt(0)" ::: "memory");
    __syncthreads();
    if (threadIdx.x == 0) {
        unsigned* bar = b.bar;
        __builtin_amdgcn_s_waitcnt(0);
        unsigned nloc = b.st[0], nx = b.st[1];
        if (nloc == 0u) { xcd_barrier_complete(bar, b.x, nloc, nx); b.st[0] = nloc; b.st[1] = nx; }
        const unsigned old = xb_add(&bar[XB_XSUB(b.x)], 1u);
        const unsigned gen = old / nloc;
        if (old + 1u == (gen + 1u) * nloc) {
            __builtin_amdgcn_fence(__ATOMIC_RELEASE, "agent");
            asm volatile("s_waitcnt vmcnt(0)" ::: "memory");
            const unsigned og = xb_add(&bar[XB_TOP], 1u);
            const unsigned tg = og / nx;
            if (og + 1u == (tg + 1u) * nx) xb_add(&bar[XB_TOPGEN], 1u);
            else XB_SPIN(xb_ld(&bar[XB_TOPGEN]) == tg, bar);
            __builtin_amdgcn_fence(__ATOMIC_ACQUIRE, "agent");
            xb_add(&bar[XB_XGEN(b.x)], 1u);
            asm volatile("s_waitcnt vmcnt(0)" ::: "memory");
        } else {
            XB_SPIN(xb_ld(&bar[XB_XGEN(b.x)]) == gen, bar);
            __builtin_amdgcn_fence(__ATOMIC_ACQUIRE, "agent");
            asm volatile("s_waitcnt vmcnt(0)" ::: "memory");
        }
    }
    __syncthreads();
}

#ifndef MK_PER_PHASE
#define MK_PER_PHASE 0
#endif
constexpr int NPH = 1 + 8 + 7;
__device__ __forceinline__ void group_barrier(unsigned* cnt, unsigned& round, unsigned npart, bool local) {
    asm volatile("s_waitcnt vmcnt(0)" ::: "memory");
    __syncthreads();
    if (threadIdx.x == 0) {
        if (!local) { __builtin_amdgcn_fence(__ATOMIC_RELEASE, "agent"); asm volatile("s_waitcnt vmcnt(0)" ::: "memory"); }
        (void)__hip_atomic_fetch_add(cnt, 1u, __ATOMIC_RELAXED, __HIP_MEMORY_SCOPE_AGENT);
        const unsigned target = (round + 1u) * npart; unsigned sp = 0u;
        while (__hip_atomic_load(cnt, __ATOMIC_RELAXED, __HIP_MEMORY_SCOPE_AGENT) < target) { __builtin_amdgcn_s_sleep(1); if (++sp > (1u << 24)) break; }
        __builtin_amdgcn_fence(__ATOMIC_ACQUIRE, "agent");
        asm volatile("s_waitcnt vmcnt(0)" ::: "memory");
    }
    __syncthreads();
    ++round;
}

__global__ void __launch_bounds__(NTHR, 2) mk_fwd(Args a) {
    extern __shared__ __attribute__((aligned(16))) unsigned char lds_raw[];
    LAS unsigned char* lds = (LAS unsigned char*)lds_raw;
    cg::grid_group grid = cg::this_grid();
    const int bid = blockIdx.x, nb = gridDim.x;
    const bool real = (a.ph_hi > 0);
    volatile LAS unsigned* MISC = (volatile LAS unsigned*)(lds + 131072);
    if (threadIdx.x < 32) MISC[threadIdx.x] = 0u;
    __syncthreads();
    const XcdBarrier bar = xcd_barrier_post((unsigned*)a.ws + 1024, MISC + 8);
#ifdef TSPROBE
    unsigned long long* ts = (unsigned long long*)(a.ws + 100000); int nts = 0;
#define STAMP() do { if (bid == 0 && threadIdx.x == 0) ts[nts] = __builtin_amdgcn_s_memrealtime(); ++nts; } while (0)
#else
#define STAMP() do {} while (0)
#endif
    STAMP();
#ifdef DUP_PRO
    ph_prologue(a, lds, bid, nb); __syncthreads();
#endif
    if (threadIdx.x == 0) atomicOr((unsigned*)a.ws + 15360 + (bid & 7), 1u << xb_xcc_id());
#ifdef XCCPROBE
    if (threadIdx.x == 0) { unsigned* tb = (unsigned*)a.ws + 14336; const unsigned x = xb_xcc_id();
        atomicOr(tb + (bid & 7), 1u << x); atomicOr(tb + 8 + (bid >> 5), 1u << x); }
#endif
    ph_prologue(a, lds, bid, nb);
    if (a.ph_hi < 0) grid.sync();
    xcd_barrier(bar);
    STAMP();
    for (int ll = 0; ll < 2; ++ll) {
        pg8::Gemm g2{(const bf16*)(a.ws + WS_SLAB + (size_t)(1 + ll) * SLAB + SO_Q), DM, (const bf16*)(a.ws + WS_SLAB + SO_Q + ll * 2 * MiB), MEMT, 1024, DM};
        pg8::StaticOrder S2; S2.init(MEMT, 1024, nb, (bid + 128 * ll) % nb);
        pg8::EpiAct<0> E2{(bf16*)(a.ws + WS_KVRAW + ll * 4 * MiB), 1024, 1 << 20, nullptr, 0, nullptr};
        pg8::gemm_phase<pg8::EpiAct<0>, pg8::StaticOrder, true, true>(lds, g2, S2, E2);
    }
    __syncthreads();
    ph_prologue_b(a, lds, bid);
    unsigned* done2 = (unsigned*)a.ws + 14848;
    asm volatile("s_waitcnt vmcnt(0)" ::: "memory");
    __syncthreads();
    if (threadIdx.x == 0) { __builtin_amdgcn_fence(__ATOMIC_RELEASE, "agent"); asm volatile("s_waitcnt vmcnt(0)" ::: "memory"); (void)__hip_atomic_fetch_add(done2, 1u, __ATOMIC_RELAXED, __HIP_MEMORY_SCOPE_AGENT); }
    STAMP();
    const int g = bid & 7, lb = bid >> 3; constexpr int NLB = 32;
    unsigned* gcnt = (unsigned*)a.ws + 8192 + 64 * g; unsigned round = 0u;
    const bool glocal = __builtin_popcount(__hip_atomic_load((unsigned*)a.ws + 15360 + g, __ATOMIC_RELAXED, __HIP_MEMORY_SCOPE_AGENT)) == 1;
    unsigned char* slab = a.ws + WS_SLAB + (size_t)g * SLAB;
    BV v; v.MIX = (bf16*)(slab + SO_MIX); v.G = (bf16*)(slab + SO_G); v.Q = (bf16*)(slab + SO_Q); v.K = (bf16*)(slab + SO_K); v.Vt = (bf16*)(slab + SO_VT);
    v.kvraw0 = (const bf16*)(a.ws + WS_KVRAW) + (size_t)g * MEML * 1024; v.kvraw1 = (const bf16*)(a.ws + WS_KVRAW + 4 * MiB) + (size_t)g * MEML * 1024; v.pos = (const int*)a.in[2] + g * SEQ;
    bf16* H = (bf16*)(slab + SO_H); bf16* GATE = (bf16*)(slab + SO_GATE); bf16* MERGED = (bf16*)(slab + SO_MERGED);
    float* outg = a.out + (size_t)g * SEQ * DM;
#ifdef DUP_GB
#define GB() do { group_barrier(gcnt, round, 32u, glocal); group_barrier(gcnt, round, 32u, glocal); group_barrier(gcnt, round, 32u, glocal); } while (0)
#else
#define GB() do { group_barrier(gcnt, round, 32u, glocal); STAMP(); } while (0)
#endif
#ifdef STAGGER_TICKS
    if (g >= 4) { const unsigned long long t0 = __builtin_amdgcn_s_memrealtime(); while (__builtin_amdgcn_s_memrealtime() - t0 < (unsigned long long)(STAGGER_TICKS)) __builtin_amdgcn_s_sleep(32); }
#endif
    for (int l = 0; l < 2; ++l) {
        const unsigned char* wb = a.ws + (l ? WS_W1 : WS_W0);
        const bf16* WinT = (const bf16*)(wb + WO_WIN);
        const float* xl = l ? outg : a.in[0] + (size_t)g * SEQ * DM;
        const bf16* Hl = l ? H : (const bf16*)outg;
        {
            pg8::Gemm gm{Hl, DM, WinT, SEQ, NA, DM};
            pg8::StaticOrder S; S.init(SEQ, NA, NLB, lb);
            pg8::EpiAct<1> E{v.MIX, MIXW, 14, v.G, GW, nullptr};
#ifdef DUP_P1A
            pg8::gemm_phase<pg8::EpiAct<1>, pg8::StaticOrder, true, true>(lds, gm, S, E);
#endif
            pg8::gemm_phase<pg8::EpiAct<1>, pg8::StaticOrder, true, true>(lds, gm, S, E);
        }
        GB();
        if (l == 0) {
            if (threadIdx.x == 0) { unsigned sp = 0u; while (__hip_atomic_load(done2, __ATOMIC_RELAXED, __HIP_MEMORY_SCOPE_AGENT) < (unsigned)nb) { __builtin_amdgcn_s_sleep(2); if (++sp > (1u << 24)) break; }
                __builtin_amdgcn_fence(__ATOMIC_ACQUIRE, "agent"); asm volatile("s_waitcnt vmcnt(0)" ::: "memory"); }
            __syncthreads();
        }
#ifdef DUP_P2
        ph_p2(a, v, l, lds, lb, NLB);
#endif
        ph_p2(a, v, l, lds, lb, NLB);
        GB();
#ifdef DUP_MLA
        ph_mla(v, lds, lb, NLB, !real);
#endif
#ifdef DUP_MIX3
        ph_memattn(a, v, l, lds, lb, NLB, !real); ph_sg(a, v, l, lds, lb, NLB, !real); ph_conv(a, v, l, lb, NLB, !real);
#endif
        ph_mla(v, lds, lb, NLB, real); ph_memattn(a, v, l, lds, lb, NLB, real); ph_sg(a, v, l, lds, lb, NLB, real); ph_conv(a, v, l, lb, NLB, real);
        GB();
        if (l == 1) { norm_rows(xl, a.in[3] + l * DM, H, SEQ, lb, NLB); GB(); }
        {
            pg8::Gemm gm{Hl, DM, WinT + (size_t)NA * DM, SEQ, GATEW, DM};
            pg8::StaticOrder S; S.init(SEQ, GATEW, NLB, lb);
            pg8::EpiGateQ E{GATE, a.in[21] + l * 4096};
#ifdef DUP_P1B
            pg8::gemm_phase<pg8::EpiGateQ, pg8::StaticOrder, true, true>(lds, gm, S, E);
#endif
            pg8::gemm_phase<pg8::EpiGateQ, pg8::StaticOrder, true, true>(lds, gm, S, E);
        }
        GB();
        {
            pg8::Gemm gm{v.G, GW, (const bf16*)(wb + WO_WBR), SEQ, DM, 2048};
            pg8::StaticOrder S; S.init(SEQ, DM, NLB, lb);
            pg8::EpiGate E{GATE, MERGED};
#ifdef DUP_P4
            pg8::gemm_phase<pg8::EpiGate, pg8::StaticOrder, false, true>(lds, gm, S, E);
#endif
            pg8::gemm_phase<pg8::EpiGate, pg8::StaticOrder, false, true>(lds, gm, S, E);
            pg8::Unit u4; S.next(0, u4); unsigned pr4 = 0u;
            group_barrier((unsigned*)a.ws + 20480 + 64 * ((l * 8 + g) * 8 + u4.pm), pr4, 4u, glocal);
        }
        {
            pg8::Gemm gm{MERGED, DM, (const bf16*)(wb + WO_WOUT), SEQ, DM, DM};
            pg8::StaticOrder S; S.init(SEQ, DM, NLB, lb);
#ifdef DUP_P5
            { pg8::EpiRes E0{xl, outg, DM, !real}; pg8::gemm_phase<pg8::EpiRes, pg8::StaticOrder, false, true>(lds, gm, S, E0); }
#endif
            pg8::EpiRes E{xl, outg, DM, real};
            pg8::gemm_phase<pg8::EpiRes, pg8::StaticOrder, false, true>(lds, gm, S, E);
            if (l == 0) {
                pg8::Unit u; S.next(0, u);
                unsigned pround = 0u;
                group_barrier((unsigned*)a.ws + 16384 + 64 * (g * 8 + u.pm), pround, 4u, glocal);
                const int r0 = u.pm * 256 + u.pn * 64;
                norm_rows(outg + (size_t)r0 * DM, a.in[3] + DM, H + (size_t)r0 * DM, 64, 0, 1);
            }
        }
        if (l == 0) GB();
    }
#ifdef XCCPROBE
    if (bid == 0) { __syncthreads(); asm volatile("s_waitcnt vmcnt(0)" ::: "memory");
        if (threadIdx.x == 0) { pg8::StaticOrder S; S.init(SEQ, DM, NLB, lb); pg8::Unit u; S.next(0, u);
            const unsigned* tb = (const unsigned*)a.ws + 14336; int A = 0, B = 0;
            for (int r = 0; r < 8; ++r) { const unsigned ma = __hip_atomic_load(tb + r, __ATOMIC_RELAXED, __HIP_MEMORY_SCOPE_AGENT), mb = __hip_atomic_load(tb + 8 + r, __ATOMIC_RELAXED, __HIP_MEMORY_SCOPE_AGENT);
                A += (__builtin_popcount(ma) != 1); B += (__builtin_popcount(mb) != 1); }
            outg[(size_t)(u.pm * 256) * DM + u.pn * 256] += 1.0f + 10.0f * (float)A + (float)B; } }
#endif
#ifdef TSPROBE
    STAMP();
    if (bid == 0) {
        __syncthreads();
        asm volatile("s_waitcnt vmcnt(0)" ::: "memory");
        const float d1 = (float)(ts[TS_A1] - ts[TS_A0]) * 0.01f, d2 = (float)(ts[TS_B1] - ts[TS_B0]) * 0.01f;
        pg8::StaticOrder S; S.init(SEQ, DM, NLB, lb); pg8::Unit u; S.next(0, u);
        float* tile = outg + (size_t)(u.pm * 256) * DM + u.pn * 256;
        for (int i = 0; i < 128; ++i) { const int e = threadIdx.x + 512 * i; tile[(size_t)(e >> 8) * DM + (e & 255)] += 0.004f * d2; }
        __syncthreads();
        if (threadIdx.x == 0) tile[0] += 0.02f * d1;
    }
#endif
#undef GB
}

extern "C" void kernel_launch(void* const* d_in, const int* in_sizes, int n_in, void* d_out, int out_size, void* d_ws, size_t ws_size, hipStream_t stream) {
    static int grid = 0;
    if (grid == 0) {
        if (n_in != 24 || out_size != T * DM || ws_size < WS_END) { fprintf(stderr, "kernel_launch: unexpected problem (n_in %d out %d ws %zu)\n", n_in, out_size, ws_size); grid = -1; return; }
        int dev = 0, cus = 0, per_cu = 0;
        hipGetDevice(&dev); hipDeviceGetAttribute(&cus, hipDeviceAttributeMultiprocessorCount, dev);
        if (hipFuncSetAttribute((const void*)mk_fwd, hipFuncAttributeMaxDynamicSharedMemorySize, LDS_BYTES) != hipSuccess) { fprintf(stderr, "kernel_launch: hipFuncSetAttribute failed\n"); grid = -1; return; }
        if (hipOccupancyMaxActiveBlocksPerMultiprocessor(&per_cu, (const void*)mk_fwd, NTHR, LDS_BYTES) != hipSuccess || per_cu < 1) { fprintf(stderr, "kernel_launch: occupancy query says %d\n", per_cu); per_cu = 1; }
        (void)hipGetLastError();
        if (cus < 256) { fprintf(stderr, "kernel_launch: needs 256 CUs, device has %d\n", cus); grid = -1; return; }
        grid = 256;
    }
    if (grid < 0) return;
    if (hipMemsetAsync(d_ws, 0, 131072, stream) != hipSuccess) { fprintf(stderr, "kernel_launch: memset failed\n"); return; }
    Args a{};
    for (int i = 0; i < 24; ++i) a.in[i] = (const float*)d_in[i];
    a.out = (float*)d_out; a.ws = (unsigned char*)d_ws;
    a.ph_lo = 0; a.ph_hi = NPH; void* args[] = {&a};
    hipError_t e = hipLaunchCooperativeKernel((void*)mk_fwd, dim3(grid), dim3(NTHR), args, LDS_BYTES, stream);
    if (e != hipSuccess) fprintf(stderr, "cooperative launch failed: %s (grid %d)\n", hipGetErrorString(e), grid);
}
```
